# Optimizing an MI355X kernel written in HIP

```python
import jax, jax.numpy as jnp
from jax import lax
import numpy as np

D_MODEL = 1024
BATCH = 4
SEQ = 4096
DEPTH = 1
DEC_BATCH = 128
DEC_SEQ = 8
PAST_LEN = 2048
PAGE_SIZE = 128

N_HEADS = 8
N_KV_HEADS = 2
GROUP = N_HEADS // N_KV_HEADS
HEAD_DIM = D_MODEL // N_HEADS
N_IDX_HEADS = 8
IDX_DIM = 64
IDX_SCALE = (N_IDX_HEADS * IDX_DIM) ** -0.5
TOPK_MAX = 256
D_CONV = D_MODEL
CONV_WIDTH = 3
D_FF = -(-8 * D_MODEL // (3 * 256)) * 256
D_PLE = 256
ROPE_THETA = 10000.0
Q_BLOCK = 128
EPS = 1e-6
IN_SIZES = (N_HEADS * HEAD_DIM, N_KV_HEADS * HEAD_DIM, N_KV_HEADS * HEAD_DIM,
            N_IDX_HEADS * IDX_DIM, IDX_DIM, N_IDX_HEADS,
            D_CONV, D_CONV, D_CONV, D_MODEL, D_MODEL)
D_IN_TOTAL = sum(IN_SIZES)

kernel_name = "hybrid_dsa_shortconv_decoder_step"


def rmsnorm(x, g):
    xf = x.astype(jnp.float32)
    var = jnp.mean(xf * xf, axis=-1, keepdims=True)
    return (xf * lax.rsqrt(var + EPS)).astype(x.dtype) * g


def rope(x, pos):
    half = x.shape[-1] // 2
    freqs = ROPE_THETA ** (-jnp.arange(half, dtype=jnp.float32) / half)
    ang = pos.astype(jnp.float32)[:, None] * freqs[None, :]
    cos = jnp.cos(ang)[:, None, :]
    sin = jnp.sin(ang)[:, None, :]
    xf = x.astype(jnp.float32)
    x1, x2 = xf[..., :half], xf[..., half:]
    return jnp.concatenate([x1 * cos - x2 * sin, x2 * cos + x1 * sin], axis=-1).astype(x.dtype)


def mix_inputs(h, w_in, pos):
    z = h @ w_in
    offs = []
    acc = 0
    for s in IN_SIZES[:-1]:
        acc += s
        offs.append(acc)
    q, k, v, qi, ki, wi, bg, cg, xc, ga, gb = jnp.split(z, offs, axis=-1)
    B, T = h.shape[:2]
    q = rope(q.reshape(B, T, N_HEADS, HEAD_DIM), pos)
    k = rope(k.reshape(B, T, N_KV_HEADS, HEAD_DIM), pos)
    v = v.reshape(B, T, N_KV_HEADS, HEAD_DIM)
    qi = rope(qi.reshape(B, T, N_IDX_HEADS, IDX_DIM), pos)
    ki = rope(ki[:, :, None, :], pos)[:, :, 0, :]
    return q, k, v, qi, ki, wi, bg, cg, xc, ga, gb


def select_attend(q, qi, wi, q_pos, k_all, v_all, ki_all):
    B, Tq = q.shape[:2]
    L = k_all.shape[1]
    n_sel = min(TOPK_MAX, L // 4)
    causal = jnp.arange(L)[None, :] <= q_pos[:, None]
    dots = jnp.einsum('bthd,bld->bthl', qi.astype(jnp.float32), ki_all.astype(jnp.float32))
    score = jnp.einsum('bth,bthl->btl', wi.astype(jnp.float32), jax.nn.relu(dots)) * IDX_SCALE
    score = jnp.where(causal[None], score, -jnp.inf)
    _, idx = lax.top_k(score, n_sel)
    valid = idx <= q_pos[None, :, None]
    gather = jax.vmap(lambda kb, ib: kb[ib])
    k_sel = gather(k_all, idx)
    v_sel = gather(v_all, idx)
    qg = q.reshape(B, Tq, N_KV_HEADS, GROUP, HEAD_DIM)
    s = jnp.einsum('btkgd,btjkd->btkgj', qg, k_sel).astype(jnp.float32) * (HEAD_DIM ** -0.5)
    s = jnp.where(valid[:, :, None, None, :], s, -jnp.inf)
    p = jax.nn.softmax(s, axis=-1).astype(v_sel.dtype)
    o = jnp.einsum('btkgj,btjkd->btkgd', p, v_sel)
    return o.reshape(B, Tq, N_HEADS * HEAD_DIM)


def prompt_attention(q, qi, wi, k, v, ki):
    B, T = q.shape[:2]
    nb = T // Q_BLOCK

    def to_blocks(a):
        return jnp.moveaxis(a.reshape(B, nb, Q_BLOCK, *a.shape[2:]), 1, 0)

    def blk(args):
        qb, qib, wib, start = args
        pos = start + jnp.arange(Q_BLOCK)
        return select_attend(qb, qib, wib, pos, k, v, ki)

    starts = jnp.arange(nb) * Q_BLOCK
    o = lax.map(blk, (to_blocks(q), to_blocks(qi), to_blocks(wi), starts))
    return jnp.moveaxis(o, 0, 1).reshape(B, T, N_HEADS * HEAD_DIM)


def short_conv(u, prev, w):
    T = u.shape[1]
    up = jnp.concatenate([prev, u], axis=1)
    out = w[0] * up[:, 0:T]
    for j in range(1, CONV_WIDTH):
        out = out + w[j] * up[:, j:j + T]
    return out, up[:, -(CONV_WIDTH - 1):]


def merge_out(o_attn, conv_out, bg, ga, gb, w_out):
    merged = jax.nn.sigmoid(ga) * o_attn + jax.nn.sigmoid(gb) * (bg * conv_out)
    return merged @ w_out


def ffn_and_ple(x, p, norm_ffn, w_gate_up, w_down, norm_ple, w_ple, w_ple_gate):
    h = rmsnorm(x, norm_ffn)
    gu = h @ w_gate_up
    g, u = gu[..., :D_FF], gu[..., D_FF:]
    x = x + (jax.nn.silu(g) * u) @ w_down
    gate = jax.nn.sigmoid(rmsnorm(x, norm_ple) @ w_ple_gate)
    return x + (p @ w_ple) * gate


def setup_inputs(seed: int = 0) -> dict:
    key = jax.random.key(seed)
    ks = jax.random.split(key, 24)
    f32 = jnp.float32
    n_pages = PAST_LEN // PAGE_SIZE
    n_used = DEC_BATCH * n_pages
    n_phys = n_used + -(-n_used // 4)
    nrm = lambda k, shape, s=1.0: jax.random.normal(k, shape, f32) * s
    page_table = jax.random.permutation(ks[0], n_phys)[:n_used].reshape(DEC_BATCH, n_pages).astype(jnp.int32)
    return {
        "x_prompt": nrm(ks[1], (BATCH, SEQ, D_MODEL)),
        "x_sample": nrm(ks[2], (DEC_BATCH, DEC_SEQ, D_MODEL)),
        "cache_k": nrm(ks[3], (DEPTH, n_phys, PAGE_SIZE, N_KV_HEADS, HEAD_DIM)),
        "cache_v": nrm(ks[4], (DEPTH, n_phys, PAGE_SIZE, N_KV_HEADS, HEAD_DIM)),
        "cache_kidx": nrm(ks[5], (DEPTH, n_phys, PAGE_SIZE, IDX_DIM)),
        "state_conv": nrm(ks[6], (DEPTH, DEC_BATCH, CONV_WIDTH - 1, D_CONV)),
        "page_table": page_table,
        "p_prompt": nrm(ks[7], (DEPTH, BATCH, SEQ, D_PLE)),
        "p_sample": nrm(ks[8], (DEPTH, DEC_BATCH, DEC_SEQ, D_PLE)),
        "norm_mix": 1.0 + nrm(ks[9], (DEPTH, D_MODEL), 0.01),
        "w_in": nrm(ks[10], (DEPTH, D_MODEL, D_IN_TOTAL), D_MODEL ** -0.5),
        "conv_w": nrm(ks[11], (DEPTH, CONV_WIDTH, D_CONV), CONV_WIDTH ** -0.5),
        "w_out": nrm(ks[12], (DEPTH, D_MODEL, D_MODEL), D_MODEL ** -0.5),
        "norm_ffn": 1.0 + nrm(ks[13], (DEPTH, D_MODEL), 0.01),
        "w_gate_up": nrm(ks[14], (DEPTH, D_MODEL, 2 * D_FF), D_MODEL ** -0.5),
        "w_down": nrm(ks[15], (DEPTH, D_FF, D_MODEL), D_FF ** -0.5),
        "norm_ple": 1.0 + nrm(ks[16], (DEPTH, D_MODEL), 0.01),
        "w_ple": nrm(ks[17], (DEPTH, D_PLE, D_MODEL), D_PLE ** -0.5),
        "w_ple_gate": nrm(ks[18], (DEPTH, D_MODEL, D_MODEL), D_MODEL ** -0.5),
        "norm_final": 1.0 + nrm(ks[19], (D_MODEL,), 0.01),
    }


def reference(x_prompt, x_sample, cache_k, cache_v, cache_kidx, state_conv, page_table,
              p_prompt, p_sample, norm_mix, w_in, conv_w, w_out, norm_ffn, w_gate_up, w_down,
              norm_ple, w_ple, w_ple_gate, norm_final):
    Bp, Tp = x_prompt.shape[:2]
    Bs, Ts = x_sample.shape[:2]
    past_len = page_table.shape[1] * PAGE_SIZE
    pos_p = jnp.arange(Tp)
    pos_s = past_len + jnp.arange(Ts)
    xp, xs = x_prompt, x_sample
    kp_l, vp_l, kip_l, cp_l = [], [], [], []
    ks_l, vs_l, kis_l, cs_l = [], [], [], []
    for l in range(DEPTH):
        h = rmsnorm(xp, norm_mix[l])
        q, k, v, qi, ki, wi, bg, cg, xc, ga, gb = mix_inputs(h, w_in[l], pos_p)
        o_a = prompt_attention(q, qi, wi, k, v, ki)
        conv_prev = jnp.zeros((Bp, CONV_WIDTH - 1, D_CONV), xp.dtype)
        conv_o, conv_new = short_conv(cg * xc, conv_prev, conv_w[l])
        xp = xp + merge_out(o_a, conv_o, bg, ga, gb, w_out[l])
        xp = ffn_and_ple(xp, p_prompt[l], norm_ffn[l], w_gate_up[l], w_down[l],
                         norm_ple[l], w_ple[l], w_ple_gate[l])
        kp_l.append(k); vp_l.append(v); kip_l.append(ki); cp_l.append(conv_new)

        h = rmsnorm(xs, norm_mix[l])
        q, k, v, qi, ki, wi, bg, cg, xc, ga, gb = mix_inputs(h, w_in[l], pos_s)
        past_k = cache_k[l][page_table].reshape(Bs, past_len, N_KV_HEADS, HEAD_DIM)
        past_v = cache_v[l][page_table].reshape(Bs, past_len, N_KV_HEADS, HEAD_DIM)
        past_ki = cache_kidx[l][page_table].reshape(Bs, past_len, IDX_DIM)
        k_all = jnp.concatenate([past_k, k], axis=1)
        v_all = jnp.concatenate([past_v, v], axis=1)
        ki_all = jnp.concatenate([past_ki, ki], axis=1)
        o_a = select_attend(q, qi, wi, pos_s, k_all, v_all, ki_all)
        conv_o, conv_new = short_conv(cg * xc, state_conv[l], conv_w[l])
        xs = xs + merge_out(o_a, conv_o, bg, ga, gb, w_out[l])
        xs = ffn_and_ple(xs, p_sample[l], norm_ffn[l], w_gate_up[l], w_down[l],
                         norm_ple[l], w_ple[l], w_ple_gate[l])
        ks_l.append(k); vs_l.append(v); kis_l.append(ki); cs_l.append(conv_new)

    y_prompt = rmsnorm(xp, norm_final)
    y_sample = rmsnorm(xs, norm_final)
    new_k_prompt = jnp.stack(kp_l)
    new_v_prompt = jnp.stack(vp_l)
    new_kidx_prompt = jnp.stack(kip_l)
    new_conv_prompt = jnp.stack(cp_l)
    new_k_sample = jnp.stack(ks_l)
    new_v_sample = jnp.stack(vs_l)
    new_kidx_sample = jnp.stack(kis_l)
    new_conv_sample = jnp.stack(cs_l)
    return (y_prompt, y_sample, new_k_prompt, new_v_prompt, new_kidx_prompt, new_conv_prompt,
            new_k_sample, new_v_sample, new_kidx_sample, new_conv_sample)
```

```cpp
#include <hip/hip_runtime.h>
#include <cstdio>
#include <cstdint>
#include <type_traits>

#ifndef MK_ONE_LAUNCH
#define MK_ONE_LAUNCH 1
#endif

__constant__ const unsigned int STREAM_SCHED[32 * 12] = {
    0x0100, 0x0120, 0x023a, 0x0250, 0x0266, 0x027e, 0x029e, 0x0003, 0x0012, 0x001a, 0x0400, 0x0408,
    0x0101, 0x0121, 0x023b, 0x0251, 0x0267, 0x027f, 0x029f, 0x0004, 0x0013, 0x001b, 0x0401, 0x0409,
    0x0102, 0x0200, 0x0300, 0x0268, 0x0280, 0x02a0, 0x0008, 0x030a, 0x040a, 0xffffu, 0xffffu, 0xffffu,
    0x0103, 0x0201, 0x0301, 0x0269, 0x0281, 0x02a1, 0x0009, 0x030b, 0x040b, 0xffffu, 0xffffu, 0xffffu,
    0x0104, 0x0202, 0x021e, 0x0302, 0x0282, 0x02a2, 0x000a, 0x030c, 0x040c, 0xffffu, 0xffffu, 0xffffu,
    0x0105, 0x0203, 0x021f, 0x0303, 0x0283, 0x02a3, 0x000b, 0x030d, 0x040d, 0xffffu, 0xffffu, 0xffffu,
    0x0106, 0x0204, 0x0220, 0x0304, 0x0284, 0x02a4, 0x000c, 0x030e, 0x040e, 0xffffu, 0xffffu, 0xffffu,
    0x0107, 0x0205, 0x0221, 0x0305, 0x0285, 0x02a5, 0x000d, 0x030f, 0x040f, 0xffffu, 0xffffu, 0xffffu,
    0x0108, 0x0206, 0x0222, 0x0306, 0x0286, 0x02a6, 0x000e, 0x0310, 0x0410, 0xffffu, 0xffffu, 0xffffu,
    0x0109, 0x0207, 0x0223, 0x0307, 0x0287, 0x02a7, 0x000f, 0x0311, 0x0411, 0xffffu, 0xffffu, 0xffffu,
    0x010a, 0x0208, 0x0224, 0x0308, 0x0288, 0x02a8, 0x0010, 0x0312, 0x0412, 0xffffu, 0xffffu, 0xffffu,
    0x010b, 0x0209, 0x0225, 0x0309, 0x0289, 0x02a9, 0x0011, 0x0313, 0x0413, 0xffffu, 0xffffu, 0xffffu,
    0x010c, 0x020a, 0x0226, 0x023c, 0x0252, 0x026a, 0x028a, 0x02aa, 0x0314, 0x0414, 0xffffu, 0xffffu,
    0x010d, 0x020b, 0x0227, 0x023d, 0x0253, 0x026b, 0x028b, 0x02ab, 0x0315, 0x0415, 0xffffu, 0xffffu,
    0x010e, 0x020c, 0x0228, 0x023e, 0x0254, 0x026c, 0x028c, 0x02ac, 0x0316, 0x0416, 0xffffu, 0xffffu,
    0x010f, 0x020d, 0x0229, 0x023f, 0x0255, 0x026d, 0x028d, 0x02ad, 0x0317, 0x0417, 0xffffu, 0xffffu,
    0x0110, 0x020e, 0x022a, 0x0240, 0x0256, 0x026e, 0x028e, 0x02ae, 0x0318, 0x0418, 0xffffu, 0xffffu,
    0x0111, 0x020f, 0x022b, 0x0241, 0x0257, 0x026f, 0x028f, 0x02af, 0x0319, 0x0419, 0xffffu, 0xffffu,
    0x0112, 0x0210, 0x022c, 0x0242, 0x0258, 0x0270, 0x0290, 0x02b0, 0x031a, 0x041a, 0xffffu, 0xffffu,
    0x0113, 0x0211, 0x022d, 0x0243, 0x0259, 0x0271, 0x0291, 0x02b1, 0x031b, 0x041b, 0xffffu, 0xffffu,
    0x0114, 0x0212, 0x022e, 0x0244, 0x025a, 0x0272, 0x0292, 0x02b2, 0x031c, 0x041c, 0xffffu, 0xffffu,
    0x0115, 0x0213, 0x022f, 0x0245, 0x025b, 0x0273, 0x0293, 0x02b3, 0x031d, 0x041d, 0xffffu, 0xffffu,
    0x0116, 0x0214, 0x0230, 0x0246, 0x025c, 0x0274, 0x0294, 0x02b4, 0x031e, 0x041e, 0xffffu, 0xffffu,
    0x0117, 0x0215, 0x0231, 0x0247, 0x025d, 0x0275, 0x0295, 0x02b5, 0x031f, 0x041f, 0xffffu, 0xffffu,
    0x0118, 0x0216, 0x0232, 0x0248, 0x025e, 0x0276, 0x0296, 0x02b6, 0x0320, 0x0420, 0xffffu, 0xffffu,
    0x0119, 0x0217, 0x0233, 0x0249, 0x025f, 0x0277, 0x0297, 0x02b7, 0x0321, 0x0421, 0xffffu, 0xffffu,
    0x011a, 0x0218, 0x0234, 0x024a, 0x0260, 0x0278, 0x0298, 0x02b8, 0x0017, 0x001f, 0x0405, 0xffffu,
    0x011b, 0x0219, 0x0235, 0x024b, 0x0261, 0x0279, 0x0299, 0x02b9, 0x0018, 0x0020, 0x0406, 0xffffu,
    0x011c, 0x021a, 0x0236, 0x024c, 0x0262, 0x027a, 0x029a, 0x02ba, 0x0019, 0x0021, 0x0407, 0xffffu,
    0x011d, 0x021b, 0x0237, 0x024d, 0x0263, 0x027b, 0x029b, 0x0000, 0x0005, 0x0014, 0x001c, 0x0402,
    0x011e, 0x021c, 0x0238, 0x024e, 0x0264, 0x027c, 0x029c, 0x0001, 0x0006, 0x0015, 0x001d, 0x0403,
    0x011f, 0x021d, 0x0239, 0x024f, 0x0265, 0x027d, 0x029d, 0x0002, 0x0007, 0x0016, 0x001e, 0x0404,
};
namespace pg8 {
#define PG8_LAS __attribute__((address_space(3)))
typedef unsigned short bf16_t;
typedef short bf16x8 __attribute__((ext_vector_type(8)));
typedef float f32x4 __attribute__((ext_vector_type(4)));
typedef unsigned u32x4 __attribute__((ext_vector_type(4)));
typedef unsigned u32x2 __attribute__((ext_vector_type(2)));
constexpr int BM = 256, BK = 64, HALF = 128, HTB = HALF * BK * 2, STAGE_BYTES = 8 * HTB, NXCD = 8, WGM = 8;

__host__ __device__ __forceinline__ int lds_byte(int r, int c) { const int st = (r >> 4) * 2 + (c >> 5), rr = r & 15, cc = c & 31, ob = rr * 64 + cc * 2; return st * 1024 + (ob ^ (((ob >> 9) & 1) << 5)); }
__host__ __device__ __forceinline__ void stage_rc(int b, int& R, int& C) { const int st = b / 1024, sb = b % 1024, swz = sb ^ (((sb >> 9) & 1) << 5); R = (st >> 1) * 16 + swz / 64; C = (st & 1) * 32 + (swz % 64) / 2; }

struct Unit { int pm, pn; };
#define PG8_GAS __attribute__((address_space(1)))
struct Gemm { const PG8_GAS bf16_t* A; const PG8_GAS bf16_t* Bt; int M, N, K; };

struct StaticOrder {
    int nM, nN, nwg, G, c;
    __host__ __device__ void init(int M, int N, int G_, int c_) { nM = M / BM; nN = N / BM; nwg = nM * nN; G = G_; c = c_; }
    __host__ __device__ bool next(int i, Unit& u) const {
        const long L = (long)i * G + c; if (L >= nwg) return false;
        int wgid = (int)L; { const int q = nwg / NXCD, r = nwg % NXCD, xcd = wgid % NXCD, off = wgid / NXCD; wgid = (xcd < r ? xcd * (q + 1) : r * (q + 1) + (xcd - r) * q) + off; }
        const int nig = WGM * nN, gid = wgid / nig, fm = gid * WGM, gsz = (nM - fm) < WGM ? (nM - fm) : WGM;
        u.pm = fm + ((wgid % nig) % gsz); u.pn = (wgid % nig) / gsz; return true;
    }
    __device__ __forceinline__ void a_ready(const Unit&) const {}
    __device__ __forceinline__ void done(const Unit&) const {}
};

typedef float f32x2c __attribute__((ext_vector_type(2)));
typedef __bf16 bf16x2c __attribute__((ext_vector_type(2)));
__device__ __forceinline__ unsigned cvt_pk_bf16(float lo, float hi) { const f32x2c v = {lo, hi}; const bf16x2c r = __builtin_convertvector(v, bf16x2c); return __builtin_bit_cast(unsigned, r); }

template <class Epi, class Sched, bool ALIGN_EPI = false, bool SP2 = false>
__device__ __forceinline__ void gemm_phase(PG8_LAS unsigned char* lds, const Gemm g, const Sched& S, const Epi& E, const int tid) {
    const int wid = __builtin_amdgcn_readfirstlane(tid >> 6), lane = tid & 63, wr = wid >> 2, wc = wid & 3, fr = lane & 15, fq = lane >> 4;
    const int K = g.K, nt = K / BK;
    unsigned voffA[2], voffB[2];
#pragma unroll
    for (int i = 0; i < 2; ++i) { int R, C; stage_rc(tid * 16 + i * 8192, R, C);
        voffA[i] = (unsigned)(R * K + C) * 2u; voffB[i] = (unsigned)(R * K + C) * 2u; }
    const size_t kstep = (size_t)(BK * 2);
    const size_t hstep = (size_t)HALF * K * 2;
    const size_t tstep = 2 * hstep;
    const unsigned ldsw = (unsigned)wid * 1024u;
    const int aoff = lds_byte(wr * 64 + fr, fq * 8), boff = lds_byte(wc * 32 + fr, fq * 8);
#define PG8_SA(b, h) (((b) * 2 + (h)) * HTB)
#define PG8_SB(b, h) ((4 + (b) * 2 + (h)) * HTB)
#define PG8_STAGE(bufoff, gbase, voff) do { _Pragma("unroll") for (int _i = 0; _i < 2; ++_i) \
        __builtin_amdgcn_global_load_lds((const PG8_GAS unsigned*)((gbase) + (voff)[_i]), (PG8_LAS unsigned*)(lds + (bufoff) + ldsw + _i * 8192), 16, 0, 0); } while (0)
#define PG8_LDA(dst, b, h) do { _Pragma("unroll") for (int m = 0; m < 4; ++m) _Pragma("unroll") for (int k = 0; k < 2; ++k) dst[m][k] = *(const PG8_LAS bf16x8*)(lds + PG8_SA(b, h) + aoff + m * 2048 + k * 1024); } while (0)
#define PG8_LDB(dst, b, h) do { _Pragma("unroll") for (int n = 0; n < 2; ++n) _Pragma("unroll") for (int k = 0; k < 2; ++k) dst[n][k] = *(const PG8_LAS bf16x8*)(lds + PG8_SB(b, h) + boff + n * 2048 + k * 1024); } while (0)
#define PG8_MMA(ai, bj, At, Bt) do { __builtin_amdgcn_s_setprio(1); _Pragma("unroll") for (int m = 0; m < 4; ++m) _Pragma("unroll") for (int n = 0; n < 2; ++n) _Pragma("unroll") for (int k = 0; k < 2; ++k) \
        acc[ai][bj][m][n] = __builtin_amdgcn_mfma_f32_16x16x32_bf16(Bt[n][k], At[m][k], acc[ai][bj][m][n], 0, 0, 0); __builtin_amdgcn_s_setprio(0); } while (0)
#define PG8_WAIT_V(n) asm volatile("s_waitcnt vmcnt(" #n ")" ::: "memory")
#define PG8_WAIT_L(n) asm volatile("s_waitcnt lgkmcnt(" #n ")" ::: "memory")
#define PG8_BAR __builtin_amdgcn_s_barrier()
#define PG8_SCHED __builtin_amdgcn_sched_barrier(0)
    Unit cur, nxt; int ui = 0;
    if (!S.next(0, cur)) return;
    f32x4 acc[2][2][4][2];
#pragma unroll
    for (int a = 0; a < 2; ++a)
#pragma unroll
        for (int b = 0; b < 2; ++b)
#pragma unroll
            for (int m = 0; m < 4; ++m)
#pragma unroll
                for (int n = 0; n < 2; ++n) acc[a][b][m][n] = (f32x4){0.f, 0.f, 0.f, 0.f};
    bf16x8 At[4][2], B0[2][2], B1[2][2];
    const PG8_GAS char* cA = (const PG8_GAS char*)g.A + (size_t)cur.pm * tstep; const PG8_GAS char* cB = (const PG8_GAS char*)g.Bt + (size_t)cur.pn * tstep;
    S.a_ready(cur);
    if constexpr (SP2) {
        PG8_STAGE(PG8_SB(0, 0), cB, voffB); PG8_STAGE(PG8_SB(0, 1), cB + hstep, voffB); PG8_STAGE(PG8_SA(0, 0), cA, voffA); PG8_STAGE(PG8_SA(0, 1), cA + hstep, voffA);
        if (wr == 1) PG8_BAR;
        PG8_WAIT_V(2); PG8_BAR;
        PG8_STAGE(PG8_SB(1, 0), cB + kstep, voffB); PG8_STAGE(PG8_SA(1, 0), cA + kstep, voffA); PG8_STAGE(PG8_SB(1, 1), cB + hstep + kstep, voffB);
        PG8_WAIT_V(6); PG8_BAR;
    } else {
        PG8_STAGE(PG8_SB(0, 0), cB, voffB); PG8_STAGE(PG8_SA(0, 0), cA, voffA); PG8_STAGE(PG8_SB(0, 1), cB + hstep, voffB); PG8_STAGE(PG8_SA(0, 1), cA + hstep, voffA);
        if (wr == 1) PG8_BAR;
        PG8_WAIT_V(4); PG8_BAR;
        PG8_STAGE(PG8_SB(1, 0), cB + kstep, voffB); PG8_STAGE(PG8_SA(1, 0), cA + kstep, voffA); PG8_STAGE(PG8_SB(1, 1), cB + hstep + kstep, voffB);
        PG8_WAIT_V(6); PG8_BAR;
    }
    for (;;) {
        const bool has_next = S.next(ui + 1, nxt);
        const PG8_GAS char* nA = has_next ? (const PG8_GAS char*)g.A + (size_t)nxt.pm * tstep : cA; const PG8_GAS char* nB = has_next ? (const PG8_GAS char*)g.Bt + (size_t)nxt.pn * tstep : cB;
        for (int t = 0; t < nt; t += 2) {
            const bool last = (t == nt - 2);
            const PG8_GAS char* a1 = cA + (size_t)(t + 1) * kstep;
            const PG8_GAS char* a2 = last ? nA : cA + (size_t)(t + 2) * kstep; const PG8_GAS char* b2 = last ? nB : cB + (size_t)(t + 2) * kstep;
            const PG8_GAS char* a3 = a2 + kstep; const PG8_GAS char* b3 = b2 + kstep;
            if (last && has_next) S.a_ready(nxt);
            if constexpr (SP2) {
            PG8_LDB(B0, 0, 0); PG8_LDB(B1, 0, 1); PG8_SCHED; PG8_LDA(At, 0, 0); PG8_STAGE(PG8_SA(1, 1), a1 + hstep, voffA);
            PG8_WAIT_V(8); PG8_WAIT_L(0); PG8_BAR; PG8_MMA(0, 0, At, B0); PG8_MMA(0, 1, At, B1); PG8_BAR; PG8_SCHED;
            PG8_LDA(At, 0, 1); PG8_STAGE(PG8_SB(0, 0), b2, voffB); PG8_STAGE(PG8_SB(0, 1), b2 + hstep, voffB); PG8_STAGE(PG8_SA(0, 0), a2, voffA);
            PG8_WAIT_V(8); PG8_WAIT_L(0); PG8_BAR; PG8_MMA(1, 0, At, B0); PG8_MMA(1, 1, At, B1); PG8_BAR; PG8_SCHED;
            PG8_LDB(B0, 1, 0); PG8_LDB(B1, 1, 1); PG8_SCHED; PG8_LDA(At, 1, 0); PG8_STAGE(PG8_SA(0, 1), a2 + hstep, voffA);
            PG8_WAIT_V(8); PG8_WAIT_L(0); PG8_BAR; PG8_MMA(0, 0, At, B0); PG8_MMA(0, 1, At, B1); PG8_BAR; PG8_SCHED;
            PG8_LDA(At, 1, 1); PG8_STAGE(PG8_SB(1, 0), b3, voffB); PG8_STAGE(PG8_SB(1, 1), b3 + hstep, voffB); PG8_STAGE(PG8_SA(1, 0), a3, voffA);
            PG8_WAIT_V(8); PG8_WAIT_L(0); PG8_BAR; PG8_MMA(1, 0, At, B0); PG8_MMA(1, 1, At, B1); PG8_BAR; PG8_SCHED;
            } else {
            PG8_LDB(B0, 0, 0); PG8_SCHED; PG8_LDA(At, 0, 0); PG8_STAGE(PG8_SA(1, 1), a1 + hstep, voffA);
            PG8_WAIT_L(8); PG8_BAR; PG8_WAIT_L(0); PG8_MMA(0, 0, At, B0); PG8_BAR; PG8_SCHED;
            PG8_LDB(B1, 0, 1); PG8_STAGE(PG8_SB(0, 0), b2, voffB);
            PG8_BAR; PG8_WAIT_L(0); PG8_MMA(0, 1, At, B1); PG8_BAR;
            PG8_LDA(At, 0, 1); PG8_STAGE(PG8_SA(0, 0), a2, voffA);
            PG8_BAR; PG8_WAIT_L(0); PG8_MMA(1, 0, At, B0); PG8_BAR; PG8_SCHED;
            PG8_STAGE(PG8_SB(0, 1), b2 + hstep, voffB);
            PG8_WAIT_V(6); PG8_BAR; PG8_MMA(1, 1, At, B1); PG8_BAR;
            PG8_LDB(B0, 1, 0); PG8_SCHED; PG8_LDA(At, 1, 0); PG8_STAGE(PG8_SA(0, 1), a2 + hstep, voffA);
            PG8_WAIT_L(8); PG8_BAR; PG8_WAIT_L(0); PG8_MMA(0, 0, At, B0); PG8_BAR; PG8_SCHED;
            PG8_LDB(B1, 1, 1); PG8_STAGE(PG8_SB(1, 0), b3, voffB);
            PG8_BAR; PG8_WAIT_L(0); PG8_MMA(0, 1, At, B1); PG8_BAR;
            PG8_LDA(At, 1, 1); PG8_STAGE(PG8_SA(1, 0), a3, voffA);
            PG8_BAR; PG8_WAIT_L(0); PG8_MMA(1, 0, At, B0); PG8_BAR; PG8_SCHED;
            PG8_STAGE(PG8_SB(1, 1), b3 + hstep, voffB);
            PG8_WAIT_V(6); PG8_BAR; PG8_MMA(1, 1, At, B1); PG8_BAR;
            }
        }
        if constexpr (ALIGN_EPI) { if (wr == 0) PG8_BAR; }
        E(acc, cur, wr, wc, fr, fq); S.done(cur);
        if (!has_next) break;
#pragma unroll
        for (int a = 0; a < 2; ++a)
#pragma unroll
            for (int b = 0; b < 2; ++b)
#pragma unroll
                for (int m = 0; m < 4; ++m)
#pragma unroll
                    for (int n = 0; n < 2; ++n) acc[a][b][m][n] = (f32x4){0.f, 0.f, 0.f, 0.f};
        cur = nxt; cA = nA; cB = nB; ++ui;
        if constexpr (ALIGN_EPI) { if (wr == 1) PG8_BAR; }
    }
    PG8_WAIT_V(0);
    if constexpr (!ALIGN_EPI) { if (wr == 0) PG8_BAR; }
    PG8_BAR;
#undef PG8_SA
#undef PG8_SB
#undef PG8_STAGE
#undef PG8_LDA
#undef PG8_LDB
#undef PG8_MMA
#undef PG8_WAIT_V
#undef PG8_WAIT_L
#undef PG8_BAR
#undef PG8_SCHED
}

__host__ __device__ __forceinline__ int perm32(int rho) { const int n = rho >> 4, i = rho & 15; return 8 * (i >> 2) + 4 * n + (i & 3); }
struct SUnit { int pm, pn, s; };
struct Stream {
    const PG8_GAS unsigned char* base; size_t A[5], Bt[5]; int nN[5], K[5], first[6], dep[5], need[5], pub[5];
    unsigned* cnt; int nM, G, c, need1_hi;
    __device__ __forceinline__ const PG8_GAS bf16_t* a_of(int s) const { return (const PG8_GAS bf16_t*)(base + (s == 0 ? A[0] : s == 1 ? A[1] : s == 2 ? A[2] : s == 3 ? A[3] : A[4])); }
    __device__ __forceinline__ const PG8_GAS bf16_t* b_of(int s) const { return (const PG8_GAS bf16_t*)(base + (s == 0 ? Bt[0] : s == 1 ? Bt[1] : s == 2 ? Bt[2] : s == 3 ? Bt[3] : Bt[4])); }
    __device__ __forceinline__ int k_of(int s) const { return s == 0 ? K[0] : s == 1 ? K[1] : s == 2 ? K[2] : s == 3 ? K[3] : K[4]; }
    __device__ __forceinline__ int nn_of(int s) const { return s == 0 ? nN[0] : s == 1 ? nN[1] : s == 2 ? nN[2] : s == 3 ? nN[3] : nN[4]; }
    __device__ __forceinline__ int dep_of(int s) const { return s == 0 ? dep[0] : s == 1 ? dep[1] : s == 2 ? dep[2] : s == 3 ? dep[3] : dep[4]; }
    __device__ __forceinline__ int need_of(int s) const { return s == 0 ? need[0] : s == 1 ? need[1] : s == 2 ? need[2] : s == 3 ? need[3] : need[4]; }
    __device__ __forceinline__ int need_for(const SUnit& u) const { return (u.s == 1 && u.pm >= 64) ? need1_hi : need_of(u.s); }
    __device__ __forceinline__ int pub_of(int s) const { return s == 0 ? pub[0] : s == 1 ? pub[1] : s == 2 ? pub[2] : s == 3 ? pub[3] : pub[4]; }
    __device__ __forceinline__ bool next(int i, SUnit& u) const {
        if (G == 256 && nM == 68) {
            if (i >= 12) return false;
            const unsigned e = STREAM_SCHED[(c >> 3) * 12 + i];
            if (e == 0xffffu) return false;
            const int s = (int)(e >> 8), j = (int)(e & 255u), x = c & 7, S = nn_of(s) >> 1;
            if (j < S) { const int g = x * S + j; u.pm = 64 + (g & 3); u.pn = g >> 2; }
            else if (s != 2) { const int jj = j - S; u.pm = 8 * x + (jj >> 2); u.pn = jj & 3; }
            else { const int jj = j - S;
                if (jj < 44) { u.pm = 8 * x + (jj & 1); u.pn = jj >> 1; } else { const int j2 = jj - 44; u.pm = 8 * x + 2 + j2 % 6; u.pn = j2 / 6; } }
            u.s = s; return true;
        }
        const int L = i * G + c; if (L >= first[5]) return false;
        const int s = (L >= first[1]) + (L >= first[2]) + (L >= first[3]) + (L >= first[4]);
        const int f = s == 0 ? first[0] : s == 1 ? first[1] : s == 2 ? first[2] : s == 3 ? first[3] : first[4];
        const int nn = nn_of(s), nwg = nM * nn; int wgid = L - f;
        { const int q = nwg / NXCD, r = nwg % NXCD, xcd = wgid % NXCD, off = wgid / NXCD; wgid = (xcd < r ? xcd * (q + 1) : r * (q + 1) + (xcd - r) * q) + off; }
        const int nig = WGM * nn, gid = wgid / nig, fm = gid * WGM, gsz = (nM - fm) < WGM ? (nM - fm) : WGM;
        u.pm = fm + ((wgid % nig) % gsz); u.pn = (wgid % nig) / gsz; u.s = s; return true;
    }
    __device__ __forceinline__ void wait_ready(const SUnit& u, int tid) const {
        const int d = dep_of(u.s);
        if (d < 0) return;
        if (tid < 64) {
            unsigned* w = cnt + (size_t)(d * 128 + u.pm) * 64; const unsigned need_ = (unsigned)need_for(u); unsigned polls = 0;
            while ((unsigned)__builtin_amdgcn_readfirstlane(__hip_atomic_load(w, __ATOMIC_RELAXED, __HIP_MEMORY_SCOPE_AGENT)) < need_) {
                if (++polls > (1u << 18)) break;
                __builtin_amdgcn_s_sleep(2); }
            __builtin_amdgcn_fence(__ATOMIC_ACQUIRE, "agent");
            asm volatile("s_waitcnt vmcnt(0)" ::: "memory");
        }
        asm volatile("" ::: "memory"); __builtin_amdgcn_s_barrier(); asm volatile("" ::: "memory");
    }
    __device__ __forceinline__ bool try_ready(const SUnit& u, int tid, volatile PG8_LAS unsigned* flag) const {
        const int d = dep_of(u.s);
        if (d < 0) return true;
        if (tid < 64) {
            unsigned* w = cnt + (size_t)(d * 128 + u.pm) * 64;
            const bool ok = (unsigned)__builtin_amdgcn_readfirstlane(__hip_atomic_load(w, __ATOMIC_RELAXED, __HIP_MEMORY_SCOPE_AGENT)) >= (unsigned)need_for(u);
            if (ok) { __builtin_amdgcn_fence(__ATOMIC_ACQUIRE, "agent"); asm volatile("s_waitcnt vmcnt(0)" ::: "memory"); }
            if (tid == 0) *flag = ok ? 1u : 0u;
            asm volatile("s_waitcnt lgkmcnt(0)" ::: "memory");
        }
        asm volatile("" ::: "memory"); __builtin_amdgcn_s_barrier(); asm volatile("" ::: "memory");
        return *flag != 0u;
    }
    __device__ __forceinline__ void done(const SUnit& u, int lane) const {
        const int p = pub_of(u.s);
        if (p < 0) return;
        asm volatile("s_waitcnt vmcnt(0)" ::: "memory");
        if (lane == 0) __hip_atomic_fetch_add(cnt + (size_t)(p * 128 + u.pm) * 64, 1u, __ATOMIC_RELAXED, __HIP_MEMORY_SCOPE_AGENT);
    }
};

template <class EpiSet>
__device__ __forceinline__ void gemm_stream(PG8_LAS unsigned char* lds, const Stream& S, const EpiSet& E, const int tid, volatile PG8_LAS unsigned* flag) {
    const int wid = __builtin_amdgcn_readfirstlane(tid >> 6), lane = tid & 63, wr = wid >> 2, wc = wid & 3, fr = lane & 15, fq = lane >> 4;
    int SR[2], SC[2];
#pragma unroll
    for (int i = 0; i < 2; ++i) stage_rc(tid * 16 + i * 8192, SR[i], SC[i]);
    const int SRb[2] = {(SR[0] & ~31) + perm32(SR[0] & 31), (SR[1] & ~31) + perm32(SR[1] & 31)};
    const size_t kstep = (size_t)(BK * 2);
    const unsigned ldsw = (unsigned)wid * 1024u;
    const int aoff = lds_byte(wr * 64 + fr, fq * 8), boff = lds_byte(wc * 32 + fr, fq * 8);
#define PG8_SA(b, h) (((b) * 2 + (h)) * HTB)
#define PG8_SB(b, h) ((4 + (b) * 2 + (h)) * HTB)
#define PG8_STAGE(bufoff, gbase, voff) do { _Pragma("unroll") for (int _i = 0; _i < 2; ++_i) \
        __builtin_amdgcn_global_load_lds((const PG8_GAS unsigned*)((gbase) + (voff)[_i]), (PG8_LAS unsigned*)(lds + (bufoff) + ldsw + _i * 8192), 16, 0, 0); } while (0)
#define PG8_LDA(dst, b, h) do { _Pragma("unroll") for (int m = 0; m < 4; ++m) _Pragma("unroll") for (int k = 0; k < 2; ++k) dst[m][k] = *(const PG8_LAS bf16x8*)(lds + PG8_SA(b, h) + aoff + m * 2048 + k * 1024); } while (0)
#define PG8_LDB(dst, b, h) do { _Pragma("unroll") for (int n = 0; n < 2; ++n) _Pragma("unroll") for (int k = 0; k < 2; ++k) dst[n][k] = *(const PG8_LAS bf16x8*)(lds + PG8_SB(b, h) + boff + n * 2048 + k * 1024); } while (0)
#define PG8_MMA(ai, bj, At, Bt) do { __builtin_amdgcn_s_setprio(1); _Pragma("unroll") for (int m = 0; m < 4; ++m) _Pragma("unroll") for (int n = 0; n < 2; ++n) _Pragma("unroll") for (int k = 0; k < 2; ++k) \
        acc[ai][bj][m][n] = __builtin_amdgcn_mfma_f32_16x16x32_bf16(Bt[n][k], At[m][k], acc[ai][bj][m][n], 0, 0, 0); __builtin_amdgcn_s_setprio(0); } while (0)
#define PG8_WAIT_V(n) asm volatile("s_waitcnt vmcnt(" #n ")" ::: "memory")
#define PG8_WAIT_L(n) asm volatile("s_waitcnt lgkmcnt(" #n ")" ::: "memory")
#define PG8_BAR __builtin_amdgcn_s_barrier()
#define PG8_SCHED __builtin_amdgcn_sched_barrier(0)
    SUnit cur, nxt; int ui = 0;
    if (!S.next(0, cur)) return;
    f32x4 acc[2][2][4][2];
#pragma unroll
    for (int a = 0; a < 2; ++a)
#pragma unroll
        for (int b = 0; b < 2; ++b)
#pragma unroll
            for (int m = 0; m < 4; ++m)
#pragma unroll
                for (int n = 0; n < 2; ++n) acc[a][b][m][n] = (f32x4){0.f, 0.f, 0.f, 0.f};
    bf16x8 At[4][2], B0[2][2], B1[2][2];
    for (;;) {
        int K = S.k_of(cur.s);
        size_t hstep = (size_t)HALF * K * 2;
        unsigned voff[2] = {(unsigned)(SR[0] * K + SC[0]) * 2u, (unsigned)(SR[1] * K + SC[1]) * 2u};
        unsigned voffB[2] = {(unsigned)(SRb[0] * K + SC[0]) * 2u, (unsigned)(SRb[1] * K + SC[1]) * 2u};
        const PG8_GAS char* cA = (const PG8_GAS char*)S.a_of(cur.s) + (size_t)cur.pm * 2 * hstep; const PG8_GAS char* cB = (const PG8_GAS char*)S.b_of(cur.s) + (size_t)cur.pn * 2 * hstep;
        S.wait_ready(cur, tid);
        PG8_STAGE(PG8_SB(0, 0), cB, voffB); PG8_STAGE(PG8_SB(0, 1), cB + hstep, voffB); PG8_STAGE(PG8_SA(0, 0), cA, voff); PG8_STAGE(PG8_SA(0, 1), cA + hstep, voff);
        if (wr == 1) PG8_BAR;
        PG8_WAIT_V(2); PG8_BAR;
        PG8_STAGE(PG8_SB(1, 0), cB + kstep, voffB); PG8_STAGE(PG8_SA(1, 0), cA + kstep, voff); PG8_STAGE(PG8_SB(1, 1), cB + hstep + kstep, voffB);
        PG8_WAIT_V(6); PG8_BAR;
        bool finished = false;
        for (;;) {
            const bool has_next = S.next(ui + 1, nxt);
            bool chain = has_next;
            const int Kn = has_next ? S.k_of(nxt.s) : K;
            const size_t hstep_n = (size_t)HALF * Kn * 2;
            const unsigned voffn[2] = {(unsigned)(SR[0] * Kn + SC[0]) * 2u, (unsigned)(SR[1] * Kn + SC[1]) * 2u};
            const unsigned voffBn[2] = {(unsigned)(SRb[0] * Kn + SC[0]) * 2u, (unsigned)(SRb[1] * Kn + SC[1]) * 2u};
            const PG8_GAS char* nA = has_next ? (const PG8_GAS char*)S.a_of(nxt.s) + (size_t)nxt.pm * 2 * hstep_n : cA;
            const PG8_GAS char* nB = has_next ? (const PG8_GAS char*)S.b_of(nxt.s) + (size_t)nxt.pn * 2 * hstep_n : cB;
            const int nt = K / BK;
            for (int t = 0; t < nt; t += 2) {
                const bool last = (t == nt - 2);
                if (last && has_next) chain = S.try_ready(nxt, tid, flag);
                const bool usen = last && chain;
                const PG8_GAS char* a1 = cA + (size_t)(t + 1) * kstep;
                const PG8_GAS char* a2 = last ? (chain ? nA : cA) : cA + (size_t)(t + 2) * kstep; const PG8_GAS char* b2 = last ? (chain ? nB : cB) : cB + (size_t)(t + 2) * kstep;
                const PG8_GAS char* a3 = a2 + kstep; const PG8_GAS char* b3 = b2 + kstep;
                const size_t h2 = usen ? hstep_n : hstep;
                const unsigned v2[2] = {usen ? voffn[0] : voff[0], usen ? voffn[1] : voff[1]};
                const unsigned v2B[2] = {usen ? voffBn[0] : voffB[0], usen ? voffBn[1] : voffB[1]};
                PG8_LDB(B0, 0, 0); PG8_LDB(B1, 0, 1); PG8_SCHED; PG8_LDA(At, 0, 0); PG8_STAGE(PG8_SA(1, 1), a1 + hstep, voff);
                PG8_WAIT_V(8); PG8_WAIT_L(0); PG8_BAR; PG8_MMA(0, 0, At, B0); PG8_MMA(0, 1, At, B1); PG8_BAR; PG8_SCHED;
                PG8_LDA(At, 0, 1); PG8_STAGE(PG8_SB(0, 0), b2, v2B); PG8_STAGE(PG8_SB(0, 1), b2 + h2, v2B); PG8_STAGE(PG8_SA(0, 0), a2, v2);
                PG8_WAIT_V(8); PG8_WAIT_L(0); PG8_BAR; PG8_MMA(1, 0, At, B0); PG8_MMA(1, 1, At, B1); PG8_BAR; PG8_SCHED;
                PG8_LDB(B0, 1, 0); PG8_LDB(B1, 1, 1); PG8_SCHED; PG8_LDA(At, 1, 0); PG8_STAGE(PG8_SA(0, 1), a2 + h2, v2);
                PG8_WAIT_V(8); PG8_WAIT_L(0); PG8_BAR; PG8_MMA(0, 0, At, B0); PG8_MMA(0, 1, At, B1); PG8_BAR; PG8_SCHED;
                PG8_LDA(At, 1, 1); PG8_STAGE(PG8_SB(1, 0), b3, v2B); PG8_STAGE(PG8_SB(1, 1), b3 + h2, v2B); PG8_STAGE(PG8_SA(1, 0), a3, v2);
                PG8_WAIT_V(8); PG8_WAIT_L(0); PG8_BAR; PG8_MMA(1, 0, At, B0); PG8_MMA(1, 1, At, B1); PG8_BAR; PG8_SCHED;
            }
            if (wr == 0) PG8_BAR;
            E(acc, cur, wr, wc, fr, fq); S.done(cur, lane);
            if (!has_next) { finished = true; break; }
#pragma unroll
            for (int a = 0; a < 2; ++a)
#pragma unroll
                for (int b = 0; b < 2; ++b)
#pragma unroll
                    for (int m = 0; m < 4; ++m)
#pragma unroll
                        for (int n = 0; n < 2; ++n) acc[a][b][m][n] = (f32x4){0.f, 0.f, 0.f, 0.f};
            cur = nxt; ++ui;
            if (!chain) break;
            cA = nA; cB = nB; K = Kn; hstep = hstep_n; voff[0] = voffn[0]; voff[1] = voffn[1]; voffB[0] = voffBn[0]; voffB[1] = voffBn[1];
            if (wr == 1) PG8_BAR;
        }
        PG8_WAIT_V(0);
        PG8_BAR;
        if (finished) break;
    }
#undef PG8_SA
#undef PG8_SB
#undef PG8_STAGE
#undef PG8_LDA
#undef PG8_LDB
#undef PG8_MMA
#undef PG8_WAIT_V
#undef PG8_WAIT_L
#undef PG8_BAR
#undef PG8_SCHED
}
}

constexpr int D = 1024, BP = 4, TP = 4096, MP = BP * TP, BS = 128, TS = 8, MS = BS * TS, M = MP + MS;
constexpr int PAST = 2048, PAGE = 128, NPG = PAST / PAGE;
constexpr int NH = 8, NKV = 2, HD = 128, NIH = 8, DI = 64, DFF = 2816, DPLE = 256;
constexpr int NIN = 29 * 256;
constexpr int NGU = 2 * DFF;
constexpr float EPS = 1e-6f;
constexpr float IDX_SCALE = 0.044194173824159216f;
constexpr int LMAX = 4096;
constexpr int OQ = 0, OK_ = 1024, OV = 1280, OQI = 1536, OKI = 2048, OWI = 2112, OBG = 2120, OCG = 3144, OXC = 4168, OGA = 5192, OGB = 6216, DIN = 7240;
constexpr size_t O_Y = 0, O_KP = 17825792, O_VP = 22020096, O_KIP = 26214400, O_CP = 27262976, O_KS = 27271168, O_VS = 27533312, O_KIS = 27795456, O_CS = 27860992, O_END = 28123136;

constexpr size_t MiB = 1u << 20;
constexpr size_t WS_CTL = 0, CTL_ZERO_BYTES = 1 * MiB;
constexpr size_t WS_WIN = 2 * MiB, WS_WOUT = 18 * MiB, WS_WGU = 20 * MiB, WS_WDN = 32 * MiB, WS_WPLE = 38 * MiB, WS_WPG = 39 * MiB;
constexpr size_t WS_CS128 = 41 * MiB, WS_CS64 = 43 * MiB;
constexpr size_t WS_X3B = 512 * MiB;
constexpr size_t WS_HB = 44 * MiB, WS_QB = 78 * MiB, WS_KB = 112 * MiB, WS_VB = 121 * MiB, WS_QIB = 130 * MiB, WS_KIB = 147 * MiB, WS_WI = 150 * MiB;
constexpr size_t WS_UB = 151 * MiB, WS_BG = 185 * MiB, WS_SGA = 219 * MiB, WS_MASK = 253 * MiB, WS_MERGED = 262 * MiB, WS_X1B = 296 * MiB;
constexpr size_t WS_PART1 = 330 * MiB, WS_PART2 = 332 * MiB, WS_PART3 = 334 * MiB, WS_ACT = 336 * MiB, WS_X2B = 430 * MiB, WS_PB = 464 * MiB, WS_PW = 473 * MiB;
constexpr size_t WS_SCORES = 512 * MiB, WS_END = 784 * MiB;
constexpr int CW_BAR = 4096;
constexpr int CW_Q = 16384;
constexpr int CW_DEP = 32768;
constexpr int NPHASE = 6;

#define GAS __attribute__((address_space(1)))
#define LAS __attribute__((address_space(3)))
typedef unsigned short bf16;
typedef unsigned v4u __attribute__((ext_vector_type(4)));
typedef unsigned v2u __attribute__((ext_vector_type(2)));
typedef float f32x4 __attribute__((ext_vector_type(4)));
typedef float f32x8 __attribute__((ext_vector_type(8)));
typedef float f32x16 __attribute__((ext_vector_type(16)));
typedef short bf16x8 __attribute__((ext_vector_type(8)));
typedef short s16x4 __attribute__((ext_vector_type(4)));
typedef GAS unsigned gu32;
#define RLX_AGENT __ATOMIC_RELAXED, __HIP_MEMORY_SCOPE_AGENT
#define LDS_WAIT() asm volatile("s_waitcnt lgkmcnt(0)" ::: "memory")
#define VM_WAIT() asm volatile("s_waitcnt vmcnt(0)" ::: "memory")
#define SBAR() __builtin_amdgcn_sched_barrier(0)
__device__ __forceinline__ unsigned cvtpk(float lo, float hi) { return pg8::cvt_pk_bf16(lo, hi); }
__device__ __forceinline__ float bf2f(unsigned short b) { return __uint_as_float(((unsigned)b) << 16); }
__device__ __forceinline__ float sigmoidf_fast(float x) { return __builtin_amdgcn_rcpf(1.0f + __builtin_amdgcn_exp2f(-1.4426950408889634f * x)); }
__device__ __forceinline__ float wave_sum(float v) {
#pragma unroll
    for (int o = 1; o < 64; o <<= 1) v += __shfl_xor(v, o);
    return v;
}
__device__ __forceinline__ int wave_sum_dpp(int v) {
    v += __builtin_amdgcn_update_dpp(0, v, 0x111, 0xf, 0xf, true);
    v += __builtin_amdgcn_update_dpp(0, v, 0x112, 0xf, 0xf, true);
    v += __builtin_amdgcn_update_dpp(0, v, 0x114, 0xf, 0xf, true);
    v += __builtin_amdgcn_update_dpp(0, v, 0x118, 0xf, 0xf, true);
    v += __builtin_amdgcn_update_dpp(0, v, 0x142, 0xa, 0xf, true);
    v += __builtin_amdgcn_update_dpp(0, v, 0x143, 0xc, 0xf, true);
    return __builtin_amdgcn_readlane(v, 63);
}
__device__ __forceinline__ unsigned wave_max_dpp(unsigned v) {
    unsigned t;
    t = (unsigned)__builtin_amdgcn_update_dpp(0, (int)v, 0x111, 0xf, 0xf, true); v = v > t ? v : t;
    t = (unsigned)__builtin_amdgcn_update_dpp(0, (int)v, 0x112, 0xf, 0xf, true); v = v > t ? v : t;
    t = (unsigned)__builtin_amdgcn_update_dpp(0, (int)v, 0x114, 0xf, 0xf, true); v = v > t ? v : t;
    t = (unsigned)__builtin_amdgcn_update_dpp(0, (int)v, 0x118, 0xf, 0xf, true); v = v > t ? v : t;
    t = (unsigned)__builtin_amdgcn_update_dpp(0, (int)v, 0x142, 0xa, 0xf, true); v = v > t ? v : t;
    t = (unsigned)__builtin_amdgcn_update_dpp(0, (int)v, 0x143, 0xc, 0xf, true); v = v > t ? v : t;
    return (unsigned)__builtin_amdgcn_readlane((int)v, 63);
}
__device__ __forceinline__ int wave_sum_i(int v) {
#pragma unroll
    for (int o = 1; o < 64; o <<= 1) v += __shfl_xor(v, o);
    return v;
}

#define XB_TMO      128
#define XB_XCNT(j)  (256  + 64 * (j))
#define XB_XSUB(j)  (1280 + 64 * (j))
#define XB_XGEN(j)  (2304 + 64 * (j))
#define XB_TOP      3328
#define XB_TOPGEN   3392
#define XCD_BAR_WORDS 3456
#define XB_SPIN_CAP (1u << 18)
__device__ __forceinline__ unsigned xb_ld(unsigned* p)              { return __hip_atomic_load(p, __ATOMIC_RELAXED, __HIP_MEMORY_SCOPE_AGENT); }
__device__ __forceinline__ unsigned xb_add(unsigned* p, unsigned v) { return __hip_atomic_fetch_add(p, v, __ATOMIC_RELAXED, __HIP_MEMORY_SCOPE_AGENT); }
__device__ __forceinline__ unsigned xb_xcc_id() { return (unsigned)__builtin_amdgcn_s_getreg((3 << 11) | 20) & 0xFu; }
#define XB_SPIN(cond, bar) do { unsigned _sp = 0; while (cond) { __builtin_amdgcn_s_sleep(1); \
    if ((++_sp & 255u) == 0u) { if (xb_ld(&(bar)[XB_TMO])) break; if (_sp > XB_SPIN_CAP) { atomicAdd(&(bar)[XB_TMO], 1u); break; } } } } while (0)
struct XcdBarrier { unsigned* bar; unsigned x; volatile LAS unsigned* st; };
__device__ __forceinline__ XcdBarrier xcd_barrier_post(unsigned* bar, volatile LAS unsigned* st, int tid) {
    XcdBarrier b; b.bar = bar; b.x = xb_xcc_id(); b.st = st;
    if (tid == 0) (void)xb_add(&bar[XB_XCNT(b.x)], 1u);
    return b;
}
__device__ __forceinline__ void xcd_barrier_complete(unsigned* bar, unsigned x, unsigned& nloc, unsigned& nx) {
    const unsigned G = gridDim.x * gridDim.y * gridDim.z;
    unsigned sum, cnt, mine, sp = 0u;
    for (;;) {
        sum = 0u; cnt = 0u; mine = 0u;
#pragma unroll
        for (unsigned j = 0; j < 16; ++j) { const unsigned c = xb_ld(&bar[XB_XCNT(j)]); sum += c; cnt += (c > 0u) ? 1u : 0u; mine = (j == x) ? c : mine; }
        if (sum == G) break;
        __builtin_amdgcn_s_sleep(1);
        if ((++sp & 255u) == 0u) { if (xb_ld(&bar[XB_TMO])) break; if (sp > XB_SPIN_CAP) { atomicAdd(&bar[XB_TMO], 1u); break; } }
    }
    nloc = mine > 0u ? mine : 1u; nx = cnt > 0u ? cnt : 1u;
}
__device__ __forceinline__ void xcd_barrier(const XcdBarrier& b, int tid) {
    asm volatile("s_waitcnt vmcnt(0)" ::: "memory");
    __syncthreads();
    if (tid == 0) {
        unsigned* bar = b.bar;
        __builtin_amdgcn_s_waitcnt(0);
        unsigned nloc = b.st[0], nx = b.st[1];
        if (nloc == 0u) { xcd_barrier_complete(bar, b.x, nloc, nx); b.st[0] = nloc; b.st[1] = nx; }
        const unsigned old = xb_add(&bar[XB_XSUB(b.x)], 1u);
        const unsigned gen = old / nloc;
        if (old + 1u == (gen + 1u) * nloc) {
            __builtin_amdgcn_fence(__ATOMIC_RELEASE, "agent");
            asm volatile("s_waitcnt vmcnt(0)" ::: "memory");
            const unsigned og = xb_add(&bar[XB_TOP], 1u);
            const unsigned tg = og / nx;
            if (og + 1u == (tg + 1u) * nx) xb_add(&bar[XB_TOPGEN], 1u);
            else XB_SPIN(xb_ld(&bar[XB_TOPGEN]) == tg, bar);
            __builtin_amdgcn_fence(__ATOMIC_ACQUIRE, "agent");
            xb_add(&bar[XB_XGEN(b.x)], 1u);
            asm volatile("s_waitcnt vmcnt(0)" ::: "memory");
        } else {
            XB_SPIN(xb_ld(&bar[XB_XGEN(b.x)]) == gen, bar);
            __builtin_amdgcn_fence(__ATOMIC_ACQUIRE, "agent");
            asm volatile("s_waitcnt vmcnt(0)" ::: "memory");
        }
    }
    __syncthreads();
}

constexpr int RING_OFF = 0, RING_BYTES = 131072;
constexpr int CW_MSK = 100000;
constexpr int LDSCTL_OFF = RING_BYTES, MISC_OFF = LDSCTL_OFF + 320;
constexpr int LDS_BYTES = 163840;
constexpr int NWAVES = 8;

struct Args { const void* in[20]; float* out; unsigned char* ws; int ph_lo, ph_hi, qoff, pad; };

struct Frame {
    LAS unsigned char* lds;
    volatile LAS unsigned* MISC;
    gu32* ctl;
    int tid, lane, wave, G, qoff;
    GAS unsigned char* ws; GAS float* out;
};
typedef __attribute__((address_space(4))) const unsigned long long karg_t;
__device__ __forceinline__ karg_t* kargs() { karg_t* p = (karg_t*)__builtin_amdgcn_kernarg_segment_ptr(); asm volatile("" : "+s"(p)); return p; }
#define INPTR(T, kp, i) ((const GAS T*)(kp)[i])
enum { I_XP = 0, I_XS, I_CK, I_CV, I_CKI, I_SC, I_PT, I_PP, I_PS, I_NMIX, I_WIN, I_CONVW, I_WOUT, I_NFFN, I_WGU, I_WDN, I_NPLE, I_WPLE, I_WPG, I_NFIN };
__device__ __forceinline__ int row_pos(int m) { return m < MP ? (m & (TP - 1)) : PAST + (m & (TS - 1)); }

__device__ __forceinline__ int lane_opaque() { int l = (int)__builtin_amdgcn_mbcnt_hi(~0u, __builtin_amdgcn_mbcnt_lo(~0u, 0u)); asm volatile("" : "+v"(l)); return l; }
__device__ __forceinline__ int wq_next(Frame& F, int q) {
    __syncthreads();
    if (F.tid == 0) F.MISC[16] = __hip_atomic_fetch_add((unsigned*)(F.ctl + CW_Q + 64 * (q + F.qoff)), 1u, RLX_AGENT);
    __syncthreads();
    return (int)F.MISC[16];
}

__device__ __forceinline__ int in_src_col(int p) {
    const int tile = p >> 8, q = p & 255, bj = q >> 7, w = q & 127;
    if (tile < 4) return OQ + (2 * tile + (w >> 6)) * 128 + 64 * bj + (w & 63);
    if (tile == 4) return OK_ + (w >> 6) * 128 + 64 * bj + (w & 63);
    if (tile == 5) return OV + q;
    if (tile < 8) return OQI + (4 * (tile - 6) + (w >> 5)) * 64 + 32 * bj + (w & 31);
    if (tile == 8) { if (w < 32) return OKI + 32 * bj + w; if (bj == 0 && w < 40) return OWI + (w - 32); return -1; }
    if (tile < 17) return (bj ? OXC : OCG) + 128 * (tile - 9) + w;
    if (tile < 25) return (bj ? OGB : OBG) + 128 * (tile - 17) + w;
    return OGA + 256 * (tile - 25) + q;
}
__device__ __forceinline__ int gu_src_col(int p) { const int tile = p >> 8, q = p & 255; return q < 128 ? 128 * tile + q : DFF + 128 * tile + (q - 128); }

template <int MAP>
__device__ __forceinline__ void p0_transpose_item(const GAS float* W, int Nsrc, int K, int Nphys, GAS bf16* WT, const GAS float* kscale, LAS float* scr, int item, int lane) {
    const int nblk = Nphys / 32, kb = item / nblk, nb = item % nblk, k0 = 64 * kb, n0 = 32 * nb;
    const int r8 = lane >> 3, c4 = (lane & 7) * 4, p = n0 + c4;
    const int sc = MAP == 0 ? p : (MAP == 1 ? in_src_col(p) : gu_src_col(p));
#pragma unroll
    for (int i = 0; i < 8; ++i) { const int kk = 8 * i + r8;
        f32x4 v = f32x4{0.f, 0.f, 0.f, 0.f}; if (sc >= 0) v = *(const GAS f32x4*)(W + (size_t)(k0 + kk) * Nsrc + sc);
        if (kscale) v = v * kscale[k0 + kk];
        LAS float* d = scr + kk * 33 + c4; d[0] = v.x; d[1] = v.y; d[2] = v.z; d[3] = v.w; }
    LDS_WAIT(); asm volatile("" ::: "memory");
    const int c = lane & 7;
#pragma unroll
    for (int j = 0; j < 4; ++j) { const int n = (lane >> 3) + 8 * j; const LAS float* s = scr + (8 * c) * 33 + n;
        v4u o; o.x = cvtpk(s[0 * 33], s[1 * 33]); o.y = cvtpk(s[2 * 33], s[3 * 33]); o.z = cvtpk(s[4 * 33], s[5 * 33]); o.w = cvtpk(s[6 * 33], s[7 * 33]);
        *(GAS v4u*)(WT + (size_t)(n0 + n) * K + k0 + 8 * c) = o; }
    LDS_WAIT(); asm volatile("" ::: "memory");
}
__device__ __forceinline__ void sincos_d(double x, double& s, double& c) {
    const double k = __builtin_rint(x * 0.63661977236758134308);
    double r = __builtin_fma(-k, 1.57079632679489655800e+00, x); r = __builtin_fma(-k, 6.12323399573676603587e-17, r);
    const double r2 = r * r;
    double sp = -7.6471637318198164759e-13; sp = sp * r2 + 1.6059043836821614599e-10; sp = sp * r2 - 2.5052108385441718775e-08; sp = sp * r2 + 2.7557319223985890653e-06;
    sp = sp * r2 - 1.9841269841269841270e-04; sp = sp * r2 + 8.3333333333333333333e-03; sp = sp * r2 - 1.6666666666666666667e-01; const double sr = r + r * r2 * sp;
    double cp = 4.7794773323873852974e-14; cp = cp * r2 - 1.1470745597729724714e-11; cp = cp * r2 + 2.0876756987868098979e-09; cp = cp * r2 - 2.7557319223985890653e-07;
    cp = cp * r2 + 2.4801587301587301587e-05; cp = cp * r2 - 1.3888888888888888889e-03; cp = cp * r2 + 4.1666666666666666667e-02; cp = cp * r2 - 0.5; const double cr = 1.0 + r2 * cp;
    const int q = ((int)k) & 3;
    s = (q == 0) ? sr : (q == 1) ? cr : (q == 2) ? -sr : -cr;
    c = (q == 0) ? cr : (q == 1) ? -sr : (q == 2) ? -cr : sr;
}
__device__ __forceinline__ void p0_prologue(Frame& F) {
    LAS float* scr = (LAS float*)(F.lds + RING_OFF + F.wave * 16384);
    const int gw = blockIdx.x * NWAVES + F.wave, NGW = F.G * NWAVES, lane = F.lane;
    GAS unsigned char* ws = F.ws; karg_t* kp = kargs();
    constexpr int I_IN = (D / 64) * (NIN / 32), I_OUT = (D / 64) * (D / 32), I_GU = (D / 64) * (NGU / 32), I_DN = (DFF / 64) * (D / 32), I_PLE = (DPLE / 64) * (D / 32), I_PG = I_OUT;
    constexpr int NITEMS = I_IN + I_OUT + I_GU + I_DN + I_PLE + I_PG;
    for (int it = gw; it < NITEMS; it += NGW) {
        int r = it;
        if (r < I_IN) { p0_transpose_item<1>(INPTR(float, kp, I_WIN), DIN, D, NIN, (GAS bf16*)(ws + WS_WIN), nullptr, scr, r, lane); continue; } r -= I_IN;
        if (r < I_OUT) { p0_transpose_item<0>(INPTR(float, kp, I_WOUT), D, D, D, (GAS bf16*)(ws + WS_WOUT), nullptr, scr, r, lane); continue; } r -= I_OUT;
        if (r < I_GU) { p0_transpose_item<2>(INPTR(float, kp, I_WGU), NGU, D, NGU, (GAS bf16*)(ws + WS_WGU), INPTR(float, kp, I_NFFN), scr, r, lane); continue; } r -= I_GU;
        if (r < I_DN) { p0_transpose_item<0>(INPTR(float, kp, I_WDN), D, DFF, D, (GAS bf16*)(ws + WS_WDN), nullptr, scr, r, lane); continue; } r -= I_DN;
        if (r < I_PLE) { p0_transpose_item<0>(INPTR(float, kp, I_WPLE), D, DPLE, D, (GAS bf16*)(ws + WS_WPLE), nullptr, scr, r, lane); continue; } r -= I_PLE;
        p0_transpose_item<0>(INPTR(float, kp, I_WPG), D, D, D, (GAS bf16*)(ws + WS_WPG), INPTR(float, kp, I_NPLE), scr, r, lane);
    }
    {
        const int gt = blockIdx.x * (NWAVES * 64) + F.tid, NT_ = F.G * NWAVES * 64;
        GAS float2* cs128 = (GAS float2*)(ws + WS_CS128); GAS float2* cs64 = (GAS float2*)(ws + WS_CS64);
        for (int i = gt; i < TP * 64 + TP * 32; i += NT_) {
            int pos, fi, half; GAS float2* dst;
            if (i < TP * 64) { pos = i >> 6; fi = i & 63; half = 64; dst = cs128 + i; } else { const int j = i - TP * 64; pos = j >> 5; fi = j & 31; half = 32; dst = cs64 + j; }
            const float freq = __builtin_powf(10000.0f, -(float)fi / (float)half);
            const float ang = (float)pos * freq;
            double s, c; sincos_d((double)ang, s, c);
            dst->x = (float)c; dst->y = (float)s;
        }
    }
    {
        const GAS f32x4* gr = (const GAS f32x4*)INPTR(float, kp, I_NMIX) + lane;
        f32x4 g4[4];
#pragma unroll
        for (int j = 0; j < 4; ++j) g4[j] = gr[64 * j];
        const GAS float* xp = INPTR(float, kp, I_XP); const GAS float* xs = INPTR(float, kp, I_XS);
        for (int m0 = gw; m0 < M; m0 += 4 * NGW) {
            f32x4 v[4][4];
#pragma unroll
            for (int u = 0; u < 4; ++u) { const int m = m0 + u * NGW; if (m < M) {
                const GAS f32x4* xr = (const GAS f32x4*)(m < MP ? xp + (size_t)m * D : xs + (size_t)(m - MP) * D) + lane;
#pragma unroll
                for (int j = 0; j < 4; ++j) v[u][j] = xr[64 * j]; } }
#pragma unroll
            for (int u = 0; u < 4; ++u) { const int m = m0 + u * NGW; if (m < M) {
                float s = 0.f;
#pragma unroll
                for (int j = 0; j < 4; ++j) s += (v[u][j].x * v[u][j].x + v[u][j].y * v[u][j].y) + (v[u][j].z * v[u][j].z + v[u][j].w * v[u][j].w);
                const float rs = 1.0f / sqrtf(wave_sum(s) * (1.f / D) + EPS);
                GAS v2u* o8 = (GAS v2u*)((GAS bf16*)(ws + WS_HB) + (size_t)m * D) + lane;
#pragma unroll
                for (int j = 0; j < 4; ++j) { const f32x4 g = g4[j]; v2u o; o.x = cvtpk(v[u][j].x * rs * g.x, v[u][j].y * rs * g.y); o.y = cvtpk(v[u][j].z * rs * g.z, v[u][j].w * rs * g.w); o8[64 * j] = o; } } }
        }
    }
    {
        const GAS float* pp = INPTR(float, kp, I_PP); const GAS float* ps = INPTR(float, kp, I_PS);
        for (int m0 = gw; m0 < M; m0 += 8 * NGW) {
            f32x4 v[8];
#pragma unroll
            for (int u = 0; u < 8; ++u) { const int m = m0 + u * NGW; if (m < M) v[u] = ((const GAS f32x4*)(m < MP ? pp + (size_t)m * DPLE : ps + (size_t)(m - MP) * DPLE))[lane]; }
#pragma unroll
            for (int u = 0; u < 8; ++u) { const int m = m0 + u * NGW; if (m < M) { v2u o; o.x = cvtpk(v[u].x, v[u].y); o.y = cvtpk(v[u].z, v[u].w);
                ((GAS v2u*)((GAS bf16*)(ws + WS_PB) + (size_t)m * DPLE))[lane] = o; } }
        }
    }
}

constexpr float QK_LOG2_SCALE = 0.088388347648318440f * 1.4426950408889634f;
struct EpiIn {
    GAS bf16 *qb, *kb, *vb, *qib, *kib, *ub, *bgb, *sgab; GAS float* wi; const GAS float2 *cs128, *cs64; GAS float* out;
    __device__ __forceinline__ void operator()(const pg8::f32x4 (&acc)[2][2][4][2], const pg8::Unit& u, int wr, int wc, int fr, int fq) const {
        const int pn = u.pn;
        const bool roped = pn < 5 || (pn > 5 && pn < 8) || (pn == 8 && wc == 0);
        f32x4 cn00, cn01, cn10, cn11;
#define LDCC(im) do { const int row_ = u.pm * 256 + ((im) >> 2) * 128 + wr * 64 + ((im) & 3) * 16 + fr; const int pos_ = row_pos(row_); \
            const GAS float2* tb_ = cs128 + (pn < 5 ? 0 : (int)((WS_CS64 - WS_CS128) / 8)); const int st_ = pn < 5 ? 64 : 32;     \
            const int w0_ = 32 * wc + 4 * fq, w1_ = w0_ + 16; \
            const int d0_ = pn < 5 ? (w0_ & 63) : (pn < 8 ? (w0_ & 31) : (4 * fq)), d1_ = pn < 5 ? (w1_ & 63) : (pn < 8 ? (w1_ & 31) : (16 + 4 * fq)); \
            cn00 = *(const GAS f32x4*)(tb_ + pos_ * st_ + d0_); cn01 = *(const GAS f32x4*)(tb_ + pos_ * st_ + d0_ + 2); \
            cn10 = *(const GAS f32x4*)(tb_ + pos_ * st_ + d1_); cn11 = *(const GAS f32x4*)(tb_ + pos_ * st_ + d1_ + 2); } while (0)
        if (roped) LDCC(0);
#pragma unroll
        for (int ai = 0; ai < 2; ++ai)
#pragma unroll
            for (int m = 0; m < 4; ++m) {
                int row = u.pm * 256 + ai * 128 + wr * 64 + m * 16 + fr; asm volatile("" : "+v"(row));
                const int pos = row_pos(row);
                const f32x4 cc00 = cn00, cc01 = cn01, cc10 = cn10, cc11 = cn11;
                if (roped && ai * 4 + m < 7) LDCC(ai * 4 + m + 1);
                if (pn < 5) {
#pragma unroll
                    for (int n = 0; n < 2; ++n) {
                        const int w = 32 * wc + 16 * n + 4 * fq, d = w & 63, hh = w >> 6;
                        const f32x4 c01 = n ? cc10 : cc00, c23 = n ? cc11 : cc01;
                        const f32x4 x1 = acc[ai][0][m][n], x2 = acc[ai][1][m][n];
                        f32x4 o1, o2;
                        o1.x = x1.x * c01.x - x2.x * c01.y; o2.x = x2.x * c01.x + x1.x * c01.y;
                        o1.y = x1.y * c01.z - x2.y * c01.w; o2.y = x2.y * c01.z + x1.y * c01.w;
                        o1.z = x1.z * c23.x - x2.z * c23.y; o2.z = x2.z * c23.x + x1.z * c23.y;
                        o1.w = x1.w * c23.z - x2.w * c23.w; o2.w = x2.w * c23.z + x1.w * c23.w;
                        const float qs = pn < 4 ? QK_LOG2_SCALE : 1.f;
                        v2u b1, b2; b1.x = cvtpk(o1.x * qs, o1.y * qs); b1.y = cvtpk(o1.z * qs, o1.w * qs); b2.x = cvtpk(o2.x * qs, o2.y * qs); b2.y = cvtpk(o2.z * qs, o2.w * qs);
                        if (pn < 4) { GAS bf16* q = qb + (size_t)row * D + (2 * pn + hh) * 128 + d; *(GAS v2u*)q = b1; *(GAS v2u*)(q + 64) = b2; }
                        else { GAS bf16* k = kb + (size_t)row * 256 + hh * 128 + d; *(GAS v2u*)k = b1; *(GAS v2u*)(k + 64) = b2;
                               GAS float* ko = out + (row < MP ? O_KP + (size_t)row * 256 : O_KS + (size_t)(row - MP) * 256) + hh * 128 + d; *(GAS f32x4*)ko = o1; *(GAS f32x4*)(ko + 64) = o2; }
                    }
                } else if (pn == 5) {
#pragma unroll
                    for (int bj = 0; bj < 2; ++bj)
#pragma unroll
                        for (int n = 0; n < 2; ++n) { const int c = 128 * bj + 32 * wc + 16 * n + 4 * fq; const f32x4 x = acc[ai][bj][m][n];
                            v2u b; b.x = cvtpk(x.x, x.y); b.y = cvtpk(x.z, x.w); *(GAS v2u*)(vb + (size_t)row * 256 + c) = b;
                            *(GAS f32x4*)(out + (row < MP ? O_VP + (size_t)row * 256 : O_VS + (size_t)(row - MP) * 256) + c) = x; }
                } else if (pn < 8) {
#pragma unroll
                    for (int n = 0; n < 2; ++n) {
                        const int w = 32 * wc + 16 * n + 4 * fq, d = w & 31, ih = 4 * (pn - 6) + (w >> 5);
                        const f32x4 c01 = n ? cc10 : cc00, c23 = n ? cc11 : cc01;
                        const f32x4 x1 = acc[ai][0][m][n], x2 = acc[ai][1][m][n];
                        f32x4 o1, o2;
                        o1.x = x1.x * c01.x - x2.x * c01.y; o2.x = x2.x * c01.x + x1.x * c01.y;
                        o1.y = x1.y * c01.z - x2.y * c01.w; o2.y = x2.y * c01.z + x1.y * c01.w;
                        o1.z = x1.z * c23.x - x2.z * c23.y; o2.z = x2.z * c23.x + x1.z * c23.y;
                        o1.w = x1.w * c23.z - x2.w * c23.w; o2.w = x2.w * c23.z + x1.w * c23.w;
                        v2u b1, b2; b1.x = cvtpk(o1.x, o1.y); b1.y = cvtpk(o1.z, o1.w); b2.x = cvtpk(o2.x, o2.y); b2.y = cvtpk(o2.z, o2.w);
                        { const int q8 = row & 7, rr = (ih & 3) + 8 * (ih >> 2) + 4 * (q8 & 1) + 16 * ((q8 >> 1) & 1);
                          GAS bf16* qf = qib + (size_t)(row >> 3) * 4096 + ((q8 >> 2) * 4 + (d >> 4)) * 512 + ((((d >> 3) & 1) * 32 + rr) * 8) + (d & 7);
                          *(GAS v2u*)qf = b1; *(GAS v2u*)(qf + 1024) = b2; }
                    }
                } else if (pn == 8) {
                    if (wc == 0) {
#pragma unroll
                        for (int n = 0; n < 2; ++n) {
                            const int d = 16 * n + 4 * fq;
                            const f32x4 c01 = n ? cc10 : cc00, c23 = n ? cc11 : cc01;
                            const f32x4 x1 = acc[ai][0][m][n], x2 = acc[ai][1][m][n];
                            f32x4 o1, o2;
                            o1.x = x1.x * c01.x - x2.x * c01.y; o2.x = x2.x * c01.x + x1.x * c01.y;
                            o1.y = x1.y * c01.z - x2.y * c01.w; o2.y = x2.y * c01.z + x1.y * c01.w;
                            o1.z = x1.z * c23.x - x2.z * c23.y; o2.z = x2.z * c23.x + x1.z * c23.y;
                            o1.w = x1.w * c23.z - x2.w * c23.w; o2.w = x2.w * c23.z + x1.w * c23.w;
                            v2u b1, b2; b1.x = cvtpk(o1.x, o1.y); b1.y = cvtpk(o1.z, o1.w); b2.x = cvtpk(o2.x, o2.y); b2.y = cvtpk(o2.z, o2.w);
                            { GAS bf16* kf = kib + (size_t)(row >> 5) * 2048 + (d >> 4) * 512 + ((((d >> 3) & 1) * 32 + (row & 31)) * 8) + (d & 7);
                              *(GAS v2u*)kf = b1; *(GAS v2u*)(kf + 1024) = b2; }
                            GAS float* ko = out + (row < MP ? O_KIP + (size_t)row * 64 : O_KIS + (size_t)(row - MP) * 64) + d; *(GAS f32x4*)ko = o1; *(GAS f32x4*)(ko + 32) = o2;
                        }
                    } else if (wc == 1 && fq < 2) {
                        *(GAS f32x4*)(wi + (size_t)row * 8 + 4 * fq) = acc[ai][0][m][0] * IDX_SCALE;
                    }
                } else if (pn < 17) {
                    const int t = row < MP ? (row & (TP - 1)) : (row & (TS - 1)), tl = row < MP ? TP : TS;
#pragma unroll
                    for (int n = 0; n < 2; ++n) { const int ch = 128 * (pn - 9) + 32 * wc + 16 * n + 4 * fq; const f32x4 x = acc[ai][0][m][n] * acc[ai][1][m][n];
                        v2u b; b.x = cvtpk(x.x, x.y); b.y = cvtpk(x.z, x.w); *(GAS v2u*)(ub + (size_t)row * D + ch) = b;
                        if (t >= tl - 2) { const int bidx = row < MP ? (row >> 12) : ((row - MP) >> 3);
                            *(GAS f32x4*)(out + (row < MP ? O_CP : O_CS) + ((size_t)bidx * 2 + (t - (tl - 2))) * D + ch) = x; } }
                } else if (pn < 25) {
#pragma unroll
                    for (int n = 0; n < 2; ++n) { const int ch = 128 * (pn - 17) + 32 * wc + 16 * n + 4 * fq; const f32x4 a = acc[ai][0][m][n], g = acc[ai][1][m][n];
                        v2u b; b.x = cvtpk(a.x * sigmoidf_fast(g.x), a.y * sigmoidf_fast(g.y)); b.y = cvtpk(a.z * sigmoidf_fast(g.z), a.w * sigmoidf_fast(g.w));
                        *(GAS v2u*)(bgb + (size_t)row * D + ch) = b; }
                } else {
#pragma unroll
                    for (int bj = 0; bj < 2; ++bj)
#pragma unroll
                        for (int n = 0; n < 2; ++n) { const int ch = 256 * (pn - 25) + 128 * bj + 32 * wc + 16 * n + 4 * fq; const f32x4 g = acc[ai][bj][m][n];
                            v2u b; b.x = cvtpk(sigmoidf_fast(g.x), sigmoidf_fast(g.y)); b.y = cvtpk(sigmoidf_fast(g.z), sigmoidf_fast(g.w));
                            *(GAS v2u*)(sgab + (size_t)row * D + ch) = b; }
                }
                asm volatile("" ::: "memory");
            }
    }
};
template <bool WT> __device__ __forceinline__ void st16(GAS void* base, size_t byteoff, size_t nbytes, v4u v) {
    if (WT) __builtin_amdgcn_raw_buffer_store_b128(v, __builtin_amdgcn_make_buffer_rsrc((void*)base, 0, (int)nbytes, 0x00020000), (int)byteoff, 0, 16);
    else *(GAS v4u*)((GAS char*)base + byteoff) = v; }
template <bool WT> __device__ __forceinline__ void st4(GAS float* p, float v) {
    if (WT) __hip_atomic_store((GAS unsigned*)p, __float_as_uint(v), __ATOMIC_RELAXED, __HIP_MEMORY_SCOPE_AGENT); else *p = v; }
__device__ __forceinline__ v4u pack8(const f32x4& a, const f32x4& b) { v4u o; o.x = cvtpk(a.x, a.y); o.y = cvtpk(a.z, a.w); o.z = cvtpk(b.x, b.y); o.w = cvtpk(b.z, b.w); return o; }
__device__ __forceinline__ void unpack8(const v4u w, f32x4& a, f32x4& b) {
    a.x = __uint_as_float(w.x << 16); a.y = __uint_as_float(w.x & 0xffff0000u); a.z = __uint_as_float(w.y << 16); a.w = __uint_as_float(w.y & 0xffff0000u);
    b.x = __uint_as_float(w.z << 16); b.y = __uint_as_float(w.z & 0xffff0000u); b.z = __uint_as_float(w.w << 16); b.w = __uint_as_float(w.w & 0xffff0000u); }
template <bool WT = false> struct EpiBf {
    GAS bf16* O; int ldc;
    __device__ __forceinline__ void operator()(const pg8::f32x4 (&acc)[2][2][4][2], const pg8::Unit& u, int wr, int wc, int fr, int fq) const {
#pragma unroll
        for (int ai = 0; ai < 2; ++ai)
#pragma unroll
            for (int m = 0; m < 4; ++m) { const int row = u.pm * 256 + ai * 128 + wr * 64 + m * 16 + fr;
#pragma unroll
                for (int bj = 0; bj < 2; ++bj) { const int c = u.pn * 256 + 128 * bj + 32 * wc + 8 * fq;
                    st16<WT>(O, ((size_t)row * ldc + c) * 2, (size_t)M * ldc * 2, pack8(acc[ai][bj][m][0], acc[ai][bj][m][1])); } }
    }
};
template <int BASEMODE  , bool WT = false> struct EpiRes {
    const GAS float *xp, *xs; const GAS bf16* baseb; GAS bf16* xo; GAS float* part;
    __device__ __forceinline__ void operator()(const pg8::f32x4 (&acc)[2][2][4][2], const pg8::Unit& u, int wr, int wc, int fr, int fq) const {
#pragma unroll
        for (int ai = 0; ai < 2; ++ai) {
            f32x4 b0[4][2], b1[4][2];
#pragma unroll
            for (int m = 0; m < 4; ++m) { const int row = u.pm * 256 + ai * 128 + wr * 64 + m * 16 + fr;
#pragma unroll
                for (int bj = 0; bj < 2; ++bj) { const int c = u.pn * 256 + 128 * bj + 32 * wc + 8 * fq;
                    if (BASEMODE == 0) { const GAS float* xr = (row < MP ? xp + (size_t)row * D : xs + (size_t)(row - MP) * D) + c; b0[m][bj] = *(const GAS f32x4*)xr; b1[m][bj] = *(const GAS f32x4*)(xr + 4); }
                    else unpack8(*(const GAS v4u*)(baseb + (size_t)row * D + c), b0[m][bj], b1[m][bj]); } }
#pragma unroll
            for (int m = 0; m < 4; ++m) { const int row = u.pm * 256 + ai * 128 + wr * 64 + m * 16 + fr; float ss = 0.f;
#pragma unroll
                for (int bj = 0; bj < 2; ++bj) { const int c = u.pn * 256 + 128 * bj + 32 * wc + 8 * fq; const f32x4 x0 = acc[ai][bj][m][0] + b0[m][bj], x1 = acc[ai][bj][m][1] + b1[m][bj];
                    ss += ((x0.x * x0.x + x0.y * x0.y) + (x0.z * x0.z + x0.w * x0.w)) + ((x1.x * x1.x + x1.y * x1.y) + (x1.z * x1.z + x1.w * x1.w));
                    st16<WT>(xo, ((size_t)row * D + c) * 2, (size_t)M * D * 2, pack8(x0, x1)); }
                ss += __shfl_xor(ss, 16); ss += __shfl_xor(ss, 32);
                if (fq == 0) st4<WT>(part + (size_t)row * 16 + u.pn * 4 + wc, ss); }
        }
    }
};
__device__ __forceinline__ float row_rs(const GAS float* part, int row) {
    const f32x4 a = *(const GAS f32x4*)(part + (size_t)row * 16), b = *(const GAS f32x4*)(part + (size_t)row * 16 + 4), c = *(const GAS f32x4*)(part + (size_t)row * 16 + 8), d = *(const GAS f32x4*)(part + (size_t)row * 16 + 12);
    const float s = ((a.x + a.y) + (a.z + a.w)) + ((b.x + b.y) + (b.z + b.w)) + ((c.x + c.y) + (c.z + c.w)) + ((d.x + d.y) + (d.z + d.w));
    return 1.0f / sqrtf(s * (1.f / D) + EPS);
}
__device__ __forceinline__ f32x4 swiglu4(const f32x4& g, const f32x4& u) { f32x4 o; o.x = g.x * sigmoidf_fast(g.x) * u.x; o.y = g.y * sigmoidf_fast(g.y) * u.y; o.z = g.z * sigmoidf_fast(g.z) * u.z; o.w = g.w * sigmoidf_fast(g.w) * u.w; return o; }
__device__ __forceinline__ float row_rs_q(const GAS float* part, int row, int fq) {
    const f32x4 a = *(const GAS f32x4*)(part + (size_t)row * 16 + 4 * fq);
    float s = (a.x + a.y) + (a.z + a.w);
    s += __shfl_xor(s, 16); s += __shfl_xor(s, 32);
    return 1.0f / sqrtf(s * (1.f / D) + EPS);
}
template <bool WT = false> struct EpiSwiGLU {
    const GAS float* part; GAS bf16* act;
    __device__ __forceinline__ void operator()(const pg8::f32x4 (&acc)[2][2][4][2], const pg8::Unit& u, int wr, int wc, int fr, int fq) const {
        float rsv[2][4];
#pragma unroll
        for (int ai = 0; ai < 2; ++ai)
#pragma unroll
            for (int m = 0; m < 4; ++m) rsv[ai][m] = row_rs_q(part, u.pm * 256 + ai * 128 + wr * 64 + m * 16 + fr, fq);
#pragma unroll
        for (int ai = 0; ai < 2; ++ai)
#pragma unroll
            for (int m = 0; m < 4; ++m) { const int row = u.pm * 256 + ai * 128 + wr * 64 + m * 16 + fr; const float rs = rsv[ai][m];
                const int c = u.pn * 128 + 32 * wc + 8 * fq;
                st16<WT>(act, ((size_t)row * DFF + c) * 2, (size_t)M * DFF * 2, pack8(swiglu4(acc[ai][0][m][0] * rs, acc[ai][1][m][0] * rs), swiglu4(acc[ai][0][m][1] * rs, acc[ai][1][m][1] * rs))); }
    }
};
template <bool WT = false> struct EpiPle {
    const GAS float* part2; const GAS bf16 *x2b, *pw; GAS bf16* x3; GAS float* part3;
    __device__ __forceinline__ void operator()(const pg8::f32x4 (&acc)[2][2][4][2], const pg8::Unit& u, int wr, int wc, int fr, int fq) const {
#pragma unroll
        for (int ai = 0; ai < 2; ++ai) {
        float rsv[2][4];
#pragma unroll
        for (int m = 0; m < 4; ++m) rsv[ai][m] = row_rs_q(part2, u.pm * 256 + ai * 128 + wr * 64 + m * 16 + fr, fq);
#pragma unroll
        for (int mh = 0; mh < 2; ++mh) {
            v4u xv[2][2], pv[2][2];
#pragma unroll
            for (int m2 = 0; m2 < 2; ++m2) { const int row = u.pm * 256 + ai * 128 + wr * 64 + (2 * mh + m2) * 16 + fr;
#pragma unroll
                for (int bj = 0; bj < 2; ++bj) { const int c = u.pn * 256 + 128 * bj + 32 * wc + 8 * fq;
                    xv[m2][bj] = *(const GAS v4u*)(x2b + (size_t)row * D + c); pv[m2][bj] = *(const GAS v4u*)(pw + (size_t)row * D + c); } }
#pragma unroll
            for (int m2 = 0; m2 < 2; ++m2) { const int m = 2 * mh + m2; const int row = u.pm * 256 + ai * 128 + wr * 64 + m * 16 + fr; const float rs = rsv[ai][m]; float ss = 0.f;
#pragma unroll
                for (int bj = 0; bj < 2; ++bj) { const int c = u.pn * 256 + 128 * bj + 32 * wc + 8 * fq;
                    f32x4 xa, xb, pa, pb; unpack8(xv[m2][bj], xa, xb); unpack8(pv[m2][bj], pa, pb);
                    const f32x4 a0 = acc[ai][bj][m][0] * rs, a1 = acc[ai][bj][m][1] * rs;
                    f32x4 x0, x1;
                    x0.x = xa.x + pa.x * sigmoidf_fast(a0.x); x0.y = xa.y + pa.y * sigmoidf_fast(a0.y); x0.z = xa.z + pa.z * sigmoidf_fast(a0.z); x0.w = xa.w + pa.w * sigmoidf_fast(a0.w);
                    x1.x = xb.x + pb.x * sigmoidf_fast(a1.x); x1.y = xb.y + pb.y * sigmoidf_fast(a1.y); x1.z = xb.z + pb.z * sigmoidf_fast(a1.z); x1.w = xb.w + pb.w * sigmoidf_fast(a1.w);
                    ss += ((x0.x * x0.x + x0.y * x0.y) + (x0.z * x0.z + x0.w * x0.w)) + ((x1.x * x1.x + x1.y * x1.y) + (x1.z * x1.z + x1.w * x1.w));
                    st16<WT>(x3, ((size_t)row * D + c) * 2, (size_t)M * D * 2, pack8(x0, x1)); }
                ss += __shfl_xor(ss, 16); ss += __shfl_xor(ss, 32);
                if (fq == 0) st4<WT>(part3 + (size_t)row * 16 + u.pn * 4 + wc, ss); }
        }
        }
    }
};
struct EpiStream {
    GAS unsigned char* ws; GAS float* out; const GAS float *xp, *xs;
    __device__ __forceinline__ void operator()(const pg8::f32x4 (&acc)[2][2][4][2], const pg8::SUnit& su, int wr, int wc, int fr, int fq) const {
        const pg8::Unit u{su.pm, su.pn};
        if (su.s == 0) { const EpiBf<true> e{(GAS bf16*)(ws + WS_PW), D}; e(acc, u, wr, wc, fr, fq); }
        else if (su.s == 1) { const EpiRes<0, true> e{xp, xs, nullptr, (GAS bf16*)(ws + WS_X1B), (GAS float*)(ws + WS_PART1)}; e(acc, u, wr, wc, fr, fq); }
        else if (su.s == 2) { const EpiSwiGLU<true> e{(const GAS float*)(ws + WS_PART1), (GAS bf16*)(ws + WS_ACT)}; e(acc, u, wr, wc, fr, fq); }
        else if (su.s == 3) { const EpiRes<1, true> e{nullptr, nullptr, (const GAS bf16*)(ws + WS_X1B), (GAS bf16*)(ws + WS_X2B), (GAS float*)(ws + WS_PART2)}; e(acc, u, wr, wc, fr, fq); }
        else { const EpiPle<true> e{(const GAS float*)(ws + WS_PART2), (const GAS bf16*)(ws + WS_X2B), (const GAS bf16*)(ws + WS_PW), (GAS bf16*)(ws + WS_X3B), (GAS float*)(ws + WS_PART3)}; e(acc, u, wr, wc, fr, fq); }
    }
};

__device__ __forceinline__ float relu_i(float x) { const int i = __float_as_int(x); return __int_as_float(i > 0 ? i : 0); }
__device__ __forceinline__ void idx_scores(const bf16x8 (&Af)[2][4], const bf16x8 (&Bf)[4], const f32x4 (&wv)[2][4], float (&sc)[2][2]) {
#pragma unroll
    for (int R = 0; R < 2; ++R) {
        f32x16 d = {};
#pragma unroll
        for (int s = 0; s < 4; ++s) d = __builtin_amdgcn_mfma_f32_32x32x16_bf16(Af[R][s], Bf[s], d, 0, 0, 0);
        float s0 = 0.f, s1 = 0.f;
#pragma unroll
        for (int r = 0; r < 8; ++r) { s0 = fmaf(relu_i(d[r]), wv[R][r >> 2][r & 3], s0); asm volatile("" : "+v"(s0)); s1 = fmaf(relu_i(d[8 + r]), wv[R][2 + (r >> 2)][r & 3], s1); }
        sc[R][0] = s0; sc[R][1] = s1;
    }
}
__device__ __forceinline__ void idx_load_q(const GAS bf16* qib, const GAS float* wi, int mq0, int lane, bf16x8 (&Af)[2][4], f32x4 (&wv)[2][4]) {
    const int r = lane & 31, hh = lane >> 5;
#pragma unroll
    for (int R = 0; R < 2; ++R) {
        const GAS bf16* qp = qib + (size_t)(mq0 >> 3) * 4096 + R * 2048 + lane * 8;
#pragma unroll
        for (int s = 0; s < 4; ++s) Af[R][s] = *(const GAS bf16x8*)(qp + 512 * s);
        const GAS float* w0 = wi + (size_t)(mq0 + 4 * R + hh) * 8; const GAS float* w1 = wi + (size_t)(mq0 + 4 * R + 2 + hh) * 8;
        wv[R][0] = *(const GAS f32x4*)w0; wv[R][1] = *(const GAS f32x4*)(w0 + 4); wv[R][2] = *(const GAS f32x4*)w1; wv[R][3] = *(const GAS f32x4*)(w1 + 4);
    }
}
__device__ __forceinline__ unsigned sortable(float f) { const unsigned u = __float_as_uint(f); return (u & 0x80000000u) ? ~u : (u | 0x80000000u); }
__device__ __forceinline__ void st8wt(GAS void* base, size_t byteoff, size_t nbytes, unsigned long long v) {
    const v2u d = {(unsigned)v, (unsigned)(v >> 32)};
    __builtin_amdgcn_raw_buffer_store_b64(d, __builtin_amdgcn_make_buffer_rsrc((void*)base, 0, (int)nbytes, 0x00020000), (int)byteoff, 0, 16); }
__device__ __forceinline__ unsigned* mask_counter(gu32* ctl, int row) { return (unsigned*)(ctl + CW_MSK) + (size_t)(row < MP ? (row >> 6) : 256 + ((row - MP) >> 3)) * 64; }
__device__ __forceinline__ void p2_item(int p, bool& sample, int& b, int& t0, int& mq0) {
    sample = p < BS;
    if (sample) { b = p; t0 = PAST; mq0 = MP + b * TS; }
    else { const int tg = 2047 - (p - BS); t0 = (tg >> 2) * 8; b = tg & 3; mq0 = b * TP + t0; }
}
__device__ __forceinline__ void p2_index_select(Frame& F) {
    GAS unsigned char* ws = F.ws;
    const GAS bf16* qib = (const GAS bf16*)(ws + WS_QIB); const GAS bf16* kib = (const GAS bf16*)(ws + WS_KIB); const GAS float* wi = (const GAS float*)(ws + WS_WI);
    GAS unsigned long long* mask = (GAS unsigned long long*)(ws + WS_MASK);
    const int lane = F.lane, w = F.wave, c = lane & 31, hh = lane >> 5;
    karg_t* kp = kargs(); const GAS int* page_table = INPTR(int, kp, I_PT); const GAS float* cache_kidx = INPTR(float, kp, I_CKI);
    LAS float* sc = (LAS float*)(F.lds + RING_OFF);
    volatile LAS unsigned long long* wl = (volatile LAS unsigned long long*)(F.lds + LDSCTL_OFF + 2048 + w * 512);
    bf16x8 Af[2][4]; f32x4 wv[2][4];
    { bool s_; int b_, t_, m_; p2_item((int)blockIdx.x, s_, b_, t_, m_); idx_load_q(qib, wi, m_, lane, Af, wv); }
    unsigned* qctr = (unsigned*)(F.ctl + CW_Q);
    int pend_row = -1;
    for (int it = (int)blockIdx.x; it < 2048 + BS;) {
        unsigned claim = 0u;
        if (w == 0 && lane == 0) claim = (unsigned)F.G + __hip_atomic_fetch_add(qctr, 1u, __ATOMIC_RELAXED, __HIP_MEMORY_SCOPE_AGENT);
        __syncthreads();
        bool sample; int b, t0, mq0;
        p2_item(it, sample, b, t0, mq0);
        const int Lmax = t0 + 8, L = t0 + w + 1;
        if (Lmax > 256) {
            const int ntiles = ((Lmax + 63) >> 6) * 2;
            const int nj = (ntiles - w + 7) >> 3;
            if (!sample) {
                auto ldB = [&](bf16x8 (&B)[2][4], int j) {
#pragma unroll
                    for (int jj = 0; jj < 2; ++jj) { int kt = w + 8 * (j + jj); kt = kt < ntiles ? kt : ntiles - 1;
                        const GAS bf16* kq_ = kib + (size_t)(b * (TP / 32) + kt) * 2048 + lane * 8;
#pragma unroll
                        for (int s2 = 0; s2 < 4; ++s2) B[jj][s2] = *(const GAS bf16x8*)(kq_ + 512 * s2); } };
                auto cmpB = [&](const bf16x8 (&B)[2][4], int j) {
#pragma unroll
                    for (int jj = 0; jj < 2; ++jj) { if (j + jj < nj) { const int kt = w + 8 * (j + jj);
                        float s4[2][2]; idx_scores(Af, B[jj], wv, s4);
#pragma unroll
                        for (int R = 0; R < 2; ++R) { const int e = kt * 32 + c;
                            sc[(4 * R + hh) * LMAX + e] = __uint_as_float(e <= t0 + 4 * R + hh ? sortable(s4[R][0]) : 0u);
                            sc[(4 * R + 2 + hh) * LMAX + e] = __uint_as_float(e <= t0 + 4 * R + 2 + hh ? sortable(s4[R][1]) : 0u); } }
                        else { asm volatile("" :: "v"(B[jj][0]), "v"(B[jj][1]), "v"(B[jj][2]), "v"(B[jj][3])); } } };
                bf16x8 B0[2][4], B1[2][4];
                ldB(B0, 0);
                for (int j0 = 0; j0 < nj; j0 += 4) { ldB(B1, j0 + 2); cmpB(B0, j0); ldB(B0, j0 + 4); cmpB(B1, j0 + 2); }
#pragma unroll
                for (int jj = 0; jj < 2; ++jj) asm volatile("" :: "v"(B0[jj][0]), "v"(B0[jj][1]), "v"(B0[jj][2]), "v"(B0[jj][3]));
            } else {
                for (int j0 = 0; j0 < nj; j0 += 2) {
                    f32x4 Fb[2][8];
#pragma unroll
                    for (int jj = 0; jj < 2; ++jj) { { int kt = w + 8 * (j0 + jj); kt = kt < ntiles ? kt : ntiles - 1;
                        if (kt < 64) { const int phys = page_table[b * NPG + (kt >> 2)];
                            const GAS float* kq = cache_kidx + ((size_t)phys * PAGE + (kt & 3) * 32 + c) * DI + 8 * hh;
#pragma unroll
                            for (int s2 = 0; s2 < 4; ++s2) { Fb[jj][2 * s2] = *(const GAS f32x4*)(kq + 16 * s2); Fb[jj][2 * s2 + 1] = *(const GAS f32x4*)(kq + 16 * s2 + 4); } }
                        else { const int mk = mq0 + (c & 7);
                            const GAS bf16* kq = kib + (size_t)(mk >> 5) * 2048 + (hh * 32 + (mk & 31)) * 8;
#pragma unroll
                            for (int s2 = 0; s2 < 4; ++s2) { const bf16x8 kv = *(const GAS bf16x8*)(kq + 512 * s2);
                                Fb[jj][2 * s2] = f32x4{bf2f((unsigned short)kv[0]), bf2f((unsigned short)kv[1]), bf2f((unsigned short)kv[2]), bf2f((unsigned short)kv[3])};
                                Fb[jj][2 * s2 + 1] = f32x4{bf2f((unsigned short)kv[4]), bf2f((unsigned short)kv[5]), bf2f((unsigned short)kv[6]), bf2f((unsigned short)kv[7])}; } } } }
#pragma unroll
                    for (int jj = 0; jj < 2; ++jj) { if (j0 + jj < nj) { const int kt = w + 8 * (j0 + jj);
                        bf16x8 Bf[4];
#pragma unroll
                        for (int s2 = 0; s2 < 4; ++s2) { const f32x4 a = Fb[jj][2 * s2], bq = Fb[jj][2 * s2 + 1];
                            v4u o; o.x = cvtpk(a.x, a.y); o.y = cvtpk(a.z, a.w); o.z = cvtpk(bq.x, bq.y); o.w = cvtpk(bq.z, bq.w); Bf[s2] = *(bf16x8*)&o; }
                        float s4[2][2]; idx_scores(Af, Bf, wv, s4);
#pragma unroll
                        for (int R = 0; R < 2; ++R) { const int e = kt * 32 + c;
                            sc[(4 * R + hh) * LMAX + e] = __uint_as_float(e <= t0 + 4 * R + hh ? sortable(s4[R][0]) : 0u);
                            sc[(4 * R + 2 + hh) * LMAX + e] = __uint_as_float(e <= t0 + 4 * R + 2 + hh ? sortable(s4[R][1]) : 0u); } }
                        else { asm volatile("" :: "v"(Fb[jj][0]), "v"(Fb[jj][1]), "v"(Fb[jj][2]), "v"(Fb[jj][3]), "v"(Fb[jj][4]), "v"(Fb[jj][5]), "v"(Fb[jj][6]), "v"(Fb[jj][7])); } }
                }
            }
        }
        if (w == 0 && lane == 0) F.MISC[16] = claim;
        LDS_WAIT();
        __syncthreads();
        const int itn = (int)F.MISC[16];
        if (pend_row >= 0) {
            asm volatile("s_waitcnt vmcnt(0)" ::: "memory");
            if (lane == 0) __hip_atomic_fetch_add(mask_counter(F.ctl, pend_row), 1u, __ATOMIC_RELAXED, __HIP_MEMORY_SCOPE_AGENT);
            pend_row = -1; }
        auto prefetch_q = [&]() {
          if (itn < 2048 + BS) { bool sn; int bn, t0n, mqn; p2_item(itn, sn, bn, t0n, mqn);
              if (t0n + 8 > 256) idx_load_q(qib, wi, mqn, lane, Af, wv); } };
        GAS unsigned long long* mrow = mask + (size_t)(mq0 + w) * 64;
        if (L <= 256) {
            const int lo = 64 * lane;
            const unsigned long long word = (L >= lo + 64) ? ~0ull : (L > lo ? ((1ull << (L - lo)) - 1ull) : 0ull);
            st8wt(mask, ((size_t)(mq0 + w) * 64 + lane) * 8, (size_t)M * 64 * 8, word); pend_row = mq0 + w;
            it = itn;
            continue;
        }
        const int nch = (L + 63) >> 6;
        unsigned x[64];
        const LAS float* srow = sc + w * LMAX + lane; const int rem = L - lane;
#pragma unroll
        for (int g = 0; g < 8; ++g) { if (g * 8 < nch) {
#pragma unroll
            for (int i = 0; i < 8; ++i) { const unsigned v = __float_as_uint(srow[(g * 8 + i) * 64]); x[g * 8 + i] = (g * 8 + i < nch) ? v : 0u; } }
          else {
#pragma unroll
            for (int i = 0; i < 8; ++i) x[g * 8 + i] = 0u; } }
        prefetch_q();
        unsigned T = 0u; bool exact = false; unsigned prefix = 0u; int need = 256;
        {
            asm volatile("" ::: "memory");
            LAS unsigned* h12 = (LAS unsigned*)(sc + w * LMAX);
#pragma unroll
            for (int i = 0; i < 16; ++i) *(LAS v4u*)(h12 + 256 * i + 4 * lane) = v4u{0u, 0u, 0u, 0u};
            asm volatile("" ::: "memory");
#pragma unroll
            for (int g = 0; g < 8; ++g) { if (g * 8 < nch) {
#pragma unroll
                for (int i = 0; i < 8; ++i) __hip_atomic_fetch_add(h12 + (x[g * 8 + i] >> 20), 1u, __ATOMIC_RELAXED, __HIP_MEMORY_SCOPE_WORKGROUP); } }
            LDS_WAIT(); asm volatile("" ::: "memory");
            int sl = 0;
            int lo_ = lane; asm volatile("" : "+v"(lo_));
#pragma unroll
            for (int j = 0; j < 16; ++j) { const v4u c4 = *(const LAS v4u*)(h12 + 64 * lo_ + 4 * ((j + lo_) & 15)); sl += (int)(c4.x + c4.y + c4.z + c4.w); }
            int pf = sl;
            pf += __builtin_amdgcn_update_dpp(0, pf, 0x111, 0xf, 0xf, true);
            pf += __builtin_amdgcn_update_dpp(0, pf, 0x112, 0xf, 0xf, true);
            pf += __builtin_amdgcn_update_dpp(0, pf, 0x114, 0xf, 0xf, true);
            pf += __builtin_amdgcn_update_dpp(0, pf, 0x118, 0xf, 0xf, true);
            pf += __builtin_amdgcn_update_dpp(0, pf, 0x142, 0xa, 0xf, true);
            pf += __builtin_amdgcn_update_dpp(0, pf, 0x143, 0xc, 0xf, true);
            const int above_lane = __builtin_amdgcn_readlane(pf, 63) - pf;
            const int cl = __builtin_ctzll(__ballot((above_lane < need) && (above_lane + sl >= need)));
            const int ab_cl = __builtin_amdgcn_readlane(above_lane, cl);
            const int cb = (int)h12[64 * cl + lane];
            int pf2 = cb;
            pf2 += __builtin_amdgcn_update_dpp(0, pf2, 0x111, 0xf, 0xf, true);
            pf2 += __builtin_amdgcn_update_dpp(0, pf2, 0x112, 0xf, 0xf, true);
            pf2 += __builtin_amdgcn_update_dpp(0, pf2, 0x114, 0xf, 0xf, true);
            pf2 += __builtin_amdgcn_update_dpp(0, pf2, 0x118, 0xf, 0xf, true);
            pf2 += __builtin_amdgcn_update_dpp(0, pf2, 0x142, 0xa, 0xf, true);
            pf2 += __builtin_amdgcn_update_dpp(0, pf2, 0x143, 0xc, 0xf, true);
            const int above2 = ab_cl + __builtin_amdgcn_readlane(pf2, 63) - pf2;
            const int dl = __builtin_ctzll(__ballot((above2 < need) && (above2 + cb >= need)));
            const int above = __builtin_amdgcn_readlane(above2, dl), cnt_d = __builtin_amdgcn_readlane(cb, dl);
            need -= above;
            prefix = (unsigned)(64 * cl + dl);
            T = prefix << 20;
            exact = (cnt_d == need);
        }
        LAS unsigned* hist = (LAS unsigned*)(F.lds + LDSCTL_OFF + 8192 + w * 2048);
        if (!exact) {
#pragma unroll 1
        for (int p = 1; p < 4; ++p) {
            const int shift = p == 3 ? 0 : 20 - 8 * p, width = p == 3 ? 4 : 8;
            *(LAS v4u*)(hist + 4 * lane) = v4u{0u, 0u, 0u, 0u}; *(LAS v4u*)(hist + 256 + 4 * lane) = v4u{0u, 0u, 0u, 0u};
            LDS_WAIT();
#pragma unroll
            for (int g = 0; g < 8; ++g) { if (g * 8 < nch) {
#pragma unroll
                for (int i = 0; i < 8; ++i) { const unsigned xi = x[g * 8 + i];
                    if ((xi >> (shift + width)) == prefix) __hip_atomic_fetch_add(hist + (lane & 1) * 256 + ((xi >> shift) & ((1u << width) - 1u)), 1u, __ATOMIC_RELAXED, __HIP_MEMORY_SCOPE_WORKGROUP); } } }
            LDS_WAIT();
            const v4u c4 = *(const LAS v4u*)(hist + 4 * lane) + *(const LAS v4u*)(hist + 256 + 4 * lane);
            const int sl = (int)(c4.x + c4.y + c4.z + c4.w);
            int pf = sl;
            pf += __builtin_amdgcn_update_dpp(0, pf, 0x111, 0xf, 0xf, true);
            pf += __builtin_amdgcn_update_dpp(0, pf, 0x112, 0xf, 0xf, true);
            pf += __builtin_amdgcn_update_dpp(0, pf, 0x114, 0xf, 0xf, true);
            pf += __builtin_amdgcn_update_dpp(0, pf, 0x118, 0xf, 0xf, true);
            pf += __builtin_amdgcn_update_dpp(0, pf, 0x142, 0xa, 0xf, true);
            pf += __builtin_amdgcn_update_dpp(0, pf, 0x143, 0xc, 0xf, true);
            const int total = __builtin_amdgcn_readlane(pf, 63);
            const int above_lane = total - pf;
            const bool cross = (above_lane < need) && (above_lane + sl >= need);
            const int cl = __builtin_ctzll(__ballot(cross));
            const int t3 = above_lane + (int)c4.w, t2 = t3 + (int)c4.z, t1 = t2 + (int)c4.y;
            int dsel, ab, cd;
            if (t3 >= need) { dsel = 3; ab = above_lane; cd = (int)c4.w; }
            else if (t2 >= need) { dsel = 2; ab = t3; cd = (int)c4.z; }
            else if (t1 >= need) { dsel = 1; ab = t2; cd = (int)c4.y; }
            else { dsel = 0; ab = t1; cd = (int)c4.x; }
            const int d = 4 * cl + __builtin_amdgcn_readlane(dsel, cl);
            const int above = __builtin_amdgcn_readlane(ab, cl), cnt_d = __builtin_amdgcn_readlane(cd, cl);
            need -= above;
            prefix = (prefix << width) | (unsigned)d;
            T = prefix << shift;
            if (cnt_d == need) { exact = true; break; }
        }
        }
        if (exact) {
#pragma unroll
            for (int i = 0; i < 64; ++i) { const unsigned long long bm = __ballot(x[i] >= T);
                wl[i] = bm; }
        } else {
            int cgt = 0;
#pragma unroll
            for (int i = 0; i < 64; ++i) cgt += __builtin_popcountll(__ballot(x[i] > T));
            const int r = 256 - cgt;
            asm volatile("" : "+s"(T));
            int base = 0;
#pragma unroll
            for (int i = 0; i < 64; ++i) {
                const unsigned long long bgt = __ballot(x[i] > T), beq = __ballot(x[i] == T);
                const int neq = __builtin_popcountll(beq);
                int take = r - base; take = take < 0 ? 0 : take;
                unsigned long long word = bgt | beq;
                if (take < neq) {
                    const int pre = __builtin_popcountll(beq & ((1ull << lane) - 1ull));
                    word = bgt | __ballot((x[i] == T) && pre < take);
                }
                base += neq;
                wl[i] = word;
            }
        }
        LDS_WAIT();
        st8wt(mask, ((size_t)(mq0 + w) * 64 + lane) * 8, (size_t)M * 64 * 8, wl[lane]); pend_row = mq0 + w;
        LDS_WAIT();
        it = itn;
    }
    if (pend_row >= 0) { asm volatile("s_waitcnt vmcnt(0)" ::: "memory"); if (lane == 0) __hip_atomic_fetch_add(mask_counter(F.ctl, pend_row), 1u, __ATOMIC_RELAXED, __HIP_MEMORY_SCOPE_AGENT); }
}

constexpr float SM_SCALE = 0.088388347648318440f;
constexpr int KVBLK = 64;
constexpr size_t SHM_V = KVBLK * HD * 2, SHM_K = KVBLK * HD * 2;
#define KSWZ(row, colB) ((row) * 256 + ((colB) ^ (((row) & 7) << 4)))
__device__ __forceinline__ int crow(int r, int hi) { return (r & 3) + 8 * (r >> 2) + 4 * hi; }
__device__ __forceinline__ int v_st(int k, int c) { const int kk = (k & ~0xC) | ((k & 4) << 1) | ((k & 8) >> 1); return ((kk >> 3) * 4 + (c >> 5)) * 512 + ((kk & 7) * 32 + (c & 31)) * 2; }
__device__ __forceinline__ int v_rd_base(int lane) { return ((lane & 3) << 3) | (((lane >> 2) & 3) << 6) | (((lane >> 4) & 1) << 5) | (((lane >> 5) & 1) << 8); }
constexpr int v_rd_off(int d0, int ks, int half) { return d0 * 512 + ks * 4096 + half * 2048; }
template <int OFF> __device__ __forceinline__ s16x4 tr_read(int vb) {
    s16x4 r; asm volatile("ds_read_b64_tr_b16 %0, %1 offset:%2" : "=&v"(r) : "v"(vb), "i"(OFF) : "memory"); return r;
}
template <int D0> __device__ __forceinline__ void pv_one(f32x16& od, int vb, bf16x8 pa0, bf16x8 pa1, bf16x8 pa2, bf16x8 pa3) {
    const s16x4 l0 = tr_read<v_rd_off(D0, 0, 0)>(vb), h0 = tr_read<v_rd_off(D0, 0, 1)>(vb), l1 = tr_read<v_rd_off(D0, 1, 0)>(vb), h1 = tr_read<v_rd_off(D0, 1, 1)>(vb);
    const s16x4 l2 = tr_read<v_rd_off(D0, 2, 0)>(vb), h2 = tr_read<v_rd_off(D0, 2, 1)>(vb), l3 = tr_read<v_rd_off(D0, 3, 0)>(vb), h3 = tr_read<v_rd_off(D0, 3, 1)>(vb);
    asm volatile("s_waitcnt lgkmcnt(0)" ::: "memory"); SBAR();
#define PK(L, H) (bf16x8){L[0], L[1], L[2], L[3], H[0], H[1], H[2], H[3]}
    od = __builtin_amdgcn_mfma_f32_32x32x16_bf16(pa0, PK(l0, h0), od, 0, 0, 0);
    od = __builtin_amdgcn_mfma_f32_32x32x16_bf16(pa1, PK(l1, h1), od, 0, 0, 0);
    od = __builtin_amdgcn_mfma_f32_32x32x16_bf16(pa2, PK(l2, h2), od, 0, 0, 0);
    od = __builtin_amdgcn_mfma_f32_32x32x16_bf16(pa3, PK(l3, h3), od, 0, 0, 0);
#undef PK
}
__device__ __forceinline__ void pv_d0(f32x16* o, int vb, bf16x8 pa0, bf16x8 pa1, bf16x8 pa2, bf16x8 pa3) {
    pv_one<0>(o[0], vb, pa0, pa1, pa2, pa3); pv_one<1>(o[1], vb, pa0, pa1, pa2, pa3); pv_one<2>(o[2], vb, pa0, pa1, pa2, pa3); pv_one<3>(o[3], vb, pa0, pa1, pa2, pa3);
}
__device__ __forceinline__ void qkt(f32x16& p0, f32x16& p1, const char* Ks, const bf16x8* qr, int r32, int hi) {
    p0 = f32x16{}; p1 = f32x16{};
#pragma unroll
    for (int d0 = 0; d0 < 8; ++d0) { const int cb = (d0 * 16 + hi * 8) * 2;
        const bf16x8 b0 = *reinterpret_cast<const bf16x8*>(Ks + KSWZ(r32, cb));
        const bf16x8 b1 = *reinterpret_cast<const bf16x8*>(Ks + KSWZ(32 + r32, cb));
        p0 = __builtin_amdgcn_mfma_f32_32x32x16_bf16(b0, qr[d0], p0, 0, 0, 0);
        p1 = __builtin_amdgcn_mfma_f32_32x32x16_bf16(b1, qr[d0], p1, 0, 0, 0); }
}
template <int R> __device__ __forceinline__ void mask_exp(f32x16& p, unsigned w) {
    if constexpr (R < 16) { constexpr int sh = (R & 3) + 8 * (R >> 2); unsigned m; asm("v_bfe_i32 %0, %1, %2, 1" : "=v"(m) : "v"(w), "n"(sh));
        p[R] = __uint_as_float(__float_as_uint(__builtin_amdgcn_exp2f(p[R])) & m); mask_exp<R + 1>(p, w); }
}
constexpr float SM_THR = 8.f;
__device__ __forceinline__ void partialSM(f32x16& p0, f32x16& p1, unsigned long long mw, int hi, float& m_reg, float& mn, float& alpha, unsigned& mhi) {
    constexpr float C = 1.f;
    float pmax = p0[0];
#pragma unroll
    for (int r = 1; r < 16; ++r) pmax = fmaxf(pmax, p0[r]);
#pragma unroll
    for (int r = 0; r < 16; ++r) pmax = fmaxf(pmax, p1[r]);
    { auto rr = __builtin_amdgcn_permlane32_swap(__float_as_uint(pmax), __float_as_uint(pmax), false, false);
      pmax = fmaxf(__uint_as_float(rr[0]), __uint_as_float(rr[1])); }
    if (__builtin_expect(__all(pmax - m_reg <= SM_THR * 1.4426950408889634f), 1)) { mn = m_reg; alpha = 1.f; }
    else { mn = fmaxf(m_reg, pmax); alpha = __builtin_amdgcn_exp2f((m_reg - mn) * C); m_reg = mn; }
    const float mnC = -mn * C;
#pragma unroll
    for (int r = 0; r < 16; ++r) p0[r] = fmaf(p0[r], C, mnC);
#pragma unroll
    for (int r = 0; r < 16; ++r) p1[r] = fmaf(p1[r], C, mnC);
    const unsigned w0 = (unsigned)mw >> (4 * hi); mhi = (unsigned)(mw >> 32) >> (4 * hi);
    mask_exp<0>(p0, w0);
}
__device__ __forceinline__ void finishSM(f32x16& p0, f32x16& p1, float alpha, unsigned mhi, float& l_reg, bf16x8& pa0, bf16x8& pa1, bf16x8& pa2, bf16x8& pa3) {
    mask_exp<0>(p1, mhi);
    float ps = 0;
#pragma unroll
    for (int r = 0; r < 16; ++r) ps += p0[r];
#pragma unroll
    for (int r = 0; r < 16; ++r) ps += p1[r];
    { auto rr = __builtin_amdgcn_permlane32_swap(__float_as_uint(ps), __float_as_uint(ps), false, false);
      ps = __uint_as_float(rr[0]) + __uint_as_float(rr[1]); }
    l_reg = l_reg * alpha + ps;
#define PK4(P, BASE, OUT) do { unsigned a0 = cvtpk(P[BASE + 0], P[BASE + 1]), a1 = cvtpk(P[BASE + 2], P[BASE + 3]);   \
    unsigned b0 = cvtpk(P[BASE + 4], P[BASE + 5]), b1 = cvtpk(P[BASE + 6], P[BASE + 7]);                              \
    auto r0 = __builtin_amdgcn_permlane32_swap(a0, b0, false, false); auto r1 = __builtin_amdgcn_permlane32_swap(a1, b1, false, false); \
    v4u wq = {r0[0], r1[0], r0[1], r1[1]}; OUT = *reinterpret_cast<bf16x8*>(&wq); } while (0)
    PK4(p0, 0, pa0); PK4(p0, 8, pa1); PK4(p1, 0, pa2); PK4(p1, 8, pa3);
#undef PK4
}

__device__ __forceinline__ void partialFast(f32x16& p0, unsigned long long mw, int hi, unsigned& mhi) {
    const unsigned w0 = (unsigned)mw >> (4 * hi); mhi = (unsigned)(mw >> 32) >> (4 * hi);
    mask_exp<0>(p0, w0);
}
__device__ __forceinline__ void finishFast(f32x16& p0, f32x16& p1, unsigned mhi, float& l_reg, bf16x8& pa0, bf16x8& pa1, bf16x8& pa2, bf16x8& pa3) {
    mask_exp<0>(p1, mhi);
    float ps = 0;
#pragma unroll
    for (int r = 0; r < 16; ++r) ps += p0[r];
#pragma unroll
    for (int r = 0; r < 16; ++r) ps += p1[r];
    { auto rr = __builtin_amdgcn_permlane32_swap(__float_as_uint(ps), __float_as_uint(ps), false, false);
      ps = __uint_as_float(rr[0]) + __uint_as_float(rr[1]); }
    l_reg += ps;
#define PK4(P, BASE, OUT) do { unsigned a0 = cvtpk(P[BASE + 0], P[BASE + 1]), a1 = cvtpk(P[BASE + 2], P[BASE + 3]);   \
    unsigned b0 = cvtpk(P[BASE + 4], P[BASE + 5]), b1 = cvtpk(P[BASE + 6], P[BASE + 7]);                              \
    auto r0 = __builtin_amdgcn_permlane32_swap(a0, b0, false, false); auto r1 = __builtin_amdgcn_permlane32_swap(a1, b1, false, false); \
    v4u wq = {r0[0], r1[0], r0[1], r1[1]}; OUT = *reinterpret_cast<bf16x8*>(&wq); } while (0)
    PK4(p0, 0, pa0); PK4(p0, 8, pa1); PK4(p1, 0, pa2); PK4(p1, 8, pa3);
#undef PK4
}

template <bool SAMPLE, bool FAST>
__device__ __forceinline__ bool attn_unit(Frame& F, int b, int kvh, int qt, char* lds) {
    GAS unsigned char* ws = F.ws; asm volatile("" : "+s"(ws)); karg_t* kp = kargs();
    const GAS int* page_table = INPTR(int, kp, I_PT); const GAS float* cache_k = INPTR(float, kp, I_CK); const GAS float* cache_v = INPTR(float, kp, I_CV);
    const GAS bf16* qb = (const GAS bf16*)(ws + WS_QB); const GAS bf16* kb = (const GAS bf16*)(ws + WS_KB); const GAS bf16* vb = (const GAS bf16*)(ws + WS_VB);
    const GAS unsigned long long* maskb = (const GAS unsigned long long*)(ws + WS_MASK);
    const int tid = F.wave * 64 + lane_opaque();
    const int wid = F.wave, lane = tid & 63, r32 = lane & 31, hi = lane >> 5;
    char* V_lds = lds; char* K_lds = lds + 3 * SHM_V;
    float* wsl = (float*)(lds + 3 * SHM_V + 3 * SHM_K) + wid * 64; float* li_l = wsl; float* al_l = wsl + 32;
    float m_reg = -1e30f, l_reg = 0; f32x16 o[4] = {}; bf16x8 qr[8];
    const int tokw = SAMPLE ? 0 : 8 * wid;
    const int mrow0 = SAMPLE ? (MP + b * TS) : (b * TP + qt * 64);
    const int mtok = mrow0 + tokw + (r32 >> 2);
    const int head = kvh * 4 + (r32 & 3);
    { const GAS bf16* Qw = qb + (size_t)mtok * D + head * HD + hi * 8;
#pragma unroll
      for (int d0 = 0; d0 < 8; ++d0) qr[d0] = *(const GAS bf16x8*)(Qw + d0 * 16); }
    const GAS unsigned long long* mrow = maskb + (size_t)mtok * 64;
    const int sr = tid >> 4, sc = (tid & 15) * 8, vst0 = v_st(sr, sc), vst1 = v_st(32 + sr, sc);
    const int vb0 = (int)(uintptr_t)V_lds + v_rd_base(lane);
    const int NT = SAMPLE ? 34 : ((qt + 1) + ((qt + 1) & 1));
    typedef typename std::conditional<SAMPLE, f32x8, bf16x8>::type ST;
    ST vs0, vs1, ks0, ks1;
    auto tobf = [](ST x) -> bf16x8 {
        if constexpr (SAMPLE) { v4u wq = {cvtpk(x[0], x[1]), cvtpk(x[2], x[3]), cvtpk(x[4], x[5]), cvtpk(x[6], x[7])}; return *reinterpret_cast<bf16x8*>(&wq); }
        else return x; };
#define SLOAD(kt) do { \
        if constexpr (SAMPLE) { \
            if ((kt) < 32) { const int phys = page_table[b * NPG + ((kt) >> 1)]; \
                const size_t r0 = ((size_t)phys * PAGE + ((kt) & 1) * 64 + sr) * (NKV * HD) + kvh * HD + sc, r1 = r0 + (size_t)32 * (NKV * HD); \
                vs0 = *(const GAS f32x8*)(cache_v + r0); vs1 = *(const GAS f32x8*)(cache_v + r1); ks0 = *(const GAS f32x8*)(cache_k + r0); ks1 = *(const GAS f32x8*)(cache_k + r1); } \
            else { const size_t r0 = (size_t)(mrow0 + (sr & 7)) * 256 + kvh * HD + sc; \
                const bf16x8 kv = *(const GAS bf16x8*)(kb + r0), vv = *(const GAS bf16x8*)(vb + r0); \
                _Pragma("unroll") for (int _e = 0; _e < 8; ++_e) { ks0[_e] = bf2f((unsigned short)kv[_e]); vs0[_e] = bf2f((unsigned short)vv[_e]); } ks1 = ks0; vs1 = vs0; } \
        } else { \
            const size_t r0 = (size_t)(b * TP + (kt) * 64 + sr) * 256 + kvh * HD + sc, r1 = r0 + (size_t)32 * 256; \
            vs0 = *(const GAS bf16x8*)(vb + r0); vs1 = *(const GAS bf16x8*)(vb + r1); ks0 = *(const GAS bf16x8*)(kb + r0); ks1 = *(const GAS bf16x8*)(kb + r1); } } while (0)
#define SWRITE(bsel) do { *(bf16x8*)(V_lds + (bsel) * SHM_V + vst0) = tobf(vs0); *(bf16x8*)(V_lds + (bsel) * SHM_V + vst1) = tobf(vs1); const int kc = sc * 2; \
        *(bf16x8*)(K_lds + (bsel) * SHM_K + KSWZ(sr, kc)) = tobf(ks0); *(bf16x8*)(K_lds + (bsel) * SHM_K + KSWZ(32 + sr, kc)) = tobf(ks1); } while (0)
#define RESC(a) do { if (__any((a) < 1.f)) { if (hi == 0) al_l[r32] = (a); asm volatile("s_waitcnt lgkmcnt(0)" ::: "memory"); \
        _Pragma("unroll") for (int d = 0; d < 4; ++d) _Pragma("unroll") for (int r = 0; r < 16; ++r) o[d][r] *= al_l[crow(r, hi)]; } } while (0)
    f32x16 pA0, pA1, pB0, pB1; float mnA, mnB, alA, alB; bf16x8 pa0, pa1, pa2, pa3;
    unsigned long long mw; unsigned mhA, mhB;
#define PSM(P0, P1, MN, AL, MH) do { if constexpr (FAST) partialFast(P0, mw, hi, MH); else partialSM(P0, P1, mw, hi, m_reg, MN, AL, MH); } while (0)
#define FSM(P0, P1, AL, MH) do { if constexpr (FAST) finishFast(P0, P1, MH, l_reg, pa0, pa1, pa2, pa3); else finishSM(P0, P1, AL, MH, l_reg, pa0, pa1, pa2, pa3); } while (0)
#define RESCF(a) do { if constexpr (!FAST) RESC(a); } while (0)
    if (wid == 0) {
        unsigned* cw = mask_counter(F.ctl, mrow0); unsigned polls = 0;
        while ((unsigned)__builtin_amdgcn_readfirstlane(__hip_atomic_load(cw, __ATOMIC_RELAXED, __HIP_MEMORY_SCOPE_AGENT)) < (SAMPLE ? 8u : 64u)) { if (++polls > (1u << 18)) break; __builtin_amdgcn_s_sleep(2); }
        __builtin_amdgcn_fence(__ATOMIC_ACQUIRE, "agent");
        asm volatile("s_waitcnt vmcnt(0)" ::: "memory"); }
    __syncthreads();
    if (FAST && tid == 0) F.MISC[24] = 0u;
    SLOAD(0); mw = mrow[0]; VM_WAIT(); SWRITE(0); __syncthreads();
    qkt(pA0, pA1, K_lds, qr, r32, hi); PSM(pA0, pA1, mnA, alA, mhA);
    SLOAD(1); mw = mrow[1];
    VM_WAIT(); SWRITE(1); if (NT > 2) SLOAD(2); __syncthreads();
    int s0 = 0, s1 = 1, s2 = 2;
    for (int t = 1; t + 1 < NT; t += 2) {
        VM_WAIT(); SWRITE(s2); SLOAD(t + 2);
        SBAR(); qkt(pB0, pB1, K_lds + s1 * SHM_K, qr, r32, hi);
        FSM(pA0, pA1, alA, mhA); SBAR();
        pv_d0(o, vb0 + s0 * (int)SHM_V, pa0, pa1, pa2, pa3); PSM(pB0, pB1, mnB, alB, mhB); mw = mrow[t + 1];
        RESCF(alB); __syncthreads();
        { const int t_ = s0; s0 = s1; s1 = s2; s2 = t_; }
        VM_WAIT(); SWRITE(s2); if (t + 3 < NT) SLOAD(t + 3);
        SBAR(); qkt(pA0, pA1, K_lds + s1 * SHM_K, qr, r32, hi);
        FSM(pB0, pB1, alB, mhB); SBAR();
        pv_d0(o, vb0 + s0 * (int)SHM_V, pa0, pa1, pa2, pa3); PSM(pA0, pA1, mnA, alA, mhA); mw = mrow[t + 2];
        RESCF(alA); __syncthreads();
        { const int t_ = s0; s0 = s1; s1 = s2; s2 = t_; }
    }
    SBAR(); qkt(pB0, pB1, K_lds + s1 * SHM_K, qr, r32, hi);
    FSM(pA0, pA1, alA, mhA); SBAR();
    pv_d0(o, vb0 + s0 * (int)SHM_V, pa0, pa1, pa2, pa3); PSM(pB0, pB1, mnB, alB, mhB);
    RESCF(alB);
    FSM(pB0, pB1, alB, mhB); SBAR();
    pv_d0(o, vb0 + s1 * (int)SHM_V, pa0, pa1, pa2, pa3);
    if constexpr (FAST) { if (__any(!(l_reg > 1e-30f && l_reg < 1e30f)) && lane == 0) F.MISC[24] = 1u; }
#undef PSM
#undef FSM
#undef RESCF
    if (hi == 0) li_l[r32] = l_reg; asm volatile("s_waitcnt lgkmcnt(0)" ::: "memory");
    bool bad_unit = false;
    {
        int lane_e = (int)__builtin_amdgcn_mbcnt_hi(~0u, __builtin_amdgcn_mbcnt_lo(~0u, 0u)); asm volatile("" : "+v"(lane_e) :: "memory"); const int r32e = lane_e & 31, hie = lane_e >> 5;
        float rli[16];
#pragma unroll
        for (int r = 0; r < 16; ++r) rli[r] = __builtin_amdgcn_rcpf(li_l[crow(r, hie)]);
        __syncthreads();
        if constexpr (FAST) { bad_unit = F.MISC[24] != 0u;
#ifdef PROBE_FORCE_SAFE
            bad_unit = bad_unit || (qt & 1);
#endif
        }
        float* ol = (float*)(lds + wid * 16384);
#pragma unroll
        for (int r = 0; r < 16; ++r) { const int orow = crow(r, hie);
#pragma unroll
            for (int d0 = 0; d0 < 4; ++d0) ol[orow * 128 + d0 * 32 + r32e] = o[d0][r] * rli[r]; }
        asm volatile("s_waitcnt lgkmcnt(0)" ::: "memory");
        if (!SAMPLE || wid == 0) {
            const GAS bf16* ub = (const GAS bf16*)(ws + WS_UB); const GAS bf16* bgb = (const GAS bf16*)(ws + WS_BG); const GAS bf16* sgab = (const GAS bf16*)(ws + WS_SGA);
            GAS bf16* merged = (GAS bf16*)(ws + WS_MERGED);
            karg_t* kp2 = kargs(); const GAS float* conv_w = INPTR(float, kp2, I_CONVW); const GAS float* state_conv = INPTR(float, kp2, I_SC);
            const int ch = kvh * 512 + lane_e * 8;
            const f32x8 w0 = *(const GAS f32x8*)(conv_w + ch), w1 = *(const GAS f32x8*)(conv_w + D + ch), w2 = *(const GAS f32x8*)(conv_w + 2 * D + ch);
            if constexpr (!SAMPLE) {
                const int tq0 = qt * 64 + tokw; const size_t off0 = (size_t)(mrow0 + tokw) * D + ch;
                bf16x8 ur[10], sgr[8], bgr[8];
#pragma unroll
                for (int i = 0; i < 10; ++i) { const bool ok = tq0 + i - 2 >= 0; const bf16x8 x = *(const GAS bf16x8*)(ub + (ok ? off0 + (size_t)(i - 2) * D : off0)); ur[i] = ok ? x : bf16x8{}; }
#pragma unroll
                for (int tk = 0; tk < 8; ++tk) { sgr[tk] = *(const GAS bf16x8*)(sgab + off0 + (size_t)tk * D); bgr[tk] = *(const GAS bf16x8*)(bgb + off0 + (size_t)tk * D); }
#pragma unroll
                for (int tk = 0; tk < 8; ++tk) {
                    const f32x8 ov = *(const f32x8*)(ol + tk * 512 + lane_e * 8);
                    float val[8];
#pragma unroll
                    for (int e = 0; e < 8; ++e) { const float cv = w0[e] * bf2f((unsigned short)ur[tk][e]) + w1[e] * bf2f((unsigned short)ur[tk + 1][e]) + w2[e] * bf2f((unsigned short)ur[tk + 2][e]);
                        val[e] = bf2f((unsigned short)sgr[tk][e]) * ov[e] + bf2f((unsigned short)bgr[tk][e]) * cv; }
                    v4u pk = {cvtpk(val[0], val[1]), cvtpk(val[2], val[3]), cvtpk(val[4], val[5]), cvtpk(val[6], val[7])};
                    st16<true>(merged, (off0 + (size_t)tk * D) * 2, (size_t)M * D * 2, pk);
                }
            } else {
            for (int tk = 0; tk < 8; ++tk) {
                const int tok = tokw + tk, mm = mrow0 + tok, t = SAMPLE ? tok : (qt * 64 + tok);
                const size_t off = (size_t)mm * D + ch;
                const f32x8 ov = *(const f32x8*)(ol + tk * 512 + lane_e * 8);
                const bf16x8 sg = *(const GAS bf16x8*)(sgab + off), bg = *(const GAS bf16x8*)(bgb + off), u2 = *(const GAS bf16x8*)(ub + off);
                f32x8 u1, u0;
                if (t >= 1) { const bf16x8 x = *(const GAS bf16x8*)(ub + off - D);
#pragma unroll
                    for (int e = 0; e < 8; ++e) u1[e] = bf2f((unsigned short)x[e]); }
                else if (SAMPLE) u1 = *(const GAS f32x8*)(state_conv + ((size_t)b * 2 + 1) * D + ch);
                else u1 = f32x8{};
                if (t >= 2) { const bf16x8 x = *(const GAS bf16x8*)(ub + off - 2 * D);
#pragma unroll
                    for (int e = 0; e < 8; ++e) u0[e] = bf2f((unsigned short)x[e]); }
                else if (SAMPLE) u0 = *(const GAS f32x8*)(state_conv + ((size_t)b * 2 + t) * D + ch);
                else u0 = f32x8{};
                float val[8];
#pragma unroll
                for (int e = 0; e < 8; ++e) { const float cv = w0[e] * u0[e] + w1[e] * u1[e] + w2[e] * bf2f((unsigned short)u2[e]);
                    val[e] = bf2f((unsigned short)sg[e]) * ov[e] + bf2f((unsigned short)bg[e]) * cv; }
                v4u pk = {cvtpk(val[0], val[1]), cvtpk(val[2], val[3]), cvtpk(val[4], val[5]), cvtpk(val[6], val[7])};
                st16<true>(merged, off * 2, (size_t)M * D * 2, pk);
            }
            }
            if (!bad_unit) {
                asm volatile("s_waitcnt vmcnt(0)" ::: "memory");
                if (lane_e == 0) __hip_atomic_fetch_add((unsigned*)(F.ctl + CW_DEP) + (size_t)(3 * 128 + (mrow0 >> 8)) * 64, 1u, __ATOMIC_RELAXED, __HIP_MEMORY_SCOPE_AGENT);
            }
        }
    }
#undef SLOAD
#undef SWRITE
#undef RESC
    return bad_unit;
}
__device__ __forceinline__ void attn_sample_unit(Frame& F, int b, int kvh, char* lds) {
    GAS unsigned char* ws = F.ws; asm volatile("" : "+s"(ws)); karg_t* kp = kargs();
    const GAS int* page_table = INPTR(int, kp, I_PT); const GAS float* cache_k = INPTR(float, kp, I_CK); const GAS float* cache_v = INPTR(float, kp, I_CV);
    const GAS bf16* qb = (const GAS bf16*)(ws + WS_QB); const GAS bf16* kb = (const GAS bf16*)(ws + WS_KB); const GAS bf16* vb = (const GAS bf16*)(ws + WS_VB);
    const GAS unsigned long long* maskb = (const GAS unsigned long long*)(ws + WS_MASK);
    const int tid = F.wave * 64 + lane_opaque();
    const int wid = F.wave, lane = tid & 63, r32 = lane & 31, hi = lane >> 5;
    char* V_lds = lds; char* K_lds = lds + 2 * SHM_V;
    float* wsl = (float*)(lds + 2 * SHM_V + 2 * SHM_K) + wid * 64; float* al_l = wsl + 32;
    float* mlt = (float*)(lds + LDSCTL_OFF + 6144);
    float m_reg = -1e30f, l_reg = 0; f32x16 o[4] = {}; bf16x8 qr[8];
    const int mrow0 = MP + b * TS;
    const int mtok = mrow0 + (r32 >> 2);
    const int head = kvh * 4 + (r32 & 3);
    { const GAS bf16* Qw = qb + (size_t)mtok * D + head * HD + hi * 8;
#pragma unroll
      for (int d0 = 0; d0 < 8; ++d0) qr[d0] = *(const GAS bf16x8*)(Qw + d0 * 16); }
    const GAS unsigned long long* mrow = maskb + (size_t)mtok * 64;
    const int sr = tid >> 4, sc = (tid & 15) * 8, vst0 = v_st(sr, sc), vst1 = v_st(32 + sr, sc);
    const int vb0 = (int)(uintptr_t)V_lds + v_rd_base(lane);
    unsigned long long* Mt = (unsigned long long*)(lds + 68 * 1024);
    unsigned long long* Ut = (unsigned long long*)(lds + 72 * 1024);
    int* baset = (int*)(lds + 72 * 1024 + 512);
    int* ptab = (int*)(lds + 72 * 1024 + 832);
    unsigned short* klist = (unsigned short*)(lds + 73 * 1024);
    unsigned long long* cmt = (unsigned long long*)(lds + 78 * 1024);
    if (wid == 0) {
        unsigned* cw = mask_counter(F.ctl, mrow0); unsigned polls = 0;
        while ((unsigned)__builtin_amdgcn_readfirstlane(__hip_atomic_load(cw, __ATOMIC_RELAXED, __HIP_MEMORY_SCOPE_AGENT)) < 8u) { if (++polls > (1u << 18)) break; __builtin_amdgcn_s_sleep(2); }
        __builtin_amdgcn_fence(__ATOMIC_ACQUIRE, "agent");
        asm volatile("s_waitcnt vmcnt(0)" ::: "memory"); }
    __syncthreads();
    Mt[wid * 64 + lane] = lane < 33 ? maskb[(size_t)(mrow0 + wid) * 64 + lane] : 0ull;
    if (tid < NPG) ptab[tid] = page_table[b * NPG + tid];
    asm volatile("s_waitcnt vmcnt(0) lgkmcnt(0)" ::: "memory");
    __syncthreads();
    if (wid == 0) {
        unsigned long long u = 0ull;
#pragma unroll
        for (int w2 = 0; w2 < 8; ++w2) u |= Mt[w2 * 64 + lane];
        const int pc = __builtin_popcountll(u);
        int pf = pc;
        pf += __builtin_amdgcn_update_dpp(0, pf, 0x111, 0xf, 0xf, true);
        pf += __builtin_amdgcn_update_dpp(0, pf, 0x112, 0xf, 0xf, true);
        pf += __builtin_amdgcn_update_dpp(0, pf, 0x114, 0xf, 0xf, true);
        pf += __builtin_amdgcn_update_dpp(0, pf, 0x118, 0xf, 0xf, true);
        pf += __builtin_amdgcn_update_dpp(0, pf, 0x142, 0xa, 0xf, true);
        pf += __builtin_amdgcn_update_dpp(0, pf, 0x143, 0xc, 0xf, true);
        Ut[lane] = u; baset[lane] = pf - pc;
        if (lane == 63) baset[64] = pf;
    }
    asm volatile("s_waitcnt lgkmcnt(0)" ::: "memory");
    __syncthreads();
    const int Cn = baset[64];
#pragma unroll
    for (int i = 0; i < 5; ++i) { const int k = tid + 512 * i;
        if (k < 33 * 64) { const unsigned long long wd = Ut[k >> 6];
            if ((wd >> (k & 63)) & 1ull) klist[baset[k >> 6] + __builtin_popcountll(wd & ((1ull << (k & 63)) - 1ull))] = (unsigned short)k; } }
    asm volatile("s_waitcnt lgkmcnt(0)" ::: "memory");
    __syncthreads();
    const int NTS = (Cn + 63) >> 6;
    for (int j = 0; j < NTS; ++j) {
        const int p = 64 * j + lane; const int key = klist[p < Cn ? p : Cn - 1];
        const bool bit = (p < Cn) && ((Mt[wid * 64 + (key >> 6)] >> (key & 63)) & 1ull);
        const unsigned long long wd = __ballot(bit);
        if (lane == 0) cmt[wid * 34 + j] = wd;
    }
    asm volatile("s_waitcnt lgkmcnt(0)" ::: "memory");
    __syncthreads();
    const unsigned long long* cmrow = cmt + (r32 >> 2) * 34;
    f32x8 vs0, vs1, ks0, ks1;
    auto tobf = [](f32x8 x) -> bf16x8 { v4u wq = {cvtpk(x[0], x[1]), cvtpk(x[2], x[3]), cvtpk(x[4], x[5]), cvtpk(x[6], x[7])}; return *reinterpret_cast<bf16x8*>(&wq); };
    auto ldrow = [&](int p, f32x8& kd, f32x8& vd) {
        const int key = klist[p < Cn ? p : Cn - 1];
        if (key < PAST) { const size_t r0 = ((size_t)ptab[key >> 7] * PAGE + (key & (PAGE - 1))) * (NKV * HD) + kvh * HD + sc;
            kd = *(const GAS f32x8*)(cache_k + r0); vd = *(const GAS f32x8*)(cache_v + r0); }
        else { const size_t r0 = (size_t)(mrow0 + (key - PAST)) * 256 + kvh * HD + sc;
            const bf16x8 kv = *(const GAS bf16x8*)(kb + r0), vv = *(const GAS bf16x8*)(vb + r0);
#pragma unroll
            for (int e = 0; e < 8; ++e) { kd[e] = bf2f((unsigned short)kv[e]); vd[e] = bf2f((unsigned short)vv[e]); } } };
#define SLOAD(kt) do { ldrow(64 * (kt) + sr, ks0, vs0); ldrow(64 * (kt) + 32 + sr, ks1, vs1); } while (0)
#define SWRITE(bsel) do { *(bf16x8*)(V_lds + (bsel) * SHM_V + vst0) = tobf(vs0); *(bf16x8*)(V_lds + (bsel) * SHM_V + vst1) = tobf(vs1); const int kc = sc * 2; \
        *(bf16x8*)(K_lds + (bsel) * SHM_K + KSWZ(sr, kc)) = tobf(ks0); *(bf16x8*)(K_lds + (bsel) * SHM_K + KSWZ(32 + sr, kc)) = tobf(ks1); } while (0)
    SLOAD(0); VM_WAIT(); SWRITE(0); SLOAD(1); __syncthreads();
    for (int j = 0; j < NTS; ++j) {
        if (j + 1 < NTS) { VM_WAIT(); SWRITE((j + 1) & 1); if (j + 2 < NTS) SLOAD(j + 2); }
        if (wid == (j & 7)) {
            const int bsel = j & 1;
            const unsigned long long mw = cmrow[j];
            f32x16 p0, p1; float mn, al; bf16x8 pa0, pa1, pa2, pa3; unsigned mh;
            qkt(p0, p1, K_lds + bsel * SHM_K, qr, r32, hi);
            partialSM(p0, p1, mw, hi, m_reg, mn, al, mh);
            if (__any(al < 1.f)) { if (hi == 0) al_l[r32] = al; asm volatile("s_waitcnt lgkmcnt(0)" ::: "memory");
#pragma unroll
                for (int d = 0; d < 4; ++d)
#pragma unroll
                    for (int r = 0; r < 16; ++r) o[d][r] *= al_l[crow(r, hi)]; }
            finishSM(p0, p1, al, mh, l_reg, pa0, pa1, pa2, pa3); SBAR();
            pv_d0(o, vb0 + bsel * (int)SHM_V, pa0, pa1, pa2, pa3);
        }
        __syncthreads();
    }
    {
        float* ol = (float*)(lds + wid * 16384);
#pragma unroll
        for (int r = 0; r < 16; ++r) { const int orow = crow(r, hi);
#pragma unroll
            for (int d0 = 0; d0 < 4; ++d0) ol[orow * 128 + d0 * 32 + r32] = o[d0][r]; }
        if (hi == 0) { mlt[(wid * 32 + r32) * 2] = m_reg; mlt[(wid * 32 + r32) * 2 + 1] = l_reg; }
        asm volatile("s_waitcnt lgkmcnt(0)" ::: "memory");
        __syncthreads();
        constexpr float C = 1.f;
        const int tk = wid, hq = lane >> 4, row = tk * 4 + hq;
        float mx = -1e30f;
#pragma unroll
        for (int w2 = 0; w2 < 8; ++w2) mx = fmaxf(mx, mlt[(w2 * 32 + row) * 2]);
        float fw[8]; float den = 0.f;
#pragma unroll
        for (int w2 = 0; w2 < 8; ++w2) { fw[w2] = __builtin_amdgcn_exp2f((mlt[(w2 * 32 + row) * 2] - mx) * C); den += fw[w2] * mlt[(w2 * 32 + row) * 2 + 1]; }
        const float rden = __builtin_amdgcn_rcpf(den);
        f32x8 ov = f32x8{};
#pragma unroll
        for (int w2 = 0; w2 < 8; ++w2) { const f32x8 x = *(const f32x8*)((float*)(lds + w2 * 16384) + row * 128 + (lane & 15) * 8); ov += x * fw[w2]; }
        ov = ov * rden;
        const GAS bf16* ub = (const GAS bf16*)(ws + WS_UB); const GAS bf16* bgb = (const GAS bf16*)(ws + WS_BG); const GAS bf16* sgab = (const GAS bf16*)(ws + WS_SGA);
        GAS bf16* merged = (GAS bf16*)(ws + WS_MERGED);
        karg_t* kp2 = kargs(); const GAS float* conv_w = INPTR(float, kp2, I_CONVW); const GAS float* state_conv = INPTR(float, kp2, I_SC);
        const int ch = kvh * 512 + lane * 8;
        const f32x8 w0 = *(const GAS f32x8*)(conv_w + ch), w1 = *(const GAS f32x8*)(conv_w + D + ch), w2v = *(const GAS f32x8*)(conv_w + 2 * D + ch);
        const int t = tk; const size_t off = (size_t)(mrow0 + tk) * D + ch;
        const bf16x8 sg = *(const GAS bf16x8*)(sgab + off), bg = *(const GAS bf16x8*)(bgb + off), u2 = *(const GAS bf16x8*)(ub + off);
        f32x8 u1, u0;
        if (t >= 1) { const bf16x8 x = *(const GAS bf16x8*)(ub + off - D);
#pragma unroll
            for (int e = 0; e < 8; ++e) u1[e] = bf2f((unsigned short)x[e]); }
        else u1 = *(const GAS f32x8*)(state_conv + ((size_t)b * 2 + 1) * D + ch);
        if (t >= 2) { const bf16x8 x = *(const GAS bf16x8*)(ub + off - 2 * D);
#pragma unroll
            for (int e = 0; e < 8; ++e) u0[e] = bf2f((unsigned short)x[e]); }
        else u0 = *(const GAS f32x8*)(state_conv + ((size_t)b * 2 + t) * D + ch);
        float val[8];
#pragma unroll
        for (int e = 0; e < 8; ++e) { const float cv = w0[e] * u0[e] + w1[e] * u1[e] + w2v[e] * bf2f((unsigned short)u2[e]);
            val[e] = bf2f((unsigned short)sg[e]) * ov[e] + bf2f((unsigned short)bg[e]) * cv; }
        v4u pk = {cvtpk(val[0], val[1]), cvtpk(val[2], val[3]), cvtpk(val[4], val[5]), cvtpk(val[6], val[7])};
        st16<true>(merged, off * 2, (size_t)M * D * 2, pk);
        asm volatile("s_waitcnt vmcnt(0)" ::: "memory");
        if (lane == 0) __hip_atomic_fetch_add((unsigned*)(F.ctl + CW_DEP) + (size_t)(3 * 128 + (mrow0 >> 8)) * 64, 1u, __ATOMIC_RELAXED, __HIP_MEMORY_SCOPE_AGENT);
    }
#undef SLOAD
#undef SWRITE
}
__device__ __forceinline__ void p4_attention(Frame& F, char* lds_generic) {
    char* lds = lds_generic + RING_OFF;
    const int grp = __builtin_amdgcn_readfirstlane(((int)blockIdx.x >> 3) & 1);
#pragma unroll 1
    for (int step = 0; step < 2; ++step) {
        const int kind = __builtin_amdgcn_readfirstlane(step ^ grp);
        if (kind == 0) {
            for (int it = blockIdx.x; it < 256; it += F.G) attn_sample_unit(F, it >> 1, it & 1, lds);
        } else {
            for (int it = blockIdx.x; it < 256; it += F.G) {
                const int combo = it & 7, i = it >> 3, b = combo >> 1, kvh = combo & 1;
                for (int h2 = 0; h2 < 2; ++h2) { const int qt = h2 ? i : 63 - i;
                    if (attn_unit<false, true>(F, b, kvh, qt, lds)) attn_unit<false, false>(F, b, kvh, qt, lds); }
            }
        }
    }
}

__device__ __forceinline__ void p9_final(Frame& F) {
    const int lane = lane_opaque(), w = F.wave;
    const GAS float* part3 = (const GAS float*)(F.ws + WS_PART3); const GAS bf16* x3b = (const GAS bf16*)(F.ws + WS_X3B);
    karg_t* kp = kargs(); const GAS f32x4* gr = (const GAS f32x4*)INPTR(float, kp, I_NFIN);
    f32x4 g4[4];
#pragma unroll
    for (int j = 0; j < 4; ++j) g4[j] = gr[(j >> 1) * 128 + 2 * lane + (j & 1)];
    unsigned* qc = (unsigned*)(F.ctl + CW_Q + 2 * 64); unsigned* bank = (unsigned*)(F.ctl + CW_DEP) + (size_t)4 * 128 * 64;
    for (;;) {
        __syncthreads();
        if (w == 0) { unsigned c = 0u; if (lane == 0) c = __hip_atomic_fetch_add(qc, 1u, __ATOMIC_RELAXED, __HIP_MEMORY_SCOPE_AGENT);
            c = (unsigned)__builtin_amdgcn_readfirstlane((int)c);
            if (c < (unsigned)(M / 32)) { const int pi = (int)c >> 3, pm = pi < 4 ? 64 + pi : 8 * ((pi - 4) & 7) + ((pi - 4) >> 3);
                unsigned* cw = bank + (size_t)pm * 64; unsigned polls = 0;
                while ((unsigned)__builtin_amdgcn_readfirstlane(__hip_atomic_load(cw, __ATOMIC_RELAXED, __HIP_MEMORY_SCOPE_AGENT)) < 32u) { if (++polls > (1u << 18)) break; __builtin_amdgcn_s_sleep(2); }
                __builtin_amdgcn_fence(__ATOMIC_ACQUIRE, "agent");
                asm volatile("s_waitcnt vmcnt(0)" ::: "memory");
                c = (unsigned)(pm * 8 + ((int)c & 7)); }
            else c = 0xffffffffu;
            if (lane == 0) F.MISC[16] = c; LDS_WAIT(); }
        __syncthreads();
        const unsigned ch = F.MISC[16];
        if (ch == 0xffffffffu) break;
        const int r0 = (int)ch * 32 + w * 4;
#pragma unroll
        for (int h = 0; h < 1; ++h) {
            v4u v[4][2]; float rs[4];
#pragma unroll
            for (int u = 0; u < 4; ++u) { const int m = r0 + 4 * h + u; rs[u] = row_rs(part3, m);
                const GAS v4u* xr = (const GAS v4u*)(x3b + (size_t)m * D) + lane; v[u][0] = xr[0]; v[u][1] = xr[64]; }
#pragma unroll
            for (int u = 0; u < 4; ++u) { const int m = r0 + 4 * h + u; GAS f32x4* yr = (GAS f32x4*)(F.out + O_Y + (size_t)m * D);
#pragma unroll
                for (int hh = 0; hh < 2; ++hh) { f32x4 a, b; unpack8(v[u][hh], a, b);
                    yr[hh * 128 + 2 * lane] = a * rs[u] * g4[2 * hh]; yr[hh * 128 + 2 * lane + 1] = b * rs[u] * g4[2 * hh + 1]; } }
        }
    }
}

__global__ void __launch_bounds__(NWAVES * 64, 2) mk_fwd(Args args) {
    extern __shared__ __attribute__((aligned(16))) unsigned char lds[];
    Frame F;
    F.lds = (LAS unsigned char*)lds;
    F.MISC = (volatile LAS unsigned*)(F.lds + MISC_OFF);
    F.tid = threadIdx.x; F.lane = F.tid & 63; F.wave = __builtin_amdgcn_readfirstlane(F.tid >> 6);
    F.G = gridDim.x;
    karg_t* kp0 = kargs();
    GAS unsigned char* ws = (GAS unsigned char*)kp0[21]; F.ws = ws; F.out = (GAS float*)kp0[20];
    F.ctl = (gu32*)(ws + WS_CTL);
    for (int u = F.tid; u < (LDS_BYTES - LDSCTL_OFF) / 4; u += NWAVES * 64) ((LAS unsigned*)(F.lds + LDSCTL_OFF))[u] = 0u;
    __syncthreads();
    const int lo = args.ph_lo, hi = args.ph_hi; F.qoff = args.qoff;
    const bool multi = (hi - lo) > 1;
    XcdBarrier bar; bar.bar = (unsigned*)(F.ctl + CW_BAR); bar.x = 0; bar.st = nullptr;
    if (multi) bar = xcd_barrier_post((unsigned*)(F.ctl + CW_BAR), F.MISC + 8, F.tid);
#ifndef PHASE_MASK
#define PHASE_MASK 0xfff
#endif
#define IN(k) (((PHASE_MASK >> (k)) & 1) && lo <= (k) && (k) < hi && (F.lane = lane_opaque(), F.tid = F.wave * 64 + F.lane, true))
#define INP(k) (((PHASE_MASK >> (k)) & 1) && lo <= (k) && (k) < hi)
#define SEAM(k) do { if (INP(k) && INP((k) + 1)) xcd_barrier(bar, F.wave * 64 + lane_opaque()); } while (0)
    using pg8::Gemm; using pg8::StaticOrder;
    const GAS bf16* HB = (const GAS bf16*)(ws + WS_HB);

    if (IN(0)) { if (blockIdx.x == 0 && F.tid < 8) __hip_atomic_store((unsigned*)(F.ctl + CW_Q + 64 * F.tid), 0u, RLX_AGENT);
                 p0_prologue(F); } SEAM(0);

    if (IN(1)) {
        { Gemm g{HB, (const GAS bf16*)(ws + WS_WIN), M, NIN, D}; StaticOrder S; S.init(M, NIN, F.G, (int)blockIdx.x);
          EpiIn E{(GAS bf16*)(ws + WS_QB), (GAS bf16*)(ws + WS_KB), (GAS bf16*)(ws + WS_VB), (GAS bf16*)(ws + WS_QIB), (GAS bf16*)(ws + WS_KIB), (GAS bf16*)(ws + WS_UB), (GAS bf16*)(ws + WS_BG), (GAS bf16*)(ws + WS_SGA),
                  (GAS float*)(ws + WS_WI), (const GAS float2*)(ws + WS_CS128), (const GAS float2*)(ws + WS_CS64), F.out};
          pg8::gemm_phase<EpiIn, StaticOrder, true, true>(F.lds + RING_OFF, g, S, E, F.wave * 64 + lane_opaque()); }
    } SEAM(1);

    if (IN(2)) { p2_index_select(F); }
    if (IN(3)) { p4_attention(F, (char*)lds); }

    if (IN(4)) {
        pg8::Stream S;
        S.A[0] = WS_PB; S.Bt[0] = WS_WPLE; S.nN[0] = D / 256;   S.K[0] = DPLE; S.dep[0] = -1; S.need[0] = 0;                S.pub[0] = 2;
        S.A[1] = WS_MERGED; S.Bt[1] = WS_WOUT; S.nN[1] = D / 256;   S.K[1] = D;    S.dep[1] = 3;  S.need[1] = 64; S.need1_hi = 512;  S.pub[1] = 0;
        S.A[2] = WS_X1B; S.Bt[2] = WS_WGU;  S.nN[2] = NGU / 256; S.K[2] = D;    S.dep[2] = 0;  S.need[2] = 8 * (D / 256);    S.pub[2] = 1;
        S.A[3] = WS_ACT; S.Bt[3] = WS_WDN;  S.nN[3] = D / 256;   S.K[3] = DFF;  S.dep[3] = 1;  S.need[3] = 8 * (NGU / 256);  S.pub[3] = 2;
        S.A[4] = WS_X2B; S.Bt[4] = WS_WPG;  S.nN[4] = D / 256;   S.K[4] = D;    S.dep[4] = 2;  S.need[4] = 16 * (D / 256);   S.pub[4] = 4;
        S.nM = M / 256; S.first[0] = 0;
        S.first[1] = S.first[0] + S.nM * S.nN[0]; S.first[2] = S.first[1] + S.nM * S.nN[1]; S.first[3] = S.first[2] + S.nM * S.nN[2]; S.first[4] = S.first[3] + S.nM * S.nN[3]; S.first[5] = S.first[4] + S.nM * S.nN[4];
        S.base = ws; S.cnt = (unsigned*)(F.ctl + CW_DEP); S.G = F.G; S.c = (int)blockIdx.x;
        karg_t* kp = kargs();
        EpiStream E{ws, F.out, INPTR(float, kp, I_XP), INPTR(float, kp, I_XS)};
        pg8::gemm_stream<EpiStream>(F.lds + RING_OFF, S, E, F.wave * 64 + lane_opaque(), F.MISC + 20);
    }

    if (IN(5)) { p9_final(F); }
#undef IN
#undef SEAM
}

extern "C" void kernel_launch(void* const* d_in, const int* in_sizes, int n_in, void* d_out, int out_size, void* d_ws, size_t ws_size, hipStream_t stream) {
    static int grid = 0;
    if (grid == 0) {
        if (n_in != 20 || out_size != (int)O_END || ws_size < WS_END) { fprintf(stderr, "kernel_launch: unexpected shapes: n_in %d out %d ws %zu (need %zu)\n", n_in, out_size, ws_size, (size_t)WS_END); grid = -1; return; }
        int dev = 0, cus = 0;
        if (hipGetDevice(&dev) != hipSuccess || hipDeviceGetAttribute(&cus, hipDeviceAttributeMultiprocessorCount, dev) != hipSuccess) { grid = -1; return; }
        if (hipFuncSetAttribute((const void*)mk_fwd, hipFuncAttributeMaxDynamicSharedMemorySize, LDS_BYTES) != hipSuccess) { fprintf(stderr, "kernel_launch: hipFuncSetAttribute failed\n"); grid = -1; return; }
        int nb = 0;
        if (hipOccupancyMaxActiveBlocksPerMultiprocessor(&nb, (const void*)mk_fwd, NWAVES * 64, LDS_BYTES) != hipSuccess || nb < 1) { fprintf(stderr, "kernel_launch: occupancy query failed (%d)\n", nb); grid = -1; return; }
        (void)hipGetLastError();
        grid = cus;
    }
    if (grid < 0) return;
    if (hipMemsetAsync((char*)d_ws + WS_CTL, 0, CTL_ZERO_BYTES, stream) != hipSuccess) { fprintf(stderr, "kernel_launch: memset failed\n"); return; }
    Args a{};
    for (int i = 0; i < 20; ++i) a.in[i] = d_in[i];
    a.out = (float*)d_out; a.ws = (unsigned char*)d_ws;
#if MK_ONE_LAUNCH
    a.ph_lo = 0; a.ph_hi = NPHASE;
    hipLaunchKernelGGL(mk_fwd, dim3(grid), dim3(NWAVES * 64), LDS_BYTES, stream, a);
#else
    for (int p = 0; p < NPHASE; ++p) { a.ph_lo = p; a.ph_hi = p + 1; a.qoff = 0; hipLaunchKernelGGL(mk_fwd, dim3(grid), dim3(NWAVES * 64), LDS_BYTES, stream, a); }
#endif
    const hipError_t le = hipPeekAtLastError();
    if (le != hipSuccess) fprintf(stderr, "kernel_launch: launch failed: %s\n", hipGetErrorName(le));
}
```

```cpp
#include <hip/hip_runtime.h>
#include <cstdio>
#include <cstdint>
#include <type_traits>

#ifndef MK_ONE_LAUNCH
#define MK_ONE_LAUNCH 1
#endif

__constant__ const unsigned int STREAM_SCHED[32 * 12] = {
    0x0100, 0x0120, 0x023a, 0x0250, 0x0266, 0x027e, 0x029e, 0x0003, 0x0012, 0x001a, 0x0400, 0x0408,
    0x0101, 0x0121, 0x023b, 0x0251, 0x0267, 0x027f, 0x029f, 0x0004, 0x0013, 0x001b, 0x0401, 0x0409,
    0x0102, 0x0200, 0x0300, 0x0268, 0x0280, 0x02a0, 0x0008, 0x030a, 0x040a, 0xffffu, 0xffffu, 0xffffu,
    0x0103, 0x0201, 0x0301, 0x0269, 0x0281, 0x02a1, 0x0009, 0x030b, 0x040b, 0xffffu, 0xffffu, 0xffffu,
    0x0104, 0x0202, 0x021e, 0x0302, 0x0282, 0x02a2, 0x000a, 0x030c, 0x040c, 0xffffu, 0xffffu, 0xffffu,
    0x0105, 0x0203, 0x021f, 0x0303, 0x0283, 0x02a3, 0x000b, 0x030d, 0x040d, 0xffffu, 0xffffu, 0xffffu,
    0x0106, 0x0204, 0x0220, 0x0304, 0x0284, 0x02a4, 0x000c, 0x030e, 0x040e, 0xffffu, 0xffffu, 0xffffu,
    0x0107, 0x0205, 0x0221, 0x0305, 0x0285, 0x02a5, 0x000d, 0x030f, 0x040f, 0xffffu, 0xffffu, 0xffffu,
    0x0108, 0x0206, 0x0222, 0x0306, 0x0286, 0x02a6, 0x000e, 0x0310, 0x0410, 0xffffu, 0xffffu, 0xffffu,
    0x0109, 0x0207, 0x0223, 0x0307, 0x0287, 0x02a7, 0x000f, 0x0311, 0x0411, 0xffffu, 0xffffu, 0xffffu,
    0x010a, 0x0208, 0x0224, 0x0308, 0x0288, 0x02a8, 0x0010, 0x0312, 0x0412, 0xffffu, 0xffffu, 0xffffu,
    0x010b, 0x0209, 0x0225, 0x0309, 0x0289, 0x02a9, 0x0011, 0x0313, 0x0413, 0xffffu, 0xffffu, 0xffffu,
    0x010c, 0x020a, 0x0226, 0x023c, 0x0252, 0x026a, 0x028a, 0x02aa, 0x0314, 0x0414, 0xffffu, 0xffffu,
    0x010d, 0x020b, 0x0227, 0x023d, 0x0253, 0x026b, 0x028b, 0x02ab, 0x0315, 0x0415, 0xffffu, 0xffffu,
    0x010e, 0x020c, 0x0228, 0x023e, 0x0254, 0x026c, 0x028c, 0x02ac, 0x0316, 0x0416, 0xffffu, 0xffffu,
    0x010f, 0x020d, 0x0229, 0x023f, 0x0255, 0x026d, 0x028d, 0x02ad, 0x0317, 0x0417, 0xffffu, 0xffffu,
    0x0110, 0x020e, 0x022a, 0x0240, 0x0256, 0x026e, 0x028e, 0x02ae, 0x0318, 0x0418, 0xffffu, 0xffffu,
    0x0111, 0x020f, 0x022b, 0x0241, 0x0257, 0x026f, 0x028f, 0x02af, 0x0319, 0x0419, 0xffffu, 0xffffu,
    0x0112, 0x0210, 0x022c, 0x0242, 0x0258, 0x0270, 0x0290, 0x02b0, 0x031a, 0x041a, 0xffffu, 0xffffu,
    0x0113, 0x0211, 0x022d, 0x0243, 0x0259, 0x0271, 0x0291, 0x02b1, 0x031b, 0x041b, 0xffffu, 0xffffu,
    0x0114, 0x0212, 0x022e, 0x0244, 0x025a, 0x0272, 0x0292, 0x02b2, 0x031c, 0x041c, 0xffffu, 0xffffu,
    0x0115, 0x0213, 0x022f, 0x0245, 0x025b, 0x0273, 0x0293, 0x02b3, 0x031d, 0x041d, 0xffffu, 0xffffu,
    0x0116, 0x0214, 0x0230, 0x0246, 0x025c, 0x0274, 0x0294, 0x02b4, 0x031e, 0x041e, 0xffffu, 0xffffu,
    0x0117, 0x0215, 0x0231, 0x0247, 0x025d, 0x0275, 0x0295, 0x02b5, 0x031f, 0x041f, 0xffffu, 0xffffu,
    0x0118, 0x0216, 0x0232, 0x0248, 0x025e, 0x0276, 0x0296, 0x02b6, 0x0320, 0x0420, 0xffffu, 0xffffu,
    0x0119, 0x0217, 0x0233, 0x0249, 0x025f, 0x0277, 0x0297, 0x02b7, 0x0321, 0x0421, 0xffffu, 0xffffu,
    0x011a, 0x0218, 0x0234, 0x024a, 0x0260, 0x0278, 0x0298, 0x02b8, 0x0017, 0x001f, 0x0405, 0xffffu,
    0x011b, 0x0219, 0x0235, 0x024b, 0x0261, 0x0279, 0x0299, 0x02b9, 0x0018, 0x0020, 0x0406, 0xffffu,
    0x011c, 0x021a, 0x0236, 0x024c, 0x0262, 0x027a, 0x029a, 0x02ba, 0x0019, 0x0021, 0x0407, 0xffffu,
    0x011d, 0x021b, 0x0237, 0x024d, 0x0263, 0x027b, 0x029b, 0x0000, 0x0005, 0x0014, 0x001c, 0x0402,
    0x011e, 0x021c, 0x0238, 0x024e, 0x0264, 0x027c, 0x029c, 0x0001, 0x0006, 0x0015, 0x001d, 0x0403,
    0x011f, 0x021d, 0x0239, 0x024f, 0x0265, 0x027d, 0x029d, 0x0002, 0x0007, 0x0016, 0x001e, 0x0404,
};
namespace pg8 {
#define PG8_LAS __attribute__((address_space(3)))
typedef unsigned short bf16_t;
typedef short bf16x8 __attribute__((ext_vector_type(8)));
typedef float f32x4 __attribute__((ext_vector_type(4)));
typedef unsigned u32x4 __attribute__((ext_vector_type(4)));
typedef unsigned u32x2 __attribute__((ext_vector_type(2)));
constexpr int BM = 256, BK = 64, HALF = 128, HTB = HALF * BK * 2, STAGE_BYTES = 8 * HTB, NXCD = 8, WGM = 8;

__host__ __device__ __forceinline__ int lds_byte(int r, int c) { const int st = (r >> 4) * 2 + (c >> 5), rr = r & 15, cc = c & 31, ob = rr * 64 + cc * 2; return st * 1024 + (ob ^ (((ob >> 9) & 1) << 5)); }
__host__ __device__ __forceinline__ void stage_rc(int b, int& R, int& C) { const int st = b / 1024, sb = b % 1024, swz = sb ^ (((sb >> 9) & 1) << 5); R = (st >> 1) * 16 + swz / 64; C = (st & 1) * 32 + (swz % 64) / 2; }

struct Unit { int pm, pn; };
#define PG8_GAS __attribute__((address_space(1)))
struct Gemm { const PG8_GAS bf16_t* A; const PG8_GAS bf16_t* Bt; int M, N, K; };

struct StaticOrder {
    int nM, nN, nwg, G, c;
    __host__ __device__ void init(int M, int N, int G_, int c_) { nM = M / BM; nN = N / BM; nwg = nM * nN; G = G_; c = c_; }
    __host__ __device__ bool next(int i, Unit& u) const {
        const long L = (long)i * G + c; if (L >= nwg) return false;
        int wgid = (int)L; { const int q = nwg / NXCD, r = nwg % NXCD, xcd = wgid % NXCD, off = wgid / NXCD; wgid = (xcd < r ? xcd * (q + 1) : r * (q + 1) + (xcd - r) * q) + off; }
        const int nig = WGM * nN, gid = wgid / nig, fm = gid * WGM, gsz = (nM - fm) < WGM ? (nM - fm) : WGM;
        u.pm = fm + ((wgid % nig) % gsz); u.pn = (wgid % nig) / gsz; return true;
    }
    __device__ __forceinline__ void a_ready(const Unit&) const {}
    __device__ __forceinline__ void done(const Unit&) const {}
};

typedef float f32x2c __attribute__((ext_vector_type(2)));
typedef __bf16 bf16x2c __attribute__((ext_vector_type(2)));
__device__ __forceinline__ unsigned cvt_pk_bf16(float lo, float hi) { const f32x2c v = {lo, hi}; const bf16x2c r = __builtin_convertvector(v, bf16x2c); return __builtin_bit_cast(unsigned, r); }

__host__ __device__ __forceinline__ int perm32(int rho);
template <class Epi, class Sched, bool ALIGN_EPI = false, bool SP2 = false>
__device__ __forceinline__ void gemm_phase(PG8_LAS unsigned char* lds, const Gemm g, const Sched& S, const Epi& E, const int tid) {
    const int wid = __builtin_amdgcn_readfirstlane(tid >> 6), lane = tid & 63, wr = wid >> 2, wc = wid & 3, fr = lane & 15, fq = lane >> 4;
    const int K = g.K, nt = K / BK;
    unsigned voffA[2], voffB[2];
#pragma unroll
    for (int i = 0; i < 2; ++i) { int R, C; stage_rc(tid * 16 + i * 8192, R, C);
        voffA[i] = (unsigned)(R * K + C) * 2u; voffB[i] = (unsigned)(((R & ~31) + perm32(R & 31)) * K + C) * 2u; }
    const size_t kstep = (size_t)(BK * 2);
    const size_t hstep = (size_t)HALF * K * 2;
    const size_t tstep = 2 * hstep;
    const unsigned ldsw = (unsigned)wid * 1024u;
    const int aoff = lds_byte(wr * 64 + fr, fq * 8), boff = lds_byte(wc * 32 + fr, fq * 8);
#define PG8_SA(b, h) (((b) * 2 + (h)) * HTB)
#define PG8_SB(b, h) ((4 + (b) * 2 + (h)) * HTB)
#define PG8_STAGE(bufoff, gbase, voff) do { _Pragma("unroll") for (int _i = 0; _i < 2; ++_i) \
        __builtin_amdgcn_global_load_lds((const PG8_GAS unsigned*)((gbase) + (voff)[_i]), (PG8_LAS unsigned*)(lds + (bufoff) + ldsw + _i * 8192), 16, 0, 0); } while (0)
#define PG8_LDA(dst, b, h) do { _Pragma("unroll") for (int m = 0; m < 4; ++m) _Pragma("unroll") for (int k = 0; k < 2; ++k) dst[m][k] = *(const PG8_LAS bf16x8*)(lds + PG8_SA(b, h) + aoff + m * 2048 + k * 1024); } while (0)
#define PG8_LDB(dst, b, h) do { _Pragma("unroll") for (int n = 0; n < 2; ++n) _Pragma("unroll") for (int k = 0; k < 2; ++k) dst[n][k] = *(const PG8_LAS bf16x8*)(lds + PG8_SB(b, h) + boff + n * 2048 + k * 1024); } while (0)
#define PG8_MMA(ai, bj, At, Bt) do { __builtin_amdgcn_s_setprio(1); _Pragma("unroll") for (int m = 0; m < 4; ++m) _Pragma("unroll") for (int n = 0; n < 2; ++n) _Pragma("unroll") for (int k = 0; k < 2; ++k) \
        acc[ai][bj][m][n] = __builtin_amdgcn_mfma_f32_16x16x32_bf16(Bt[n][k], At[m][k], acc[ai][bj][m][n], 0, 0, 0); __builtin_amdgcn_s_setprio(0); } while (0)
#define PG8_WAIT_V(n) asm volatile("s_waitcnt vmcnt(" #n ")" ::: "memory")
#define PG8_WAIT_L(n) asm volatile("s_waitcnt lgkmcnt(" #n ")" ::: "memory")
#define PG8_BAR __builtin_amdgcn_s_barrier()
#define PG8_SCHED __builtin_amdgcn_sched_barrier(0)
    Unit cur, nxt; int ui = 0;
    if (!S.next(0, cur)) return;
    f32x4 acc[2][2][4][2];
#pragma unroll
    for (int a = 0; a < 2; ++a)
#pragma unroll
        for (int b = 0; b < 2; ++b)
#pragma unroll
            for (int m = 0; m < 4; ++m)
#pragma unroll
                for (int n = 0; n < 2; ++n) acc[a][b][m][n] = (f32x4){0.f, 0.f, 0.f, 0.f};
    bf16x8 At[4][2], B0[2][2], B1[2][2];
    const PG8_GAS char* cA = (const PG8_GAS char*)g.A + (size_t)cur.pm * tstep; const PG8_GAS char* cB = (const PG8_GAS char*)g.Bt + (size_t)cur.pn * tstep;
    S.a_ready(cur);
    if constexpr (SP2) {
        PG8_STAGE(PG8_SB(0, 0), cB, voffB); PG8_STAGE(PG8_SB(0, 1), cB + hstep, voffB); PG8_STAGE(PG8_SA(0, 0), cA, voffA); PG8_STAGE(PG8_SA(0, 1), cA + hstep, voffA);
        if (wr == 1) PG8_BAR;
        PG8_WAIT_V(2); PG8_BAR;
        PG8_STAGE(PG8_SB(1, 0), cB + kstep, voffB); PG8_STAGE(PG8_SA(1, 0), cA + kstep, voffA); PG8_STAGE(PG8_SB(1, 1), cB + hstep + kstep, voffB);
        PG8_WAIT_V(6); PG8_BAR;
    } else {
        PG8_STAGE(PG8_SB(0, 0), cB, voffB); PG8_STAGE(PG8_SA(0, 0), cA, voffA); PG8_STAGE(PG8_SB(0, 1), cB + hstep, voffB); PG8_STAGE(PG8_SA(0, 1), cA + hstep, voffA);
        if (wr == 1) PG8_BAR;
        PG8_WAIT_V(4); PG8_BAR;
        PG8_STAGE(PG8_SB(1, 0), cB + kstep, voffB); PG8_STAGE(PG8_SA(1, 0), cA + kstep, voffA); PG8_STAGE(PG8_SB(1, 1), cB + hstep + kstep, voffB);
        PG8_WAIT_V(6); PG8_BAR;
    }
    for (;;) {
        const bool has_next = S.next(ui + 1, nxt);
        const PG8_GAS char* nA = has_next ? (const PG8_GAS char*)g.A + (size_t)nxt.pm * tstep : cA; const PG8_GAS char* nB = has_next ? (const PG8_GAS char*)g.Bt + (size_t)nxt.pn * tstep : cB;
        for (int t = 0; t < nt; t += 2) {
            const bool last = (t == nt - 2);
            const PG8_GAS char* a1 = cA + (size_t)(t + 1) * kstep;
            const PG8_GAS char* a2 = last ? nA : cA + (size_t)(t + 2) * kstep; const PG8_GAS char* b2 = last ? nB : cB + (size_t)(t + 2) * kstep;
            const PG8_GAS char* a3 = a2 + kstep; const PG8_GAS char* b3 = b2 + kstep;
            if (last && has_next) S.a_ready(nxt);
            if constexpr (SP2) {
            PG8_LDB(B0, 0, 0); PG8_LDB(B1, 0, 1); PG8_SCHED; PG8_LDA(At, 0, 0); PG8_STAGE(PG8_SA(1, 1), a1 + hstep, voffA);
            PG8_WAIT_V(8); PG8_WAIT_L(0); PG8_BAR; PG8_MMA(0, 0, At, B0); PG8_MMA(0, 1, At, B1); PG8_BAR; PG8_SCHED;
            PG8_LDA(At, 0, 1); PG8_STAGE(PG8_SB(0, 0), b2, voffB); PG8_STAGE(PG8_SB(0, 1), b2 + hstep, voffB); PG8_STAGE(PG8_SA(0, 0), a2, voffA);
            PG8_WAIT_V(8); PG8_WAIT_L(0); PG8_BAR; PG8_MMA(1, 0, At, B0); PG8_MMA(1, 1, At, B1); PG8_BAR; PG8_SCHED;
            PG8_LDB(B0, 1, 0); PG8_LDB(B1, 1, 1); PG8_SCHED; PG8_LDA(At, 1, 0); PG8_STAGE(PG8_SA(0, 1), a2 + hstep, voffA);
            PG8_WAIT_V(8); PG8_WAIT_L(0); PG8_BAR; PG8_MMA(0, 0, At, B0); PG8_MMA(0, 1, At, B1); PG8_BAR; PG8_SCHED;
            PG8_LDA(At, 1, 1); PG8_STAGE(PG8_SB(1, 0), b3, voffB); PG8_STAGE(PG8_SB(1, 1), b3 + hstep, voffB); PG8_STAGE(PG8_SA(1, 0), a3, voffA);
            PG8_WAIT_V(8); PG8_WAIT_L(0); PG8_BAR; PG8_MMA(1, 0, At, B0); PG8_MMA(1, 1, At, B1); PG8_BAR; PG8_SCHED;
            } else {
            PG8_LDB(B0, 0, 0); PG8_SCHED; PG8_LDA(At, 0, 0); PG8_STAGE(PG8_SA(1, 1), a1 + hstep, voffA);
            PG8_WAIT_L(8); PG8_BAR; PG8_WAIT_L(0); PG8_MMA(0, 0, At, B0); PG8_BAR; PG8_SCHED;
            PG8_LDB(B1, 0, 1); PG8_STAGE(PG8_SB(0, 0), b2, voffB);
            PG8_BAR; PG8_WAIT_L(0); PG8_MMA(0, 1, At, B1); PG8_BAR;
            PG8_LDA(At, 0, 1); PG8_STAGE(PG8_SA(0, 0), a2, voffA);
            PG8_BAR; PG8_WAIT_L(0); PG8_MMA(1, 0, At, B0); PG8_BAR; PG8_SCHED;
            PG8_STAGE(PG8_SB(0, 1), b2 + hstep, voffB);
            PG8_WAIT_V(6); PG8_BAR; PG8_MMA(1, 1, At, B1); PG8_BAR;
            PG8_LDB(B0, 1, 0); PG8_SCHED; PG8_LDA(At, 1, 0); PG8_STAGE(PG8_SA(0, 1), a2 + hstep, voffA);
            PG8_WAIT_L(8); PG8_BAR; PG8_WAIT_L(0); PG8_MMA(0, 0, At, B0); PG8_BAR; PG8_SCHED;
            PG8_LDB(B1, 1, 1); PG8_STAGE(PG8_SB(1, 0), b3, voffB);
            PG8_BAR; PG8_WAIT_L(0); PG8_MMA(0, 1, At, B1); PG8_BAR;
            PG8_LDA(At, 1, 1); PG8_STAGE(PG8_SA(1, 0), a3, voffA);
            PG8_BAR; PG8_WAIT_L(0); PG8_MMA(1, 0, At, B0); PG8_BAR; PG8_SCHED;
            PG8_STAGE(PG8_SB(1, 1), b3 + hstep, voffB);
            PG8_WAIT_V(6); PG8_BAR; PG8_MMA(1, 1, At, B1); PG8_BAR;
            }
        }
        if constexpr (ALIGN_EPI) { if (wr == 0) PG8_BAR; }
        E(acc, cur, wr, wc, fr, fq); S.done(cur);
        if (!has_next) break;
#pragma unroll
        for (int a = 0; a < 2; ++a)
#pragma unroll
            for (int b = 0; b < 2; ++b)
#pragma unroll
                for (int m = 0; m < 4; ++m)
#pragma unroll
                    for (int n = 0; n < 2; ++n) acc[a][b][m][n] = (f32x4){0.f, 0.f, 0.f, 0.f};
        cur = nxt; cA = nA; cB = nB; ++ui;
        if constexpr (ALIGN_EPI) { if (wr == 1) PG8_BAR; }
    }
    PG8_WAIT_V(0);
    if constexpr (!ALIGN_EPI) { if (wr == 0) PG8_BAR; }
    PG8_BAR;
#undef PG8_SA
#undef PG8_SB
#undef PG8_STAGE
#undef PG8_LDA
#undef PG8_LDB
#undef PG8_MMA
#undef PG8_WAIT_V
#undef PG8_WAIT_L
#undef PG8_BAR
#undef PG8_SCHED
}

__host__ __device__ __forceinline__ int perm32(int rho) { const int n = rho >> 4, i = rho & 15; return 8 * (i >> 2) + 4 * n + (i & 3); }
struct SUnit { int pm, pn, s; };
struct Stream {
    const PG8_GAS unsigned char* base; size_t A[5], Bt[5]; int nN[5], K[5], first[6], dep[5], need[5], pub[5];
    unsigned* cnt; int nM, G, c, need1_hi;
    __device__ __forceinline__ const PG8_GAS bf16_t* a_of(int s) const { return (const PG8_GAS bf16_t*)(base + (s == 0 ? A[0] : s == 1 ? A[1] : s == 2 ? A[2] : s == 3 ? A[3] : A[4])); }
    __device__ __forceinline__ const PG8_GAS bf16_t* b_of(int s) const { return (const PG8_GAS bf16_t*)(base + (s == 0 ? Bt[0] : s == 1 ? Bt[1] : s == 2 ? Bt[2] : s == 3 ? Bt[3] : Bt[4])); }
    __device__ __forceinline__ int k_of(int s) const { return s == 0 ? K[0] : s == 1 ? K[1] : s == 2 ? K[2] : s == 3 ? K[3] : K[4]; }
    __device__ __forceinline__ int nn_of(int s) const { return s == 0 ? nN[0] : s == 1 ? nN[1] : s == 2 ? nN[2] : s == 3 ? nN[3] : nN[4]; }
    __device__ __forceinline__ int dep_of(int s) const { return s == 0 ? dep[0] : s == 1 ? dep[1] : s == 2 ? dep[2] : s == 3 ? dep[3] : dep[4]; }
    __device__ __forceinline__ int need_of(int s) const { return s == 0 ? need[0] : s == 1 ? need[1] : s == 2 ? need[2] : s == 3 ? need[3] : need[4]; }
    __device__ __forceinline__ int need_for(const SUnit& u) const { return (u.s == 1 && u.pm >= 64) ? need1_hi : need_of(u.s); }
    __device__ __forceinline__ int pub_of(int s) const { return s == 0 ? pub[0] : s == 1 ? pub[1] : s == 2 ? pub[2] : s == 3 ? pub[3] : pub[4]; }
    __device__ __forceinline__ bool next(int i, SUnit& u) const {
        if (G == 256 && nM == 68) {
            if (i >= 12) return false;
            const unsigned e = STREAM_SCHED[(c >> 3) * 12 + i];
            if (e == 0xffffu) return false;
            const int s = (int)(e >> 8), j = (int)(e & 255u), x = c & 7, S = nn_of(s) >> 1;
            if (j < S) { const int g = x * S + j; u.pm = 64 + (g & 3); u.pn = g >> 2; }
            else if (s != 2) { const int jj = j - S; u.pm = 8 * x + (jj >> 2); u.pn = jj & 3; }
            else { const int jj = j - S;
                if (jj < 44) { u.pm = 8 * x + (jj & 1); u.pn = jj >> 1; } else { const int j2 = jj - 44; u.pm = 8 * x + 2 + j2 % 6; u.pn = j2 / 6; } }
            u.s = s; return true;
        }
        const int L = i * G + c; if (L >= first[5]) return false;
        const int s = (L >= first[1]) + (L >= first[2]) + (L >= first[3]) + (L >= first[4]);
        const int f = s == 0 ? first[0] : s == 1 ? first[1] : s == 2 ? first[2] : s == 3 ? first[3] : first[4];
        const int nn = nn_of(s), nwg = nM * nn; int wgid = L - f;
        { const int q = nwg / NXCD, r = nwg % NXCD, xcd = wgid % NXCD, off = wgid / NXCD; wgid = (xcd < r ? xcd * (q + 1) : r * (q + 1) + (xcd - r) * q) + off; }
        const int nig = WGM * nn, gid = wgid / nig, fm = gid * WGM, gsz = (nM - fm) < WGM ? (nM - fm) : WGM;
        u.pm = fm + ((wgid % nig) % gsz); u.pn = (wgid % nig) / gsz; u.s = s; return true;
    }
    __device__ __forceinline__ void wait_ready(const SUnit& u, int tid) const {
        const int d = dep_of(u.s);
        if (d < 0) return;
        if (tid < 64) {
            unsigned* w = cnt + (size_t)(d * 128 + u.pm) * 64; const unsigned need_ = (unsigned)need_for(u); unsigned polls = 0;
            while ((unsigned)__builtin_amdgcn_readfirstlane(__hip_atomic_load(w, __ATOMIC_RELAXED, __HIP_MEMORY_SCOPE_AGENT)) < need_) {
                if (++polls > (1u << 18)) break;
                __builtin_amdgcn_s_sleep(2); }
            __builtin_amdgcn_fence(__ATOMIC_ACQUIRE, "agent");
            asm volatile("s_waitcnt vmcnt(0)" ::: "memory");
        }
        asm volatile("" ::: "memory"); __builtin_amdgcn_s_barrier(); asm volatile("" ::: "memory");
    }
    __device__ __forceinline__ bool try_ready(const SUnit& u, int tid, volatile PG8_LAS unsigned* flag) const {
        const int d = dep_of(u.s);
        if (d < 0) return true;
        if (tid < 64) {
            unsigned* w = cnt + (size_t)(d * 128 + u.pm) * 64;
            const bool ok = (unsigned)__builtin_amdgcn_readfirstlane(__hip_atomic_load(w, __ATOMIC_RELAXED, __HIP_MEMORY_SCOPE_AGENT)) >= (unsigned)need_for(u);
            if (ok) { __builtin_amdgcn_fence(__ATOMIC_ACQUIRE, "agent"); asm volatile("s_waitcnt vmcnt(0)" ::: "memory"); }
            if (tid == 0) *flag = ok ? 1u : 0u;
            asm volatile("s_waitcnt lgkmcnt(0)" ::: "memory");
        }
        asm volatile("" ::: "memory"); __builtin_amdgcn_s_barrier(); asm volatile("" ::: "memory");
        return *flag != 0u;
    }
    __device__ __forceinline__ void done(const SUnit& u, int lane) const {
        const int p = pub_of(u.s);
        if (p < 0) return;
        asm volatile("s_waitcnt vmcnt(0)" ::: "memory");
        if (lane == 0) __hip_atomic_fetch_add(cnt + (size_t)(p * 128 + u.pm) * 64, 1u, __ATOMIC_RELAXED, __HIP_MEMORY_SCOPE_AGENT);
    }
};

template <class EpiSet>
__device__ __forceinline__ void gemm_stream(PG8_LAS unsigned char* lds, const Stream& S, const EpiSet& E, const int tid, volatile PG8_LAS unsigned* flag) {
    const int wid = __builtin_amdgcn_readfirstlane(tid >> 6), lane = tid & 63, wr = wid >> 2, wc = wid & 3, fr = lane & 15, fq = lane >> 4;
    int SR[2], SC[2];
#pragma unroll
    for (int i = 0; i < 2; ++i) stage_rc(tid * 16 + i * 8192, SR[i], SC[i]);
    const int SRb[2] = {(SR[0] & ~31) + perm32(SR[0] & 31), (SR[1] & ~31) + perm32(SR[1] & 31)};
    const size_t kstep = (size_t)(BK * 2);
    const unsigned ldsw = (unsigned)wid * 1024u;
    const int aoff = lds_byte(wr * 64 + fr, fq * 8), boff = lds_byte(wc * 32 + fr, fq * 8);
#define PG8_SA(b, h) (((b) * 2 + (h)) * HTB)
#define PG8_SB(b, h) ((4 + (b) * 2 + (h)) * HTB)
#define PG8_STAGE(bufoff, gbase, voff) do { _Pragma("unroll") for (int _i = 0; _i < 2; ++_i) \
        __builtin_amdgcn_global_load_lds((const PG8_GAS unsigned*)((gbase) + (voff)[_i]), (PG8_LAS unsigned*)(lds + (bufoff) + ldsw + _i * 8192), 16, 0, 0); } while (0)
#define PG8_LDA(dst, b, h) do { _Pragma("unroll") for (int m = 0; m < 4; ++m) _Pragma("unroll") for (int k = 0; k < 2; ++k) dst[m][k] = *(const PG8_LAS bf16x8*)(lds + PG8_SA(b, h) + aoff + m * 2048 + k * 1024); } while (0)
#define PG8_LDB(dst, b, h) do { _Pragma("unroll") for (int n = 0; n < 2; ++n) _Pragma("unroll") for (int k = 0; k < 2; ++k) dst[n][k] = *(const PG8_LAS bf16x8*)(lds + PG8_SB(b, h) + boff + n * 2048 + k * 1024); } while (0)
#define PG8_MMA(ai, bj, At, Bt) do { __builtin_amdgcn_s_setprio(1); _Pragma("unroll") for (int m = 0; m < 4; ++m) _Pragma("unroll") for (int n = 0; n < 2; ++n) _Pragma("unroll") for (int k = 0; k < 2; ++k) \
        acc[ai][bj][m][n] = __builtin_amdgcn_mfma_f32_16x16x32_bf16(Bt[n][k], At[m][k], acc[ai][bj][m][n], 0, 0, 0); __builtin_amdgcn_s_setprio(0); } while (0)
#define PG8_WAIT_V(n) asm volatile("s_waitcnt vmcnt(" #n ")" ::: "memory")
#define PG8_WAIT_L(n) asm volatile("s_waitcnt lgkmcnt(" #n ")" ::: "memory")
#define PG8_BAR __builtin_amdgcn_s_barrier()
#define PG8_SCHED __builtin_amdgcn_sched_barrier(0)
    SUnit cur, nxt; int ui = 0;
    if (!S.next(0, cur)) return;
    f32x4 acc[2][2][4][2];
#pragma unroll
    for (int a = 0; a < 2; ++a)
#pragma unroll
        for (int b = 0; b < 2; ++b)
#pragma unroll
            for (int m = 0; m < 4; ++m)
#pragma unroll
                for (int n = 0; n < 2; ++n) acc[a][b][m][n] = (f32x4){0.f, 0.f, 0.f, 0.f};
    bf16x8 At[4][2], B0[2][2], B1[2][2];
    for (;;) {
        int K = S.k_of(cur.s);
        size_t hstep = (size_t)HALF * K * 2;
        unsigned voff[2] = {(unsigned)(SR[0] * K + SC[0]) * 2u, (unsigned)(SR[1] * K + SC[1]) * 2u};
        unsigned voffB[2] = {(unsigned)(SRb[0] * K + SC[0]) * 2u, (unsigned)(SRb[1] * K + SC[1]) * 2u};
        const PG8_GAS char* cA = (const PG8_GAS char*)S.a_of(cur.s) + (size_t)cur.pm * 2 * hstep; const PG8_GAS char* cB = (const PG8_GAS char*)S.b_of(cur.s) + (size_t)cur.pn * 2 * hstep;
        S.wait_ready(cur, tid);
        PG8_STAGE(PG8_SB(0, 0), cB, voffB); PG8_STAGE(PG8_SB(0, 1), cB + hstep, voffB); PG8_STAGE(PG8_SA(0, 0), cA, voff); PG8_STAGE(PG8_SA(0, 1), cA + hstep, voff);
        if (wr == 1) PG8_BAR;
        PG8_WAIT_V(2); PG8_BAR;
        PG8_STAGE(PG8_SB(1, 0), cB + kstep, voffB); PG8_STAGE(PG8_SA(1, 0), cA + kstep, voff); PG8_STAGE(PG8_SB(1, 1), cB + hstep + kstep, voffB);
        PG8_WAIT_V(6); PG8_BAR;
        bool finished = false;
        for (;;) {
            const bool has_next = S.next(ui + 1, nxt);
            bool chain = has_next;
            const int Kn = has_next ? S.k_of(nxt.s) : K;
            const size_t hstep_n = (size_t)HALF * Kn * 2;
            const unsigned voffn[2] = {(unsigned)(SR[0] * Kn + SC[0]) * 2u, (unsigned)(SR[1] * Kn + SC[1]) * 2u};
            const unsigned voffBn[2] = {(unsigned)(SRb[0] * Kn + SC[0]) * 2u, (unsigned)(SRb[1] * Kn + SC[1]) * 2u};
            const PG8_GAS char* nA = has_next ? (const PG8_GAS char*)S.a_of(nxt.s) + (size_t)nxt.pm * 2 * hstep_n : cA;
            const PG8_GAS char* nB = has_next ? (const PG8_GAS char*)S.b_of(nxt.s) + (size_t)nxt.pn * 2 * hstep_n : cB;
            const int nt = K / BK;
            for (int t = 0; t < nt; t += 2) {
                const bool last = (t == nt - 2);
                if (last && has_next) chain = S.try_ready(nxt, tid, flag);
                const bool usen = last && chain;
                const PG8_GAS char* a1 = cA + (size_t)(t + 1) * kstep;
                const PG8_GAS char* a2 = last ? (chain ? nA : cA) : cA + (size_t)(t + 2) * kstep; const PG8_GAS char* b2 = last ? (chain ? nB : cB) : cB + (size_t)(t + 2) * kstep;
                const PG8_GAS char* a3 = a2 + kstep; const PG8_GAS char* b3 = b2 + kstep;
                const size_t h2 = usen ? hstep_n : hstep;
                const unsigned v2[2] = {usen ? voffn[0] : voff[0], usen ? voffn[1] : voff[1]};
                const unsigned v2B[2] = {usen ? voffBn[0] : voffB[0], usen ? voffBn[1] : voffB[1]};
                PG8_LDB(B0, 0, 0); PG8_LDB(B1, 0, 1); PG8_SCHED; PG8_LDA(At, 0, 0); PG8_STAGE(PG8_SA(1, 1), a1 + hstep, voff);
                PG8_WAIT_V(8); PG8_WAIT_L(0); PG8_BAR; PG8_MMA(0, 0, At, B0); PG8_MMA(0, 1, At, B1); PG8_BAR; PG8_SCHED;
                PG8_LDA(At, 0, 1); PG8_STAGE(PG8_SB(0, 0), b2, v2B); PG8_STAGE(PG8_SB(0, 1), b2 + h2, v2B); PG8_STAGE(PG8_SA(0, 0), a2, v2);
                PG8_WAIT_V(8); PG8_WAIT_L(0); PG8_BAR; PG8_MMA(1, 0, At, B0); PG8_MMA(1, 1, At, B1); PG8_BAR; PG8_SCHED;
                PG8_LDB(B0, 1, 0); PG8_LDB(B1, 1, 1); PG8_SCHED; PG8_LDA(At, 1, 0); PG8_STAGE(PG8_SA(0, 1), a2 + h2, v2);
                PG8_WAIT_V(8); PG8_WAIT_L(0); PG8_BAR; PG8_MMA(0, 0, At, B0); PG8_MMA(0, 1, At, B1); PG8_BAR; PG8_SCHED;
                PG8_LDA(At, 1, 1); PG8_STAGE(PG8_SB(1, 0), b3, v2B); PG8_STAGE(PG8_SB(1, 1), b3 + h2, v2B); PG8_STAGE(PG8_SA(1, 0), a3, v2);
                PG8_WAIT_V(8); PG8_WAIT_L(0); PG8_BAR; PG8_MMA(1, 0, At, B0); PG8_MMA(1, 1, At, B1); PG8_BAR; PG8_SCHED;
            }
            if (wr == 0) PG8_BAR;
            E(acc, cur, wr, wc, fr, fq); S.done(cur, lane);
            if (!has_next) { finished = true; break; }
#pragma unroll
            for (int a = 0; a < 2; ++a)
#pragma unroll
                for (int b = 0; b < 2; ++b)
#pragma unroll
                    for (int m = 0; m < 4; ++m)
#pragma unroll
                        for (int n = 0; n < 2; ++n) acc[a][b][m][n] = (f32x4){0.f, 0.f, 0.f, 0.f};
            cur = nxt; ++ui;
            if (!chain) break;
            cA = nA; cB = nB; K = Kn; hstep = hstep_n; voff[0] = voffn[0]; voff[1] = voffn[1]; voffB[0] = voffBn[0]; voffB[1] = voffBn[1];
            if (wr == 1) PG8_BAR;
        }
        PG8_WAIT_V(0);
        PG8_BAR;
        if (finished) break;
    }
#undef PG8_SA
#undef PG8_SB
#undef PG8_STAGE
#undef PG8_LDA
#undef PG8_LDB
#undef PG8_MMA
#undef PG8_WAIT_V
#undef PG8_WAIT_L
#undef PG8_BAR
#undef PG8_SCHED
}
}

constexpr int D = 1024, BP = 4, TP = 4096, MP = BP * TP, BS = 128, TS = 8, MS = BS * TS, M = MP + MS;
constexpr int PAST = 2048, PAGE = 128, NPG = PAST / PAGE;
constexpr int NH = 8, NKV = 2, HD = 128, NIH = 8, DI = 64, DFF = 2816, DPLE = 256;
constexpr int NIN = 29 * 256;
constexpr int NGU = 2 * DFF;
constexpr float EPS = 1e-6f;
constexpr float IDX_SCALE = 0.044194173824159216f;
constexpr int LMAX = 4096;
constexpr int OQ = 0, OK_ = 1024, OV = 1280, OQI = 1536, OKI = 2048, OWI = 2112, OBG = 2120, OCG = 3144, OXC = 4168, OGA = 5192, OGB = 6216, DIN = 7240;
constexpr size_t O_Y = 0, O_KP = 17825792, O_VP = 22020096, O_KIP = 26214400, O_CP = 27262976, O_KS = 27271168, O_VS = 27533312, O_KIS = 27795456, O_CS = 27860992, O_END = 28123136;

constexpr size_t MiB = 1u << 20;
constexpr size_t WS_CTL = 0, CTL_ZERO_BYTES = 1 * MiB;
constexpr size_t WS_WIN = 2 * MiB, WS_WOUT = 18 * MiB, WS_WGU = 20 * MiB, WS_WDN = 32 * MiB, WS_WPLE = 38 * MiB, WS_WPG = 39 * MiB;
constexpr size_t WS_CS128 = 41 * MiB, WS_CS64 = 43 * MiB;
constexpr size_t WS_X3B = 512 * MiB;
constexpr size_t WS_HB = 44 * MiB, WS_QB = 78 * MiB, WS_KB = 112 * MiB, WS_VB = 121 * MiB, WS_QIB = 130 * MiB, WS_KIB = 147 * MiB, WS_WI = 150 * MiB;
constexpr size_t WS_UB = 151 * MiB, WS_BG = 185 * MiB, WS_SGA = 219 * MiB, WS_MASK = 253 * MiB, WS_MERGED = 262 * MiB, WS_X1B = 296 * MiB;
constexpr size_t WS_PART1 = 330 * MiB, WS_PART2 = 332 * MiB, WS_PART3 = 334 * MiB, WS_ACT = 336 * MiB, WS_X2B = 430 * MiB, WS_PB = 464 * MiB, WS_PW = 473 * MiB;
constexpr size_t WS_SCORES = 512 * MiB, WS_END = 784 * MiB;
constexpr int CW_BAR = 4096;
constexpr int CW_Q = 16384;
constexpr int CW_DEP = 32768;
constexpr int NPHASE = 6;

#define GAS __attribute__((address_space(1)))
#define LAS __attribute__((address_space(3)))
typedef unsigned short bf16;
typedef unsigned v4u __attribute__((ext_vector_type(4)));
typedef unsigned v2u __attribute__((ext_vector_type(2)));
typedef float f32x4 __attribute__((ext_vector_type(4)));
typedef float f32x8 __attribute__((ext_vector_type(8)));
typedef float f32x16 __attribute__((ext_vector_type(16)));
typedef short bf16x8 __attribute__((ext_vector_type(8)));
typedef short s16x4 __attribute__((ext_vector_type(4)));
typedef GAS unsigned gu32;
#define RLX_AGENT __ATOMIC_RELAXED, __HIP_MEMORY_SCOPE_AGENT
#define LDS_WAIT() asm volatile("s_waitcnt lgkmcnt(0)" ::: "memory")
#define VM_WAIT() asm volatile("s_waitcnt vmcnt(0)" ::: "memory")
#define SBAR() __builtin_amdgcn_sched_barrier(0)
__device__ __forceinline__ unsigned cvtpk(float lo, float hi) { return pg8::cvt_pk_bf16(lo, hi); }
__device__ __forceinline__ float bf2f(unsigned short b) { return __uint_as_float(((unsigned)b) << 16); }
__device__ __forceinline__ float sigmoidf_fast(float x) { return __builtin_amdgcn_rcpf(1.0f + __builtin_amdgcn_exp2f(-1.4426950408889634f * x)); }
__device__ __forceinline__ float wave_sum(float v) {
#pragma unroll
    for (int o = 1; o < 64; o <<= 1) v += __shfl_xor(v, o);
    return v;
}
__device__ __forceinline__ int wave_sum_dpp(int v) {
    v += __builtin_amdgcn_update_dpp(0, v, 0x111, 0xf, 0xf, true);
    v += __builtin_amdgcn_update_dpp(0, v, 0x112, 0xf, 0xf, true);
    v += __builtin_amdgcn_update_dpp(0, v, 0x114, 0xf, 0xf, true);
    v += __builtin_amdgcn_update_dpp(0, v, 0x118, 0xf, 0xf, true);
    v += __builtin_amdgcn_update_dpp(0, v, 0x142, 0xa, 0xf, true);
    v += __builtin_amdgcn_update_dpp(0, v, 0x143, 0xc, 0xf, true);
    return __builtin_amdgcn_readlane(v, 63);
}
__device__ __forceinline__ unsigned wave_max_dpp(unsigned v) {
    unsigned t;
    t = (unsigned)__builtin_amdgcn_update_dpp(0, (int)v, 0x111, 0xf, 0xf, true); v = v > t ? v : t;
    t = (unsigned)__builtin_amdgcn_update_dpp(0, (int)v, 0x112, 0xf, 0xf, true); v = v > t ? v : t;
    t = (unsigned)__builtin_amdgcn_update_dpp(0, (int)v, 0x114, 0xf, 0xf, true); v = v > t ? v : t;
    t = (unsigned)__builtin_amdgcn_update_dpp(0, (int)v, 0x118, 0xf, 0xf, true); v = v > t ? v : t;
    t = (unsigned)__builtin_amdgcn_update_dpp(0, (int)v, 0x142, 0xa, 0xf, true); v = v > t ? v : t;
    t = (unsigned)__builtin_amdgcn_update_dpp(0, (int)v, 0x143, 0xc, 0xf, true); v = v > t ? v : t;
    return (unsigned)__builtin_amdgcn_readlane((int)v, 63);
}
__device__ __forceinline__ int wave_sum_i(int v) {
#pragma unroll
    for (int o = 1; o < 64; o <<= 1) v += __shfl_xor(v, o);
    return v;
}

#define XB_TMO      128
#define XB_XCNT(j)  (256  + 64 * (j))
#define XB_XSUB(j)  (1280 + 64 * (j))
#define XB_XGEN(j)  (2304 + 64 * (j))
#define XB_TOP      3328
#define XB_TOPGEN   3392
#define XCD_BAR_WORDS 3456
#define XB_SPIN_CAP (1u << 18)
__device__ __forceinline__ unsigned xb_ld(unsigned* p)              { return __hip_atomic_load(p, __ATOMIC_RELAXED, __HIP_MEMORY_SCOPE_AGENT); }
__device__ __forceinline__ unsigned xb_add(unsigned* p, unsigned v) { return __hip_atomic_fetch_add(p, v, __ATOMIC_RELAXED, __HIP_MEMORY_SCOPE_AGENT); }
__device__ __forceinline__ unsigned xb_xcc_id() { return (unsigned)__builtin_amdgcn_s_getreg((3 << 11) | 20) & 0xFu; }
#define XB_SPIN(cond, bar) do { unsigned _sp = 0; while (cond) { __builtin_amdgcn_s_sleep(1); \
    if ((++_sp & 255u) == 0u) { if (xb_ld(&(bar)[XB_TMO])) break; if (_sp > XB_SPIN_CAP) { atomicAdd(&(bar)[XB_TMO], 1u); break; } } } } while (0)
struct XcdBarrier { unsigned* bar; unsigned x; volatile LAS unsigned* st; };
__device__ __forceinline__ XcdBarrier xcd_barrier_post(unsigned* bar, volatile LAS unsigned* st, int tid) {
    XcdBarrier b; b.bar = bar; b.x = xb_xcc_id(); b.st = st;
    if (tid == 0) (void)xb_add(&bar[XB_XCNT(b.x)], 1u);
    return b;
}
__device__ __forceinline__ void xcd_barrier_complete(unsigned* bar, unsigned x, unsigned& nloc, unsigned& nx) {
    const unsigned G = gridDim.x * gridDim.y * gridDim.z;
    unsigned sum, cnt, mine, sp = 0u;
    for (;;) {
        sum = 0u; cnt = 0u; mine = 0u;
#pragma unroll
        for (unsigned j = 0; j < 16; ++j) { const unsigned c = xb_ld(&bar[XB_XCNT(j)]); sum += c; cnt += (c > 0u) ? 1u : 0u; mine = (j == x) ? c : mine; }
        if (sum == G) break;
        __builtin_amdgcn_s_sleep(1);
        if ((++sp & 255u) == 0u) { if (xb_ld(&bar[XB_TMO])) break; if (sp > XB_SPIN_CAP) { atomicAdd(&bar[XB_TMO], 1u); break; } }
    }
    nloc = mine > 0u ? mine : 1u; nx = cnt > 0u ? cnt : 1u;
}
__device__ __forceinline__ void xcd_barrier(const XcdBarrier& b, int tid) {
    asm volatile("s_waitcnt vmcnt(0)" ::: "memory");
    __syncthreads();
    if (tid == 0) {
        unsigned* bar = b.bar;
        __builtin_amdgcn_s_waitcnt(0);
        unsigned nloc = b.st[0], nx = b.st[1];
        if (nloc == 0u) { xcd_barrier_complete(bar, b.x, nloc, nx); b.st[0] = nloc; b.st[1] = nx; }
        const unsigned old = xb_add(&bar[XB_XSUB(b.x)], 1u);
        const unsigned gen = old / nloc;
        if (old + 1u == (gen + 1u) * nloc) {
            __builtin_amdgcn_fence(__ATOMIC_RELEASE, "agent");
            asm volatile("s_waitcnt vmcnt(0)" ::: "memory");
            const unsigned og = xb_add(&bar[XB_TOP], 1u);
            const unsigned tg = og / nx;
            if (og + 1u == (tg + 1u) * nx) xb_add(&bar[XB_TOPGEN], 1u);
            else XB_SPIN(xb_ld(&bar[XB_TOPGEN]) == tg, bar);
            __builtin_amdgcn_fence(__ATOMIC_ACQUIRE, "agent");
            xb_add(&bar[XB_XGEN(b.x)], 1u);
            asm volatile("s_waitcnt vmcnt(0)" ::: "memory");
        } else {
            XB_SPIN(xb_ld(&bar[XB_XGEN(b.x)]) == gen, bar);
            __builtin_amdgcn_fence(__ATOMIC_ACQUIRE, "agent");
            asm volatile("s_waitcnt vmcnt(0)" ::: "memory");
        }
    }
    __syncthreads();
}

constexpr int RING_OFF = 0, RING_BYTES = 131072;
constexpr int CW_MSK = 100000;
constexpr int LDSCTL_OFF = RING_BYTES, MISC_OFF = LDSCTL_OFF + 320;
constexpr int LDS_BYTES = 163840;
constexpr int NWAVES = 8;

struct Args { const void* in[20]; float* out; unsigned char* ws; int ph_lo, ph_hi, qoff, pad; };

struct Frame {
    LAS unsigned char* lds;
    volatile LAS unsigned* MISC;
    gu32* ctl;
    int tid, lane, wave, G, qoff;
    GAS unsigned char* ws; GAS float* out;
};
typedef __attribute__((address_space(4))) const unsigned long long karg_t;
__device__ __forceinline__ karg_t* kargs() { karg_t* p = (karg_t*)__builtin_amdgcn_kernarg_segment_ptr(); asm volatile("" : "+s"(p)); return p; }
#define INPTR(T, kp, i) ((const GAS T*)(kp)[i])
enum { I_XP = 0, I_XS, I_CK, I_CV, I_CKI, I_SC, I_PT, I_PP, I_PS, I_NMIX, I_WIN, I_CONVW, I_WOUT, I_NFFN, I_WGU, I_WDN, I_NPLE, I_WPLE, I_WPG, I_NFIN };
__device__ __forceinline__ int row_pos(int m) { return m < MP ? (m & (TP - 1)) : PAST + (m & (TS - 1)); }

__device__ __forceinline__ int lane_opaque() { int l = (int)__builtin_amdgcn_mbcnt_hi(~0u, __builtin_amdgcn_mbcnt_lo(~0u, 0u)); asm volatile("" : "+v"(l)); return l; }
__device__ __forceinline__ int wq_next(Frame& F, int q) {
    __syncthreads();
    if (F.tid == 0) F.MISC[16] = __hip_atomic_fetch_add((unsigned*)(F.ctl + CW_Q + 64 * (q + F.qoff)), 1u, RLX_AGENT);
    __syncthreads();
    return (int)F.MISC[16];
}

__device__ __forceinline__ int in_src_col(int p) {
    const int tile = p >> 8, q = p & 255, bj = q >> 7, w = q & 127;
    if (tile < 4) return OQ + (2 * tile + (w >> 6)) * 128 + 64 * bj + (w & 63);
    if (tile == 4) return OK_ + (w >> 6) * 128 + 64 * bj + (w & 63);
    if (tile == 5) return OV + q;
    if (tile < 8) return OQI + (4 * (tile - 6) + (w >> 5)) * 64 + 32 * bj + (w & 31);
    if (tile == 8) { if (w < 32) return OKI + 32 * bj + w; if (bj == 0 && w < 40) return OWI + (w - 32); return -1; }
    if (tile < 17) return (bj ? OXC : OCG) + 128 * (tile - 9) + w;
    if (tile < 25) return (bj ? OGB : OBG) + 128 * (tile - 17) + w;
    return OGA + 256 * (tile - 25) + q;
}
__device__ __forceinline__ int gu_src_col(int p) { const int tile = p >> 8, q = p & 255; return q < 128 ? 128 * tile + q : DFF + 128 * tile + (q - 128); }

template <int MAP>
__device__ __forceinline__ void p0_transpose_item(const GAS float* W, int Nsrc, int K, int Nphys, GAS bf16* WT, const GAS float* kscale, LAS float* scr, int item, int lane) {
    const int nblk = Nphys / 32, kb = item / nblk, nb = item % nblk, k0 = 64 * kb, n0 = 32 * nb;
    const int r8 = lane >> 3, c4 = (lane & 7) * 4, p = n0 + c4;
    const int sc = MAP == 0 ? p : (MAP == 1 ? in_src_col(p) : gu_src_col(p));
#pragma unroll
    for (int i = 0; i < 8; ++i) { const int kk = 8 * i + r8;
        f32x4 v = f32x4{0.f, 0.f, 0.f, 0.f}; if (sc >= 0) v = *(const GAS f32x4*)(W + (size_t)(k0 + kk) * Nsrc + sc);
        if (kscale) v = v * kscale[k0 + kk];
        LAS float* d = scr + kk * 33 + c4; d[0] = v.x; d[1] = v.y; d[2] = v.z; d[3] = v.w; }
    LDS_WAIT(); asm volatile("" ::: "memory");
    const int c = lane & 7;
#pragma unroll
    for (int j = 0; j < 4; ++j) { const int n = (lane >> 3) + 8 * j; const LAS float* s = scr + (8 * c) * 33 + n;
        v4u o; o.x = cvtpk(s[0 * 33], s[1 * 33]); o.y = cvtpk(s[2 * 33], s[3 * 33]); o.z = cvtpk(s[4 * 33], s[5 * 33]); o.w = cvtpk(s[6 * 33], s[7 * 33]);
        *(GAS v4u*)(WT + (size_t)(n0 + n) * K + k0 + 8 * c) = o; }
    LDS_WAIT(); asm volatile("" ::: "memory");
}
__device__ __forceinline__ void sincos_d(double x, double& s, double& c) {
    const double k = __builtin_rint(x * 0.63661977236758134308);
    double r = __builtin_fma(-k, 1.57079632679489655800e+00, x); r = __builtin_fma(-k, 6.12323399573676603587e-17, r);
    const double r2 = r * r;
    double sp = -7.6471637318198164759e-13; sp = sp * r2 + 1.6059043836821614599e-10; sp = sp * r2 - 2.5052108385441718775e-08; sp = sp * r2 + 2.7557319223985890653e-06;
    sp = sp * r2 - 1.9841269841269841270e-04; sp = sp * r2 + 8.3333333333333333333e-03; sp = sp * r2 - 1.6666666666666666667e-01; const double sr = r + r * r2 * sp;
    double cp = 4.7794773323873852974e-14; cp = cp * r2 - 1.1470745597729724714e-11; cp = cp * r2 + 2.0876756987868098979e-09; cp = cp * r2 - 2.7557319223985890653e-07;
    cp = cp * r2 + 2.4801587301587301587e-05; cp = cp * r2 - 1.3888888888888888889e-03; cp = cp * r2 + 4.1666666666666666667e-02; cp = cp * r2 - 0.5; const double cr = 1.0 + r2 * cp;
    const int q = ((int)k) & 3;
    s = (q == 0) ? sr : (q == 1) ? cr : (q == 2) ? -sr : -cr;
    c = (q == 0) ? cr : (q == 1) ? -sr : (q == 2) ? -cr : sr;
}
__device__ __forceinline__ void p0_prologue(Frame& F) {
    LAS float* scr = (LAS float*)(F.lds + RING_OFF + F.wave * 16384);
    const int gw = blockIdx.x * NWAVES + F.wave, NGW = F.G * NWAVES, lane = F.lane;
    GAS unsigned char* ws = F.ws; karg_t* kp = kargs();
    constexpr int I_IN = (D / 64) * (NIN / 32), I_OUT = (D / 64) * (D / 32), I_GU = (D / 64) * (NGU / 32), I_DN = (DFF / 64) * (D / 32), I_PLE = (DPLE / 64) * (D / 32), I_PG = I_OUT;
    constexpr int NITEMS = I_IN + I_OUT + I_GU + I_DN + I_PLE + I_PG;
    for (int it = gw; it < NITEMS; it += NGW) {
        int r = it;
        if (r < I_IN) { p0_transpose_item<1>(INPTR(float, kp, I_WIN), DIN, D, NIN, (GAS bf16*)(ws + WS_WIN), nullptr, scr, r, lane); continue; } r -= I_IN;
        if (r < I_OUT) { p0_transpose_item<0>(INPTR(float, kp, I_WOUT), D, D, D, (GAS bf16*)(ws + WS_WOUT), nullptr, scr, r, lane); continue; } r -= I_OUT;
        if (r < I_GU) { p0_transpose_item<2>(INPTR(float, kp, I_WGU), NGU, D, NGU, (GAS bf16*)(ws + WS_WGU), INPTR(float, kp, I_NFFN), scr, r, lane); continue; } r -= I_GU;
        if (r < I_DN) { p0_transpose_item<0>(INPTR(float, kp, I_WDN), D, DFF, D, (GAS bf16*)(ws + WS_WDN), nullptr, scr, r, lane); continue; } r -= I_DN;
        if (r < I_PLE) { p0_transpose_item<0>(INPTR(float, kp, I_WPLE), D, DPLE, D, (GAS bf16*)(ws + WS_WPLE), nullptr, scr, r, lane); continue; } r -= I_PLE;
        p0_transpose_item<0>(INPTR(float, kp, I_WPG), D, D, D, (GAS bf16*)(ws + WS_WPG), INPTR(float, kp, I_NPLE), scr, r, lane);
    }
    {
        const int gt = blockIdx.x * (NWAVES * 64) + F.tid, NT_ = F.G * NWAVES * 64;
        GAS float2* cs128 = (GAS float2*)(ws + WS_CS128); GAS float2* cs64 = (GAS float2*)(ws + WS_CS64);
        for (int i = gt; i < TP * 64 + TP * 32; i += NT_) {
            int pos, fi, half; GAS float2* dst;
            if (i < TP * 64) { pos = i >> 6; fi = i & 63; half = 64; dst = cs128 + i; } else { const int j = i - TP * 64; pos = j >> 5; fi = j & 31; half = 32; dst = cs64 + j; }
            const float freq = __builtin_powf(10000.0f, -(float)fi / (float)half);
            const float ang = (float)pos * freq;
            double s, c; sincos_d((double)ang, s, c);
            dst->x = (float)c; dst->y = (float)s;
        }
    }
    {
        const GAS f32x4* gr = (const GAS f32x4*)INPTR(float, kp, I_NMIX) + lane;
        f32x4 g4[4];
#pragma unroll
        for (int j = 0; j < 4; ++j) g4[j] = gr[64 * j];
        const GAS float* xp = INPTR(float, kp, I_XP); const GAS float* xs = INPTR(float, kp, I_XS);
        for (int m0 = gw; m0 < M; m0 += 4 * NGW) {
            f32x4 v[4][4];
#pragma unroll
            for (int u = 0; u < 4; ++u) { const int m = m0 + u * NGW; if (m < M) {
                const GAS f32x4* xr = (const GAS f32x4*)(m < MP ? xp + (size_t)m * D : xs + (size_t)(m - MP) * D) + lane;
#pragma unroll
                for (int j = 0; j < 4; ++j) v[u][j] = xr[64 * j]; } }
#pragma unroll
            for (int u = 0; u < 4; ++u) { const int m = m0 + u * NGW; if (m < M) {
                float s = 0.f;
#pragma unroll
                for (int j = 0; j < 4; ++j) s += (v[u][j].x * v[u][j].x + v[u][j].y * v[u][j].y) + (v[u][j].z * v[u][j].z + v[u][j].w * v[u][j].w);
                const float rs = 1.0f / sqrtf(wave_sum(s) * (1.f / D) + EPS);
                GAS v2u* o8 = (GAS v2u*)((GAS bf16*)(ws + WS_HB) + (size_t)m * D) + lane;
#pragma unroll
                for (int j = 0; j < 4; ++j) { const f32x4 g = g4[j]; v2u o; o.x = cvtpk(v[u][j].x * rs * g.x, v[u][j].y * rs * g.y); o.y = cvtpk(v[u][j].z * rs * g.z, v[u][j].w * rs * g.w); o8[64 * j] = o; } } }
        }
    }
    {
        const GAS float* pp = INPTR(float, kp, I_PP); const GAS float* ps = INPTR(float, kp, I_PS);
        for (int m0 = gw; m0 < M; m0 += 8 * NGW) {
            f32x4 v[8];
#pragma unroll
            for (int u = 0; u < 8; ++u) { const int m = m0 + u * NGW; if (m < M) v[u] = ((const GAS f32x4*)(m < MP ? pp + (size_t)m * DPLE : ps + (size_t)(m - MP) * DPLE))[lane]; }
#pragma unroll
            for (int u = 0; u < 8; ++u) { const int m = m0 + u * NGW; if (m < M) { v2u o; o.x = cvtpk(v[u].x, v[u].y); o.y = cvtpk(v[u].z, v[u].w);
                ((GAS v2u*)((GAS bf16*)(ws + WS_PB) + (size_t)m * DPLE))[lane] = o; } }
        }
    }
}

constexpr float QK_LOG2_SCALE = 0.088388347648318440f * 1.4426950408889634f;
struct EpiIn {
    GAS bf16 *qb, *kb, *vb, *qib, *kib, *ub, *bgb, *sgab; GAS float* wi; const GAS float2 *cs128, *cs64; GAS float* out;
    __device__ __forceinline__ void operator()(const pg8::f32x4 (&acc)[2][2][4][2], const pg8::Unit& u, int wr, int wc, int fr, int fq) const {
        const int pn = u.pn;
#pragma unroll
        for (int ai = 0; ai < 2; ++ai)
#pragma unroll
            for (int m = 0; m < 4; ++m) {
                int row = u.pm * 256 + ai * 128 + wr * 64 + m * 16 + fr; asm volatile("" : "+v"(row));
                const int pos = row_pos(row);
                if (pn < 5) {
#pragma unroll
                    for (int n = 0; n < 2; ++n) {
                        const int w = 32 * wc + 8 * fq + 4 * n, d = w & 63, hh = w >> 6;
                        const f32x4 c01 = *(const GAS f32x4*)(cs128 + pos * 64 + d), c23 = *(const GAS f32x4*)(cs128 + pos * 64 + d + 2);
                        const f32x4 x1 = acc[ai][0][m][n], x2 = acc[ai][1][m][n];
                        f32x4 o1, o2;
                        o1.x = x1.x * c01.x - x2.x * c01.y; o2.x = x2.x * c01.x + x1.x * c01.y;
                        o1.y = x1.y * c01.z - x2.y * c01.w; o2.y = x2.y * c01.z + x1.y * c01.w;
                        o1.z = x1.z * c23.x - x2.z * c23.y; o2.z = x2.z * c23.x + x1.z * c23.y;
                        o1.w = x1.w * c23.z - x2.w * c23.w; o2.w = x2.w * c23.z + x1.w * c23.w;
                        const float qs = pn < 4 ? QK_LOG2_SCALE : 1.f;
                        v2u b1, b2; b1.x = cvtpk(o1.x * qs, o1.y * qs); b1.y = cvtpk(o1.z * qs, o1.w * qs); b2.x = cvtpk(o2.x * qs, o2.y * qs); b2.y = cvtpk(o2.z * qs, o2.w * qs);
                        if (pn < 4) { GAS bf16* q = qb + (size_t)row * D + (2 * pn + hh) * 128 + d; *(GAS v2u*)q = b1; *(GAS v2u*)(q + 64) = b2; }
                        else { GAS bf16* k = kb + (size_t)row * 256 + hh * 128 + d; *(GAS v2u*)k = b1; *(GAS v2u*)(k + 64) = b2;
                               GAS float* ko = out + (row < MP ? O_KP + (size_t)row * 256 : O_KS + (size_t)(row - MP) * 256) + hh * 128 + d; *(GAS f32x4*)ko = o1; *(GAS f32x4*)(ko + 64) = o2; }
                    }
                } else if (pn == 5) {
#pragma unroll
                    for (int bj = 0; bj < 2; ++bj)
                        { const int c = 128 * bj + 32 * wc + 8 * fq; const f32x4 x0 = acc[ai][bj][m][0], x1 = acc[ai][bj][m][1];
                            *(GAS v4u*)(vb + (size_t)row * 256 + c) = v4u{cvtpk(x0.x, x0.y), cvtpk(x0.z, x0.w), cvtpk(x1.x, x1.y), cvtpk(x1.z, x1.w)};
                            GAS float* vo = out + (row < MP ? O_VP + (size_t)row * 256 : O_VS + (size_t)(row - MP) * 256) + c; *(GAS f32x4*)vo = x0; *(GAS f32x4*)(vo + 4) = x1; }
                } else if (pn < 8) {
#pragma unroll
                    for (int n = 0; n < 2; ++n) {
                        const int w = 32 * wc + 8 * fq + 4 * n, d = w & 31, ih = 4 * (pn - 6) + (w >> 5);
                        const f32x4 c01 = *(const GAS f32x4*)(cs64 + pos * 32 + d), c23 = *(const GAS f32x4*)(cs64 + pos * 32 + d + 2);
                        const f32x4 x1 = acc[ai][0][m][n], x2 = acc[ai][1][m][n];
                        f32x4 o1, o2;
                        o1.x = x1.x * c01.x - x2.x * c01.y; o2.x = x2.x * c01.x + x1.x * c01.y;
                        o1.y = x1.y * c01.z - x2.y * c01.w; o2.y = x2.y * c01.z + x1.y * c01.w;
                        o1.z = x1.z * c23.x - x2.z * c23.y; o2.z = x2.z * c23.x + x1.z * c23.y;
                        o1.w = x1.w * c23.z - x2.w * c23.w; o2.w = x2.w * c23.z + x1.w * c23.w;
                        v2u b1, b2; b1.x = cvtpk(o1.x, o1.y); b1.y = cvtpk(o1.z, o1.w); b2.x = cvtpk(o2.x, o2.y); b2.y = cvtpk(o2.z, o2.w);
                        { const int q8 = row & 7, rr = (ih & 3) + 8 * (ih >> 2) + 4 * (q8 & 1) + 16 * ((q8 >> 1) & 1);
                          GAS bf16* qf = qib + (size_t)(row >> 3) * 4096 + ((q8 >> 2) * 4 + (d >> 4)) * 512 + ((((d >> 3) & 1) * 32 + rr) * 8) + (d & 7);
                          *(GAS v2u*)qf = b1; *(GAS v2u*)(qf + 1024) = b2; }
                    }
                } else if (pn == 8) {
                    if (wc == 0) {
#pragma unroll
                        for (int n = 0; n < 2; ++n) {
                            const int d = 8 * fq + 4 * n;
                            const f32x4 c01 = *(const GAS f32x4*)(cs64 + pos * 32 + d), c23 = *(const GAS f32x4*)(cs64 + pos * 32 + d + 2);
                            const f32x4 x1 = acc[ai][0][m][n], x2 = acc[ai][1][m][n];
                            f32x4 o1, o2;
                            o1.x = x1.x * c01.x - x2.x * c01.y; o2.x = x2.x * c01.x + x1.x * c01.y;
                            o1.y = x1.y * c01.z - x2.y * c01.w; o2.y = x2.y * c01.z + x1.y * c01.w;
                            o1.z = x1.z * c23.x - x2.z * c23.y; o2.z = x2.z * c23.x + x1.z * c23.y;
                            o1.w = x1.w * c23.z - x2.w * c23.w; o2.w = x2.w * c23.z + x1.w * c23.w;
                            v2u b1, b2; b1.x = cvtpk(o1.x, o1.y); b1.y = cvtpk(o1.z, o1.w); b2.x = cvtpk(o2.x, o2.y); b2.y = cvtpk(o2.z, o2.w);
                            { GAS bf16* kf = kib + (size_t)(row >> 5) * 2048 + (d >> 4) * 512 + ((((d >> 3) & 1) * 32 + (row & 31)) * 8) + (d & 7);
                              *(GAS v2u*)kf = b1; *(GAS v2u*)(kf + 1024) = b2; }
                            GAS float* ko = out + (row < MP ? O_KIP + (size_t)row * 64 : O_KIS + (size_t)(row - MP) * 64) + d; *(GAS f32x4*)ko = o1; *(GAS f32x4*)(ko + 32) = o2;
                        }
                    } else if (wc == 1 && fq == 0) {
                        *(GAS f32x4*)(wi + (size_t)row * 8) = acc[ai][0][m][0] * IDX_SCALE; *(GAS f32x4*)(wi + (size_t)row * 8 + 4) = acc[ai][0][m][1] * IDX_SCALE;
                    }
                } else if (pn < 17) {
                    const int t = row < MP ? (row & (TP - 1)) : (row & (TS - 1)), tl = row < MP ? TP : TS;
                    { const int ch = 128 * (pn - 9) + 32 * wc + 8 * fq; const f32x4 x0 = acc[ai][0][m][0] * acc[ai][1][m][0], x1 = acc[ai][0][m][1] * acc[ai][1][m][1];
                        *(GAS v4u*)(ub + (size_t)row * D + ch) = v4u{cvtpk(x0.x, x0.y), cvtpk(x0.z, x0.w), cvtpk(x1.x, x1.y), cvtpk(x1.z, x1.w)};
                        if (t >= tl - 2) { const int bidx = row < MP ? (row >> 12) : ((row - MP) >> 3);
                            GAS float* co = out + (row < MP ? O_CP : O_CS) + ((size_t)bidx * 2 + (t - (tl - 2))) * D + ch; *(GAS f32x4*)co = x0; *(GAS f32x4*)(co + 4) = x1; } }
                } else if (pn < 25) {
                    { const int ch = 128 * (pn - 17) + 32 * wc + 8 * fq; const f32x4 a0 = acc[ai][0][m][0], g0 = acc[ai][1][m][0], a1 = acc[ai][0][m][1], g1 = acc[ai][1][m][1];
                        *(GAS v4u*)(bgb + (size_t)row * D + ch) = v4u{cvtpk(a0.x * sigmoidf_fast(g0.x), a0.y * sigmoidf_fast(g0.y)), cvtpk(a0.z * sigmoidf_fast(g0.z), a0.w * sigmoidf_fast(g0.w)),
                                                                        cvtpk(a1.x * sigmoidf_fast(g1.x), a1.y * sigmoidf_fast(g1.y)), cvtpk(a1.z * sigmoidf_fast(g1.z), a1.w * sigmoidf_fast(g1.w))}; }
                } else {
#pragma unroll
                    for (int bj = 0; bj < 2; ++bj)
                        { const int ch = 256 * (pn - 25) + 128 * bj + 32 * wc + 8 * fq; const f32x4 g0 = acc[ai][bj][m][0], g1 = acc[ai][bj][m][1];
                            *(GAS v4u*)(sgab + (size_t)row * D + ch) = v4u{cvtpk(sigmoidf_fast(g0.x), sigmoidf_fast(g0.y)), cvtpk(sigmoidf_fast(g0.z), sigmoidf_fast(g0.w)),
                                                                             cvtpk(sigmoidf_fast(g1.x), sigmoidf_fast(g1.y)), cvtpk(sigmoidf_fast(g1.z), sigmoidf_fast(g1.w))}; }
                }
                asm volatile("" ::: "memory");
            }
    }
};
template <bool WT> __device__ __forceinline__ void st16(GAS void* base, size_t byteoff, size_t nbytes, v4u v) {
    if (WT) __builtin_amdgcn_raw_buffer_store_b128(v, __builtin_amdgcn_make_buffer_rsrc((void*)base, 0, (int)nbytes, 0x00020000), (int)byteoff, 0, 16);
    else *(GAS v4u*)((GAS char*)base + byteoff) = v; }
template <bool WT> __device__ __forceinline__ void st4(GAS float* p, float v) {
    if (WT) __hip_atomic_store((GAS unsigned*)p, __float_as_uint(v), __ATOMIC_RELAXED, __HIP_MEMORY_SCOPE_AGENT); else *p = v; }
__device__ __forceinline__ v4u pack8(const f32x4& a, const f32x4& b) { v4u o; o.x = cvtpk(a.x, a.y); o.y = cvtpk(a.z, a.w); o.z = cvtpk(b.x, b.y); o.w = cvtpk(b.z, b.w); return o; }
__device__ __forceinline__ void unpack8(const v4u w, f32x4& a, f32x4& b) {
    a.x = __uint_as_float(w.x << 16); a.y = __uint_as_float(w.x & 0xffff0000u); a.z = __uint_as_float(w.y << 16); a.w = __uint_as_float(w.y & 0xffff0000u);
    b.x = __uint_as_float(w.z << 16); b.y = __uint_as_float(w.z & 0xffff0000u); b.z = __uint_as_float(w.w << 16); b.w = __uint_as_float(w.w & 0xffff0000u); }
template <bool WT = false> struct EpiBf {
    GAS bf16* O; int ldc;
    __device__ __forceinline__ void operator()(const pg8::f32x4 (&acc)[2][2][4][2], const pg8::Unit& u, int wr, int wc, int fr, int fq) const {
#pragma unroll
        for (int ai = 0; ai < 2; ++ai)
#pragma unroll
            for (int m = 0; m < 4; ++m) { const int row = u.pm * 256 + ai * 128 + wr * 64 + m * 16 + fr;
#pragma unroll
                for (int bj = 0; bj < 2; ++bj) { const int c = u.pn * 256 + 128 * bj + 32 * wc + 8 * fq;
                    st16<WT>(O, ((size_t)row * ldc + c) * 2, (size_t)M * ldc * 2, pack8(acc[ai][bj][m][0], acc[ai][bj][m][1])); } }
    }
};
template <int BASEMODE  , bool WT = false> struct EpiRes {
    const GAS float *xp, *xs; const GAS bf16* baseb; GAS bf16* xo; GAS float* part;
    __device__ __forceinline__ void operator()(const pg8::f32x4 (&acc)[2][2][4][2], const pg8::Unit& u, int wr, int wc, int fr, int fq) const {
#pragma unroll
        for (int ai = 0; ai < 2; ++ai) {
            f32x4 b0[4][2], b1[4][2];
#pragma unroll
            for (int m = 0; m < 4; ++m) { const int row = u.pm * 256 + ai * 128 + wr * 64 + m * 16 + fr;
#pragma unroll
                for (int bj = 0; bj < 2; ++bj) { const int c = u.pn * 256 + 128 * bj + 32 * wc + 8 * fq;
                    if (BASEMODE == 0) { const GAS float* xr = (row < MP ? xp + (size_t)row * D : xs + (size_t)(row - MP) * D) + c; b0[m][bj] = *(const GAS f32x4*)xr; b1[m][bj] = *(const GAS f32x4*)(xr + 4); }
                    else unpack8(*(const GAS v4u*)(baseb + (size_t)row * D + c), b0[m][bj], b1[m][bj]); } }
#pragma unroll
            for (int m = 0; m < 4; ++m) { const int row = u.pm * 256 + ai * 128 + wr * 64 + m * 16 + fr; float ss = 0.f;
#pragma unroll
                for (int bj = 0; bj < 2; ++bj) { const int c = u.pn * 256 + 128 * bj + 32 * wc + 8 * fq; const f32x4 x0 = acc[ai][bj][m][0] + b0[m][bj], x1 = acc[ai][bj][m][1] + b1[m][bj];
                    ss += ((x0.x * x0.x + x0.y * x0.y) + (x0.z * x0.z + x0.w * x0.w)) + ((x1.x * x1.x + x1.y * x1.y) + (x1.z * x1.z + x1.w * x1.w));
                    st16<WT>(xo, ((size_t)row * D + c) * 2, (size_t)M * D * 2, pack8(x0, x1)); }
                ss += __shfl_xor(ss, 16); ss += __shfl_xor(ss, 32);
                if (fq == 0) st4<WT>(part + (size_t)row * 16 + u.pn * 4 + wc, ss); }
        }
    }
};
__device__ __forceinline__ float row_rs(const GAS float* part, int row) {
    const f32x4 a = *(const GAS f32x4*)(part + (size_t)row * 16), b = *(const GAS f32x4*)(part + (size_t)row * 16 + 4), c = *(const GAS f32x4*)(part + (size_t)row * 16 + 8), d = *(const GAS f32x4*)(part + (size_t)row * 16 + 12);
    const float s = ((a.x + a.y) + (a.z + a.w)) + ((b.x + b.y) + (b.z + b.w)) + ((c.x + c.y) + (c.z + c.w)) + ((d.x + d.y) + (d.z + d.w));
    return 1.0f / sqrtf(s * (1.f / D) + EPS);
}
__device__ __forceinline__ f32x4 swiglu4(const f32x4& g, const f32x4& u) { f32x4 o; o.x = g.x * sigmoidf_fast(g.x) * u.x; o.y = g.y * sigmoidf_fast(g.y) * u.y; o.z = g.z * sigmoidf_fast(g.z) * u.z; o.w = g.w * sigmoidf_fast(g.w) * u.w; return o; }
__device__ __forceinline__ float row_rs_q(const GAS float* part, int row, int fq) {
    const f32x4 a = *(const GAS f32x4*)(part + (size_t)row * 16 + 4 * fq);
    float s = (a.x + a.y) + (a.z + a.w);
    s += __shfl_xor(s, 16); s += __shfl_xor(s, 32);
    return 1.0f / sqrtf(s * (1.f / D) + EPS);
}
template <bool WT = false> struct EpiSwiGLU {
    const GAS float* part; GAS bf16* act;
    __device__ __forceinline__ void operator()(const pg8::f32x4 (&acc)[2][2][4][2], const pg8::Unit& u, int wr, int wc, int fr, int fq) const {
        float rsv[2][4];
#pragma unroll
        for (int ai = 0; ai < 2; ++ai)
#pragma unroll
            for (int m = 0; m < 4; ++m) rsv[ai][m] = row_rs_q(part, u.pm * 256 + ai * 128 + wr * 64 + m * 16 + fr, fq);
#pragma unroll
        for (int ai = 0; ai < 2; ++ai)
#pragma unroll
            for (int m = 0; m < 4; ++m) { const int row = u.pm * 256 + ai * 128 + wr * 64 + m * 16 + fr; const float rs = rsv[ai][m];
                const int c = u.pn * 128 + 32 * wc + 8 * fq;
                st16<WT>(act, ((size_t)row * DFF + c) * 2, (size_t)M * DFF * 2, pack8(swiglu4(acc[ai][0][m][0] * rs, acc[ai][1][m][0] * rs), swiglu4(acc[ai][0][m][1] * rs, acc[ai][1][m][1] * rs))); }
    }
};
template <bool WT = false> struct EpiPle {
    const GAS float* part2; const GAS bf16 *x2b, *pw; GAS bf16* x3; GAS float* part3;
    __device__ __forceinline__ void operator()(const pg8::f32x4 (&acc)[2][2][4][2], const pg8::Unit& u, int wr, int wc, int fr, int fq) const {
#pragma unroll
        for (int ai = 0; ai < 2; ++ai) {
        float rsv[2][4];
#pragma unroll
        for (int m = 0; m < 4; ++m) rsv[ai][m] = row_rs_q(part2, u.pm * 256 + ai * 128 + wr * 64 + m * 16 + fr, fq);
#pragma unroll
        for (int mh = 0; mh < 2; ++mh) {
            v4u xv[2][2], pv[2][2];
#pragma unroll
            for (int m2 = 0; m2 < 2; ++m2) { const int row = u.pm * 256 + ai * 128 + wr * 64 + (2 * mh + m2) * 16 + fr;
#pragma unroll
                for (int bj = 0; bj < 2; ++bj) { const int c = u.pn * 256 + 128 * bj + 32 * wc + 8 * fq;
                    xv[m2][bj] = *(const GAS v4u*)(x2b + (size_t)row * D + c); pv[m2][bj] = *(const GAS v4u*)(pw + (size_t)row * D + c); } }
#pragma unroll
            for (int m2 = 0; m2 < 2; ++m2) { const int m = 2 * mh + m2; const int row = u.pm * 256 + ai * 128 + wr * 64 + m * 16 + fr; const float rs = rsv[ai][m]; float ss = 0.f;
#pragma unroll
                for (int bj = 0; bj < 2; ++bj) { const int c = u.pn * 256 + 128 * bj + 32 * wc + 8 * fq;
                    f32x4 xa, xb, pa, pb; unpack8(xv[m2][bj], xa, xb); unpack8(pv[m2][bj], pa, pb);
                    const f32x4 a0 = acc[ai][bj][m][0] * rs, a1 = acc[ai][bj][m][1] * rs;
                    f32x4 x0, x1;
                    x0.x = xa.x + pa.x * sigmoidf_fast(a0.x); x0.y = xa.y + pa.y * sigmoidf_fast(a0.y); x0.z = xa.z + pa.z * sigmoidf_fast(a0.z); x0.w = xa.w + pa.w * sigmoidf_fast(a0.w);
                    x1.x = xb.x + pb.x * sigmoidf_fast(a1.x); x1.y = xb.y + pb.y * sigmoidf_fast(a1.y); x1.z = xb.z + pb.z * sigmoidf_fast(a1.z); x1.w = xb.w + pb.w * sigmoidf_fast(a1.w);
                    ss += ((x0.x * x0.x + x0.y * x0.y) + (x0.z * x0.z + x0.w * x0.w)) + ((x1.x * x1.x + x1.y * x1.y) + (x1.z * x1.z + x1.w * x1.w));
                    st16<WT>(x3, ((size_t)row * D + c) * 2, (size_t)M * D * 2, pack8(x0, x1)); }
                ss += __shfl_xor(ss, 16); ss += __shfl_xor(ss, 32);
                if (fq == 0) st4<WT>(part3 + (size_t)row * 16 + u.pn * 4 + wc, ss); }
        }
        }
    }
};
struct EpiStream {
    GAS unsigned char* ws; GAS float* out; const GAS float *xp, *xs;
    __device__ __forceinline__ void operator()(const pg8::f32x4 (&acc)[2][2][4][2], const pg8::SUnit& su, int wr, int wc, int fr, int fq) const {
        const pg8::Unit u{su.pm, su.pn};
        if (su.s == 0) { const EpiBf<true> e{(GAS bf16*)(ws + WS_PW), D}; e(acc, u, wr, wc, fr, fq); }
        else if (su.s == 1) { const EpiRes<0, true> e{xp, xs, nullptr, (GAS bf16*)(ws + WS_X1B), (GAS float*)(ws + WS_PART1)}; e(acc, u, wr, wc, fr, fq); }
        else if (su.s == 2) { const EpiSwiGLU<true> e{(const GAS float*)(ws + WS_PART1), (GAS bf16*)(ws + WS_ACT)}; e(acc, u, wr, wc, fr, fq); }
        else if (su.s == 3) { const EpiRes<1, true> e{nullptr, nullptr, (const GAS bf16*)(ws + WS_X1B), (GAS bf16*)(ws + WS_X2B), (GAS float*)(ws + WS_PART2)}; e(acc, u, wr, wc, fr, fq); }
        else { const EpiPle<true> e{(const GAS float*)(ws + WS_PART2), (const GAS bf16*)(ws + WS_X2B), (const GAS bf16*)(ws + WS_PW), (GAS bf16*)(ws + WS_X3B), (GAS float*)(ws + WS_PART3)}; e(acc, u, wr, wc, fr, fq); }
    }
};

__device__ __forceinline__ float relu_i(float x) { const int i = __float_as_int(x); return __int_as_float(i > 0 ? i : 0); }
__device__ __forceinline__ void idx_scores(const bf16x8 (&Af)[2][4], const bf16x8 (&Bf)[4], const f32x4 (&wv)[2][4], float (&sc)[2][2]) {
#pragma unroll
    for (int R = 0; R < 2; ++R) {
        f32x16 d = {};
#pragma unroll
        for (int s = 0; s < 4; ++s) d = __builtin_amdgcn_mfma_f32_32x32x16_bf16(Af[R][s], Bf[s], d, 0, 0, 0);
        float s0 = 0.f, s1 = 0.f;
#pragma unroll
        for (int r = 0; r < 8; ++r) { s0 = fmaf(relu_i(d[r]), wv[R][r >> 2][r & 3], s0); asm volatile("" : "+v"(s0)); s1 = fmaf(relu_i(d[8 + r]), wv[R][2 + (r >> 2)][r & 3], s1); }
        sc[R][0] = s0; sc[R][1] = s1;
    }
}
__device__ __forceinline__ void idx_load_q(const GAS bf16* qib, const GAS float* wi, int mq0, int lane, bf16x8 (&Af)[2][4], f32x4 (&wv)[2][4]) {
    const int r = lane & 31, hh = lane >> 5;
#pragma unroll
    for (int R = 0; R < 2; ++R) {
        const GAS bf16* qp = qib + (size_t)(mq0 >> 3) * 4096 + R * 2048 + lane * 8;
#pragma unroll
        for (int s = 0; s < 4; ++s) Af[R][s] = *(const GAS bf16x8*)(qp + 512 * s);
        const GAS float* w0 = wi + (size_t)(mq0 + 4 * R + hh) * 8; const GAS float* w1 = wi + (size_t)(mq0 + 4 * R + 2 + hh) * 8;
        wv[R][0] = *(const GAS f32x4*)w0; wv[R][1] = *(const GAS f32x4*)(w0 + 4); wv[R][2] = *(const GAS f32x4*)w1; wv[R][3] = *(const GAS f32x4*)(w1 + 4);
    }
}
__device__ __forceinline__ unsigned sortable(float f) { const unsigned u = __float_as_uint(f); return (u & 0x80000000u) ? ~u : (u | 0x80000000u); }
__device__ __forceinline__ void st8wt(GAS void* base, size_t byteoff, size_t nbytes, unsigned long long v) {
    const v2u d = {(unsigned)v, (unsigned)(v >> 32)};
    __builtin_amdgcn_raw_buffer_store_b64(d, __builtin_amdgcn_make_buffer_rsrc((void*)base, 0, (int)nbytes, 0x00020000), (int)byteoff, 0, 16); }
__device__ __forceinline__ unsigned* mask_counter(gu32* ctl, int row) { return (unsigned*)(ctl + CW_MSK) + (size_t)(row < MP ? (row >> 6) : 256 + ((row - MP) >> 3)) * 64; }
__device__ __forceinline__ void p2_item(int p, bool& sample, int& b, int& t0, int& mq0) {
    sample = p < BS;
    if (sample) { b = p; t0 = PAST; mq0 = MP + b * TS; }
    else { const int tg = 2047 - (p - BS); t0 = (tg >> 2) * 8; b = tg & 3; mq0 = b * TP + t0; }
}
__device__ __forceinline__ void p2_index_select(Frame& F) {
    GAS unsigned char* ws = F.ws;
    const GAS bf16* qib = (const GAS bf16*)(ws + WS_QIB); const GAS bf16* kib = (const GAS bf16*)(ws + WS_KIB); const GAS float* wi = (const GAS float*)(ws + WS_WI);
    GAS unsigned long long* mask = (GAS unsigned long long*)(ws + WS_MASK);
    const int lane = F.lane, w = F.wave, c = lane & 31, hh = lane >> 5;
    karg_t* kp = kargs(); const GAS int* page_table = INPTR(int, kp, I_PT); const GAS float* cache_kidx = INPTR(float, kp, I_CKI);
    LAS float* sc = (LAS float*)(F.lds + RING_OFF);
    volatile LAS unsigned long long* wl = (volatile LAS unsigned long long*)(F.lds + LDSCTL_OFF + 2048 + w * 512);
    bf16x8 Af[2][4]; f32x4 wv[2][4];
    { bool s_; int b_, t_, m_; p2_item((int)blockIdx.x, s_, b_, t_, m_); idx_load_q(qib, wi, m_, lane, Af, wv); }
    unsigned* qctr = (unsigned*)(F.ctl + CW_Q);
    int pend_row = -1;
    for (int it = (int)blockIdx.x; it < 2048 + BS;) {
        unsigned claim = 0u;
        if (w == 0 && lane == 0) claim = (unsigned)F.G + __hip_atomic_fetch_add(qctr, 1u, __ATOMIC_RELAXED, __HIP_MEMORY_SCOPE_AGENT);
        __syncthreads();
        bool sample; int b, t0, mq0;
        p2_item(it, sample, b, t0, mq0);
        const int Lmax = t0 + 8, L = t0 + w + 1;
        if (Lmax > 256) {
            const int ntiles = ((Lmax + 63) >> 6) * 2;
            const int nj = (ntiles - w + 7) >> 3;
            if (!sample) {
                auto ldB = [&](bf16x8 (&B)[2][4], int j) {
#pragma unroll
                    for (int jj = 0; jj < 2; ++jj) { int kt = w + 8 * (j + jj); kt = kt < ntiles ? kt : ntiles - 1;
                        const GAS bf16* kq_ = kib + (size_t)(b * (TP / 32) + kt) * 2048 + lane * 8;
#pragma unroll
                        for (int s2 = 0; s2 < 4; ++s2) B[jj][s2] = *(const GAS bf16x8*)(kq_ + 512 * s2); } };
                auto cmpB = [&](const bf16x8 (&B)[2][4], int j) {
#pragma unroll
                    for (int jj = 0; jj < 2; ++jj) { if (j + jj < nj) { const int kt = w + 8 * (j + jj);
                        float s4[2][2]; idx_scores(Af, B[jj], wv, s4);
#pragma unroll
                        for (int R = 0; R < 2; ++R) { const int e = kt * 32 + c;
                            sc[(4 * R + hh) * LMAX + e] = __uint_as_float(e <= t0 + 4 * R + hh ? sortable(s4[R][0]) : 0u);
                            sc[(4 * R + 2 + hh) * LMAX + e] = __uint_as_float(e <= t0 + 4 * R + 2 + hh ? sortable(s4[R][1]) : 0u); } }
                        else { asm volatile("" :: "v"(B[jj][0]), "v"(B[jj][1]), "v"(B[jj][2]), "v"(B[jj][3])); } } };
                bf16x8 B0[2][4], B1[2][4];
                ldB(B0, 0);
                for (int j0 = 0; j0 < nj; j0 += 4) { ldB(B1, j0 + 2); cmpB(B0, j0); ldB(B0, j0 + 4); cmpB(B1, j0 + 2); }
#pragma unroll
                for (int jj = 0; jj < 2; ++jj) asm volatile("" :: "v"(B0[jj][0]), "v"(B0[jj][1]), "v"(B0[jj][2]), "v"(B0[jj][3]));
            } else {
                for (int j0 = 0; j0 < nj; j0 += 2) {
                    f32x4 Fb[2][8];
#pragma unroll
                    for (int jj = 0; jj < 2; ++jj) { { int kt = w + 8 * (j0 + jj); kt = kt < ntiles ? kt : ntiles - 1;
                        if (kt < 64) { const int phys = page_table[b * NPG + (kt >> 2)];
                            const GAS float* kq = cache_kidx + ((size_t)phys * PAGE + (kt & 3) * 32 + c) * DI + 8 * hh;
#pragma unroll
                            for (int s2 = 0; s2 < 4; ++s2) { Fb[jj][2 * s2] = *(const GAS f32x4*)(kq + 16 * s2); Fb[jj][2 * s2 + 1] = *(const GAS f32x4*)(kq + 16 * s2 + 4); } }
                        else { const int mk = mq0 + (c & 7);
                            const GAS bf16* kq = kib + (size_t)(mk >> 5) * 2048 + (hh * 32 + (mk & 31)) * 8;
#pragma unroll
                            for (int s2 = 0; s2 < 4; ++s2) { const bf16x8 kv = *(const GAS bf16x8*)(kq + 512 * s2);
                                Fb[jj][2 * s2] = f32x4{bf2f((unsigned short)kv[0]), bf2f((unsigned short)kv[1]), bf2f((unsigned short)kv[2]), bf2f((unsigned short)kv[3])};
                                Fb[jj][2 * s2 + 1] = f32x4{bf2f((unsigned short)kv[4]), bf2f((unsigned short)kv[5]), bf2f((unsigned short)kv[6]), bf2f((unsigned short)kv[7])}; } } } }
#pragma unroll
                    for (int jj = 0; jj < 2; ++jj) { if (j0 + jj < nj) { const int kt = w + 8 * (j0 + jj);
                        bf16x8 Bf[4];
#pragma unroll
                        for (int s2 = 0; s2 < 4; ++s2) { const f32x4 a = Fb[jj][2 * s2], bq = Fb[jj][2 * s2 + 1];
                            v4u o; o.x = cvtpk(a.x, a.y); o.y = cvtpk(a.z, a.w); o.z = cvtpk(bq.x, bq.y); o.w = cvtpk(bq.z, bq.w); Bf[s2] = *(bf16x8*)&o; }
                        float s4[2][2]; idx_scores(Af, Bf, wv, s4);
#pragma unroll
                        for (int R = 0; R < 2; ++R) { const int e = kt * 32 + c;
                            sc[(4 * R + hh) * LMAX + e] = __uint_as_float(e <= t0 + 4 * R + hh ? sortable(s4[R][0]) : 0u);
                            sc[(4 * R + 2 + hh) * LMAX + e] = __uint_as_float(e <= t0 + 4 * R + 2 + hh ? sortable(s4[R][1]) : 0u); } }
                        else { asm volatile("" :: "v"(Fb[jj][0]), "v"(Fb[jj][1]), "v"(Fb[jj][2]), "v"(Fb[jj][3]), "v"(Fb[jj][4]), "v"(Fb[jj][5]), "v"(Fb[jj][6]), "v"(Fb[jj][7])); } }
                }
            }
        }
        if (w == 0 && lane == 0) F.MISC[16] = claim;
        LDS_WAIT();
        __syncthreads();
        const int itn = (int)F.MISC[16];
        if (pend_row >= 0) {
            asm volatile("s_waitcnt vmcnt(0)" ::: "memory");
            if (lane == 0) __hip_atomic_fetch_add(mask_counter(F.ctl, pend_row), 1u, __ATOMIC_RELAXED, __HIP_MEMORY_SCOPE_AGENT);
            pend_row = -1; }
        auto prefetch_q = [&]() {
          if (itn < 2048 + BS) { bool sn; int bn, t0n, mqn; p2_item(itn, sn, bn, t0n, mqn);
              if (t0n + 8 > 256) idx_load_q(qib, wi, mqn, lane, Af, wv); } };
        GAS unsigned long long* mrow = mask + (size_t)(mq0 + w) * 64;
        if (L <= 256) {
            const int lo = 64 * lane;
            const unsigned long long word = (L >= lo + 64) ? ~0ull : (L > lo ? ((1ull << (L - lo)) - 1ull) : 0ull);
            st8wt(mask, ((size_t)(mq0 + w) * 64 + lane) * 8, (size_t)M * 64 * 8, word); pend_row = mq0 + w;
            it = itn;
            continue;
        }
        const int nch = (L + 63) >> 6;
        unsigned x[64];
        const LAS float* srow = sc + w * LMAX + lane; const int rem = L - lane;
#pragma unroll
        for (int g = 0; g < 8; ++g) { if (g * 8 < nch) {
#pragma unroll
            for (int i = 0; i < 8; ++i) { const unsigned v = __float_as_uint(srow[(g * 8 + i) * 64]); x[g * 8 + i] = (g * 8 + i < nch) ? v : 0u; } }
          else {
#pragma unroll
            for (int i = 0; i < 8; ++i) x[g * 8 + i] = 0u; } }
        prefetch_q();
        unsigned T = 0u; bool exact = false; unsigned prefix = 0u; int need = 256;
        {
            asm volatile("" ::: "memory");
            LAS unsigned* h12 = (LAS unsigned*)(sc + w * LMAX);
#pragma unroll
            for (int i = 0; i < 16; ++i) *(LAS v4u*)(h12 + 256 * i + 4 * lane) = v4u{0u, 0u, 0u, 0u};
            asm volatile("" ::: "memory");
#pragma unroll
            for (int g = 0; g < 8; ++g) { if (g * 8 < nch) {
#pragma unroll
                for (int i = 0; i < 8; ++i) __hip_atomic_fetch_add(h12 + (x[g * 8 + i] >> 20), 1u, __ATOMIC_RELAXED, __HIP_MEMORY_SCOPE_WORKGROUP); } }
            LDS_WAIT(); asm volatile("" ::: "memory");
            int sl = 0;
            int lo_ = lane; asm volatile("" : "+v"(lo_));
#pragma unroll
            for (int j = 0; j < 16; ++j) { const v4u c4 = *(const LAS v4u*)(h12 + 64 * lo_ + 4 * ((j + lo_) & 15)); sl += (int)(c4.x + c4.y + c4.z + c4.w); }
            int pf = sl;
            pf += __builtin_amdgcn_update_dpp(0, pf, 0x111, 0xf, 0xf, true);
            pf += __builtin_amdgcn_update_dpp(0, pf, 0x112, 0xf, 0xf, true);
            pf += __builtin_amdgcn_update_dpp(0, pf, 0x114, 0xf, 0xf, true);
            pf += __builtin_amdgcn_update_dpp(0, pf, 0x118, 0xf, 0xf, true);
            pf += __builtin_amdgcn_update_dpp(0, pf, 0x142, 0xa, 0xf, true);
            pf += __builtin_amdgcn_update_dpp(0, pf, 0x143, 0xc, 0xf, true);
            const int above_lane = __builtin_amdgcn_readlane(pf, 63) - pf;
            const int cl = __builtin_ctzll(__ballot((above_lane < need) && (above_lane + sl >= need)));
            const int ab_cl = __builtin_amdgcn_readlane(above_lane, cl);
            const int cb = (int)h12[64 * cl + lane];
            int pf2 = cb;
            pf2 += __builtin_amdgcn_update_dpp(0, pf2, 0x111, 0xf, 0xf, true);
            pf2 += __builtin_amdgcn_update_dpp(0, pf2, 0x112, 0xf, 0xf, true);
            pf2 += __builtin_amdgcn_update_dpp(0, pf2, 0x114, 0xf, 0xf, true);
            pf2 += __builtin_amdgcn_update_dpp(0, pf2, 0x118, 0xf, 0xf, true);
            pf2 += __builtin_amdgcn_update_dpp(0, pf2, 0x142, 0xa, 0xf, true);
            pf2 += __builtin_amdgcn_update_dpp(0, pf2, 0x143, 0xc, 0xf, true);
            const int above2 = ab_cl + __builtin_amdgcn_readlane(pf2, 63) - pf2;
            const int dl = __builtin_ctzll(__ballot((above2 < need) && (above2 + cb >= need)));
            const int above = __builtin_amdgcn_readlane(above2, dl), cnt_d = __builtin_amdgcn_readlane(cb, dl);
            need -= above;
            prefix = (unsigned)(64 * cl + dl);
            T = prefix << 20;
            exact = (cnt_d == need);
        }
        LAS unsigned* hist = (LAS unsigned*)(F.lds + LDSCTL_OFF + 8192 + w * 2048);
        if (!exact) {
#pragma unroll 1
        for (int p = 1; p < 4; ++p) {
            const int shift = p == 3 ? 0 : 20 - 8 * p, width = p == 3 ? 4 : 8;
            *(LAS v4u*)(hist + 4 * lane) = v4u{0u, 0u, 0u, 0u}; *(LAS v4u*)(hist + 256 + 4 * lane) = v4u{0u, 0u, 0u, 0u};
            LDS_WAIT();
#pragma unroll
            for (int g = 0; g < 8; ++g) { if (g * 8 < nch) {
#pragma unroll
                for (int i = 0; i < 8; ++i) { const unsigned xi = x[g * 8 + i];
                    if ((xi >> (shift + width)) == prefix) __hip_atomic_fetch_add(hist + (lane & 1) * 256 + ((xi >> shift) & ((1u << width) - 1u)), 1u, __ATOMIC_RELAXED, __HIP_MEMORY_SCOPE_WORKGROUP); } } }
            LDS_WAIT();
            const v4u c4 = *(const LAS v4u*)(hist + 4 * lane) + *(const LAS v4u*)(hist + 256 + 4 * lane);
            const int sl = (int)(c4.x + c4.y + c4.z + c4.w);
            int pf = sl;
            pf += __builtin_amdgcn_update_dpp(0, pf, 0x111, 0xf, 0xf, true);
            pf += __builtin_amdgcn_update_dpp(0, pf, 0x112, 0xf, 0xf, true);
            pf += __builtin_amdgcn_update_dpp(0, pf, 0x114, 0xf, 0xf, true);
            pf += __builtin_amdgcn_update_dpp(0, pf, 0x118, 0xf, 0xf, true);
            pf += __builtin_amdgcn_update_dpp(0, pf, 0x142, 0xa, 0xf, true);
            pf += __builtin_amdgcn_update_dpp(0, pf, 0x143, 0xc, 0xf, true);
            const int total = __builtin_amdgcn_readlane(pf, 63);
            const int above_lane = total - pf;
            const bool cross = (above_lane < need) && (above_lane + sl >= need);
            const int cl = __builtin_ctzll(__ballot(cross));
            const int t3 = above_lane + (int)c4.w, t2 = t3 + (int)c4.z, t1 = t2 + (int)c4.y;
            int dsel, ab, cd;
            if (t3 >= need) { dsel = 3; ab = above_lane; cd = (int)c4.w; }
            else if (t2 >= need) { dsel = 2; ab = t3; cd = (int)c4.z; }
            else if (t1 >= need) { dsel = 1; ab = t2; cd = (int)c4.y; }
            else { dsel = 0; ab = t1; cd = (int)c4.x; }
            const int d = 4 * cl + __builtin_amdgcn_readlane(dsel, cl);
            const int above = __builtin_amdgcn_readlane(ab, cl), cnt_d = __builtin_amdgcn_readlane(cd, cl);
            need -= above;
            prefix = (prefix << width) | (unsigned)d;
            T = prefix << shift;
            if (cnt_d == need) { exact = true; break; }
        }
        }
        if (exact) {
#pragma unroll
            for (int i = 0; i < 64; ++i) { const unsigned long long bm = __ballot(x[i] >= T);
                wl[i] = bm; }
        } else {
            int cgt = 0;
#pragma unroll
            for (int i = 0; i < 64; ++i) cgt += __builtin_popcountll(__ballot(x[i] > T));
            const int r = 256 - cgt;
            int base = 0;
#pragma unroll
            for (int i = 0; i < 64; ++i) {
                const unsigned long long bgt = __ballot(x[i] > T), beq = __ballot(x[i] == T);
                const int neq = __builtin_popcountll(beq);
                int take = r - base; take = take < 0 ? 0 : take;
                unsigned long long word = bgt | beq;
                if (take < neq) {
                    const int pre = __builtin_popcountll(beq & ((1ull << lane) - 1ull));
                    word = bgt | __ballot((x[i] == T) && pre < take);
                }
                base += neq;
                wl[i] = word;
            }
        }
        LDS_WAIT();
        st8wt(mask, ((size_t)(mq0 + w) * 64 + lane) * 8, (size_t)M * 64 * 8, wl[lane]); pend_row = mq0 + w;
        LDS_WAIT();
        it = itn;
    }
    if (pend_row >= 0) { asm volatile("s_waitcnt vmcnt(0)" ::: "memory"); if (lane == 0) __hip_atomic_fetch_add(mask_counter(F.ctl, pend_row), 1u, __ATOMIC_RELAXED, __HIP_MEMORY_SCOPE_AGENT); }
}

constexpr float SM_SCALE = 0.088388347648318440f;
constexpr int KVBLK = 64;
constexpr size_t SHM_V = KVBLK * HD * 2, SHM_K = KVBLK * HD * 2;
#define KSWZ(row, colB) ((row) * 256 + ((colB) ^ (((row) & 7) << 4)))
__device__ __forceinline__ int crow(int r, int hi) { return (r & 3) + 8 * (r >> 2) + 4 * hi; }
__device__ __forceinline__ int v_st(int k, int c) { const int kk = (k & ~0xC) | ((k & 4) << 1) | ((k & 8) >> 1); return ((kk >> 3) * 4 + (c >> 5)) * 512 + ((kk & 7) * 32 + (c & 31)) * 2; }
__device__ __forceinline__ int v_rd_base(int lane) { return ((lane & 3) << 3) | (((lane >> 2) & 3) << 6) | (((lane >> 4) & 1) << 5) | (((lane >> 5) & 1) << 8); }
constexpr int v_rd_off(int d0, int ks, int half) { return d0 * 512 + ks * 4096 + half * 2048; }
template <int OFF> __device__ __forceinline__ s16x4 tr_read(int vb) {
    s16x4 r; asm volatile("ds_read_b64_tr_b16 %0, %1 offset:%2" : "=&v"(r) : "v"(vb), "i"(OFF) : "memory"); return r;
}
template <int D0> __device__ __forceinline__ void pv_one(f32x16& od, int vb, bf16x8 pa0, bf16x8 pa1, bf16x8 pa2, bf16x8 pa3) {
    const s16x4 l0 = tr_read<v_rd_off(D0, 0, 0)>(vb), h0 = tr_read<v_rd_off(D0, 0, 1)>(vb), l1 = tr_read<v_rd_off(D0, 1, 0)>(vb), h1 = tr_read<v_rd_off(D0, 1, 1)>(vb);
    const s16x4 l2 = tr_read<v_rd_off(D0, 2, 0)>(vb), h2 = tr_read<v_rd_off(D0, 2, 1)>(vb), l3 = tr_read<v_rd_off(D0, 3, 0)>(vb), h3 = tr_read<v_rd_off(D0, 3, 1)>(vb);
    asm volatile("s_waitcnt lgkmcnt(0)" ::: "memory"); SBAR();
#define PK(L, H) (bf16x8){L[0], L[1], L[2], L[3], H[0], H[1], H[2], H[3]}
    od = __builtin_amdgcn_mfma_f32_32x32x16_bf16(pa0, PK(l0, h0), od, 0, 0, 0);
    od = __builtin_amdgcn_mfma_f32_32x32x16_bf16(pa1, PK(l1, h1), od, 0, 0, 0);
    od = __builtin_amdgcn_mfma_f32_32x32x16_bf16(pa2, PK(l2, h2), od, 0, 0, 0);
    od = __builtin_amdgcn_mfma_f32_32x32x16_bf16(pa3, PK(l3, h3), od, 0, 0, 0);
#undef PK
}
__device__ __forceinline__ void pv_d0(f32x16* o, int vb, bf16x8 pa0, bf16x8 pa1, bf16x8 pa2, bf16x8 pa3) {
    pv_one<0>(o[0], vb, pa0, pa1, pa2, pa3); pv_one<1>(o[1], vb, pa0, pa1, pa2, pa3); pv_one<2>(o[2], vb, pa0, pa1, pa2, pa3); pv_one<3>(o[3], vb, pa0, pa1, pa2, pa3);
}
__device__ __forceinline__ void qkt(f32x16& p0, f32x16& p1, const char* Ks, const bf16x8* qr, int r32, int hi) {
    p0 = f32x16{}; p1 = f32x16{};
#pragma unroll
    for (int d0 = 0; d0 < 8; ++d0) { const int cb = (d0 * 16 + hi * 8) * 2;
        const bf16x8 b0 = *reinterpret_cast<const bf16x8*>(Ks + KSWZ(r32, cb));
        const bf16x8 b1 = *reinterpret_cast<const bf16x8*>(Ks + KSWZ(32 + r32, cb));
        p0 = __builtin_amdgcn_mfma_f32_32x32x16_bf16(b0, qr[d0], p0, 0, 0, 0);
        p1 = __builtin_amdgcn_mfma_f32_32x32x16_bf16(b1, qr[d0], p1, 0, 0, 0); }
}
template <int R> __device__ __forceinline__ void mask_exp(f32x16& p, unsigned w) {
    if constexpr (R < 16) { constexpr int sh = (R & 3) + 8 * (R >> 2); unsigned m; asm("v_bfe_i32 %0, %1, %2, 1" : "=v"(m) : "v"(w), "n"(sh));
        p[R] = __uint_as_float(__float_as_uint(__builtin_amdgcn_exp2f(p[R])) & m); mask_exp<R + 1>(p, w); }
}
constexpr float SM_THR = 8.f;
__device__ __forceinline__ void partialSM(f32x16& p0, f32x16& p1, unsigned long long mw, int hi, float& m_reg, float& mn, float& alpha, unsigned& mhi) {
    constexpr float C = 1.f;
    float pmax = p0[0];
#pragma unroll
    for (int r = 1; r < 16; ++r) pmax = fmaxf(pmax, p0[r]);
#pragma unroll
    for (int r = 0; r < 16; ++r) pmax = fmaxf(pmax, p1[r]);
    { auto rr = __builtin_amdgcn_permlane32_swap(__float_as_uint(pmax), __float_as_uint(pmax), false, false);
      pmax = fmaxf(__uint_as_float(rr[0]), __uint_as_float(rr[1])); }
    if (__builtin_expect(__all(pmax - m_reg <= SM_THR * 1.4426950408889634f), 1)) { mn = m_reg; alpha = 1.f; }
    else { mn = fmaxf(m_reg, pmax); alpha = __builtin_amdgcn_exp2f((m_reg - mn) * C); m_reg = mn; }
    const float mnC = -mn * C;
#pragma unroll
    for (int r = 0; r < 16; ++r) p0[r] = fmaf(p0[r], C, mnC);
#pragma unroll
    for (int r = 0; r < 16; ++r) p1[r] = fmaf(p1[r], C, mnC);
    const unsigned w0 = (unsigned)mw >> (4 * hi); mhi = (unsigned)(mw >> 32) >> (4 * hi);
    mask_exp<0>(p0, w0);
}
__device__ __forceinline__ void finishSM(f32x16& p0, f32x16& p1, float alpha, unsigned mhi, float& l_reg, bf16x8& pa0, bf16x8& pa1, bf16x8& pa2, bf16x8& pa3) {
    mask_exp<0>(p1, mhi);
    float ps = 0;
#pragma unroll
    for (int r = 0; r < 16; ++r) ps += p0[r];
#pragma unroll
    for (int r = 0; r < 16; ++r) ps += p1[r];
    { auto rr = __builtin_amdgcn_permlane32_swap(__float_as_uint(ps), __float_as_uint(ps), false, false);
      ps = __uint_as_float(rr[0]) + __uint_as_float(rr[1]); }
    l_reg = l_reg * alpha + ps;
#define PK4(P, BASE, OUT) do { unsigned a0 = cvtpk(P[BASE + 0], P[BASE + 1]), a1 = cvtpk(P[BASE + 2], P[BASE + 3]);   \
    unsigned b0 = cvtpk(P[BASE + 4], P[BASE + 5]), b1 = cvtpk(P[BASE + 6], P[BASE + 7]);                              \
    auto r0 = __builtin_amdgcn_permlane32_swap(a0, b0, false, false); auto r1 = __builtin_amdgcn_permlane32_swap(a1, b1, false, false); \
    v4u wq = {r0[0], r1[0], r0[1], r1[1]}; OUT = *reinterpret_cast<bf16x8*>(&wq); } while (0)
    PK4(p0, 0, pa0); PK4(p0, 8, pa1); PK4(p1, 0, pa2); PK4(p1, 8, pa3);
#undef PK4
}

__device__ __forceinline__ void partialFast(f32x16& p0, unsigned long long mw, int hi, unsigned& mhi) {
    const unsigned w0 = (unsigned)mw >> (4 * hi); mhi = (unsigned)(mw >> 32) >> (4 * hi);
    mask_exp<0>(p0, w0);
}
__device__ __forceinline__ void finishFast(f32x16& p0, f32x16& p1, unsigned mhi, float& l_reg, bf16x8& pa0, bf16x8& pa1, bf16x8& pa2, bf16x8& pa3) {
    mask_exp<0>(p1, mhi);
    float ps = 0;
#pragma unroll
    for (int r = 0; r < 16; ++r) ps += p0[r];
#pragma unroll
    for (int r = 0; r < 16; ++r) ps += p1[r];
    { auto rr = __builtin_amdgcn_permlane32_swap(__float_as_uint(ps), __float_as_uint(ps), false, false);
      ps = __uint_as_float(rr[0]) + __uint_as_float(rr[1]); }
    l_reg += ps;
#define PK4(P, BASE, OUT) do { unsigned a0 = cvtpk(P[BASE + 0], P[BASE + 1]), a1 = cvtpk(P[BASE + 2], P[BASE + 3]);   \
    unsigned b0 = cvtpk(P[BASE + 4], P[BASE + 5]), b1 = cvtpk(P[BASE + 6], P[BASE + 7]);                              \
    auto r0 = __builtin_amdgcn_permlane32_swap(a0, b0, false, false); auto r1 = __builtin_amdgcn_permlane32_swap(a1, b1, false, false); \
    v4u wq = {r0[0], r1[0], r0[1], r1[1]}; OUT = *reinterpret_cast<bf16x8*>(&wq); } while (0)
    PK4(p0, 0, pa0); PK4(p0, 8, pa1); PK4(p1, 0, pa2); PK4(p1, 8, pa3);
#undef PK4
}

template <bool SAMPLE, bool FAST>
__device__ __forceinline__ bool attn_unit(Frame& F, int b, int kvh, int qt, char* lds) {
    GAS unsigned char* ws = F.ws; asm volatile("" : "+s"(ws)); karg_t* kp = kargs();
    const GAS int* page_table = INPTR(int, kp, I_PT); const GAS float* cache_k = INPTR(float, kp, I_CK); const GAS float* cache_v = INPTR(float, kp, I_CV);
    const GAS bf16* qb = (const GAS bf16*)(ws + WS_QB); const GAS bf16* kb = (const GAS bf16*)(ws + WS_KB); const GAS bf16* vb = (const GAS bf16*)(ws + WS_VB);
    const GAS unsigned long long* maskb = (const GAS unsigned long long*)(ws + WS_MASK);
    const int tid = F.wave * 64 + lane_opaque();
    const int wid = F.wave, lane = tid & 63, r32 = lane & 31, hi = lane >> 5;
    char* V_lds = lds; char* K_lds = lds + 3 * SHM_V;
    float* wsl = (float*)(lds + 3 * SHM_V + 3 * SHM_K) + wid * 64; float* li_l = wsl; float* al_l = wsl + 32;
    float m_reg = -1e30f, l_reg = 0; f32x16 o[4] = {}; bf16x8 qr[8];
    const int tokw = SAMPLE ? 0 : 8 * wid;
    const int mrow0 = SAMPLE ? (MP + b * TS) : (b * TP + qt * 64);
    const int mtok = mrow0 + tokw + (r32 >> 2);
    const int head = kvh * 4 + (r32 & 3);
    { const GAS bf16* Qw = qb + (size_t)mtok * D + head * HD + hi * 8;
#pragma unroll
      for (int d0 = 0; d0 < 8; ++d0) qr[d0] = *(const GAS bf16x8*)(Qw + d0 * 16); }
    const GAS unsigned long long* mrow = maskb + (size_t)mtok * 64;
    const int sr = tid >> 4, sc = (tid & 15) * 8, vst0 = v_st(sr, sc), vst1 = v_st(32 + sr, sc);
    const int vb0 = (int)(uintptr_t)V_lds + v_rd_base(lane);
    const int NT = SAMPLE ? 34 : ((qt + 1) + ((qt + 1) & 1));
    typedef typename std::conditional<SAMPLE, f32x8, bf16x8>::type ST;
    ST vs0, vs1, ks0, ks1;
    auto tobf = [](ST x) -> bf16x8 {
        if constexpr (SAMPLE) { v4u wq = {cvtpk(x[0], x[1]), cvtpk(x[2], x[3]), cvtpk(x[4], x[5]), cvtpk(x[6], x[7])}; return *reinterpret_cast<bf16x8*>(&wq); }
        else return x; };
#define SLOAD(kt) do { \
        if constexpr (SAMPLE) { \
            if ((kt) < 32) { const int phys = page_table[b * NPG + ((kt) >> 1)]; \
                const size_t r0 = ((size_t)phys * PAGE + ((kt) & 1) * 64 + sr) * (NKV * HD) + kvh * HD + sc, r1 = r0 + (size_t)32 * (NKV * HD); \
                vs0 = *(const GAS f32x8*)(cache_v + r0); vs1 = *(const GAS f32x8*)(cache_v + r1); ks0 = *(const GAS f32x8*)(cache_k + r0); ks1 = *(const GAS f32x8*)(cache_k + r1); } \
            else { const size_t r0 = (size_t)(mrow0 + (sr & 7)) * 256 + kvh * HD + sc; \
                const bf16x8 kv = *(const GAS bf16x8*)(kb + r0), vv = *(const GAS bf16x8*)(vb + r0); \
                _Pragma("unroll") for (int _e = 0; _e < 8; ++_e) { ks0[_e] = bf2f((unsigned short)kv[_e]); vs0[_e] = bf2f((unsigned short)vv[_e]); } ks1 = ks0; vs1 = vs0; } \
        } else { \
            const size_t r0 = (size_t)(b * TP + (kt) * 64 + sr) * 256 + kvh * HD + sc, r1 = r0 + (size_t)32 * 256; \
            vs0 = *(const GAS bf16x8*)(vb + r0); vs1 = *(const GAS bf16x8*)(vb + r1); ks0 = *(const GAS bf16x8*)(kb + r0); ks1 = *(const GAS bf16x8*)(kb + r1); } } while (0)
#define SWRITE(bsel) do { *(bf16x8*)(V_lds + (bsel) * SHM_V + vst0) = tobf(vs0); *(bf16x8*)(V_lds + (bsel) * SHM_V + vst1) = tobf(vs1); const int kc = sc * 2; \
        *(bf16x8*)(K_lds + (bsel) * SHM_K + KSWZ(sr, kc)) = tobf(ks0); *(bf16x8*)(K_lds + (bsel) * SHM_K + KSWZ(32 + sr, kc)) = tobf(ks1); } while (0)
#define RESC(a) do { if (__any((a) < 1.f)) { if (hi == 0) al_l[r32] = (a); asm volatile("s_waitcnt lgkmcnt(0)" ::: "memory"); \
        _Pragma("unroll") for (int d = 0; d < 4; ++d) _Pragma("unroll") for (int r = 0; r < 16; ++r) o[d][r] *= al_l[crow(r, hi)]; } } while (0)
    f32x16 pA0, pA1, pB0, pB1; float mnA, mnB, alA, alB; bf16x8 pa0, pa1, pa2, pa3;
    unsigned long long mw; unsigned mhA, mhB;
#define PSM(P0, P1, MN, AL, MH) do { if constexpr (FAST) partialFast(P0, mw, hi, MH); else partialSM(P0, P1, mw, hi, m_reg, MN, AL, MH); } while (0)
#define FSM(P0, P1, AL, MH) do { if constexpr (FAST) finishFast(P0, P1, MH, l_reg, pa0, pa1, pa2, pa3); else finishSM(P0, P1, AL, MH, l_reg, pa0, pa1, pa2, pa3); } while (0)
#define RESCF(a) do { if constexpr (!FAST) RESC(a); } while (0)
    if (wid == 0) {
        unsigned* cw = mask_counter(F.ctl, mrow0); unsigned polls = 0;
        while ((unsigned)__builtin_amdgcn_readfirstlane(__hip_atomic_load(cw, __ATOMIC_RELAXED, __HIP_MEMORY_SCOPE_AGENT)) < (SAMPLE ? 8u : 64u)) { if (++polls > (1u << 18)) break; __builtin_amdgcn_s_sleep(2); }
        __builtin_amdgcn_fence(__ATOMIC_ACQUIRE, "agent");
        asm volatile("s_waitcnt vmcnt(0)" ::: "memory"); }
    __syncthreads();
    if (FAST && tid == 0) F.MISC[24] = 0u;
    SLOAD(0); mw = mrow[0]; VM_WAIT(); SWRITE(0); __syncthreads();
    qkt(pA0, pA1, K_lds, qr, r32, hi); PSM(pA0, pA1, mnA, alA, mhA);
    SLOAD(1); mw = mrow[1];
    VM_WAIT(); SWRITE(1); if (NT > 2) SLOAD(2); __syncthreads();
    int s0 = 0, s1 = 1, s2 = 2;
    for (int t = 1; t + 1 < NT; t += 2) {
        VM_WAIT(); SWRITE(s2); SLOAD(t + 2);
        SBAR(); qkt(pB0, pB1, K_lds + s1 * SHM_K, qr, r32, hi);
        FSM(pA0, pA1, alA, mhA); SBAR();
        pv_d0(o, vb0 + s0 * (int)SHM_V, pa0, pa1, pa2, pa3); PSM(pB0, pB1, mnB, alB, mhB); mw = mrow[t + 1];
        RESCF(alB); __syncthreads();
        { const int t_ = s0; s0 = s1; s1 = s2; s2 = t_; }
        VM_WAIT(); SWRITE(s2); if (t + 3 < NT) SLOAD(t + 3);
        SBAR(); qkt(pA0, pA1, K_lds + s1 * SHM_K, qr, r32, hi);
        FSM(pB0, pB1, alB, mhB); SBAR();
        pv_d0(o, vb0 + s0 * (int)SHM_V, pa0, pa1, pa2, pa3); PSM(pA0, pA1, mnA, alA, mhA); mw = mrow[t + 2];
        RESCF(alA); __syncthreads();
        { const int t_ = s0; s0 = s1; s1 = s2; s2 = t_; }
    }
    SBAR(); qkt(pB0, pB1, K_lds + s1 * SHM_K, qr, r32, hi);
    FSM(pA0, pA1, alA, mhA); SBAR();
    pv_d0(o, vb0 + s0 * (int)SHM_V, pa0, pa1, pa2, pa3); PSM(pB0, pB1, mnB, alB, mhB);
    RESCF(alB);
    FSM(pB0, pB1, alB, mhB); SBAR();
    pv_d0(o, vb0 + s1 * (int)SHM_V, pa0, pa1, pa2, pa3);
    if constexpr (FAST) { if (__any(!(l_reg > 1e-30f && l_reg < 1e30f)) && lane == 0) F.MISC[24] = 1u; }
#undef PSM
#undef FSM
#undef RESCF
    if (hi == 0) li_l[r32] = l_reg; asm volatile("s_waitcnt lgkmcnt(0)" ::: "memory");
    bool bad_unit = false;
    {
        int lane_e = (int)__builtin_amdgcn_mbcnt_hi(~0u, __builtin_amdgcn_mbcnt_lo(~0u, 0u)); asm volatile("" : "+v"(lane_e) :: "memory"); const int r32e = lane_e & 31, hie = lane_e >> 5;
        float rli[16];
#pragma unroll
        for (int r = 0; r < 16; ++r) rli[r] = __builtin_amdgcn_rcpf(li_l[crow(r, hie)]);
        __syncthreads();
        if constexpr (FAST) { bad_unit = F.MISC[24] != 0u;
#ifdef PROBE_FORCE_SAFE
            bad_unit = bad_unit || (qt & 1);
#endif
        }
        float* ol = (float*)(lds + wid * 16384);
#pragma unroll
        for (int r = 0; r < 16; ++r) { const int orow = crow(r, hie);
#pragma unroll
            for (int d0 = 0; d0 < 4; ++d0) ol[orow * 128 + d0 * 32 + r32e] = o[d0][r] * rli[r]; }
        asm volatile("s_waitcnt lgkmcnt(0)" ::: "memory");
        if (!SAMPLE || wid == 0) {
            const GAS bf16* ub = (const GAS bf16*)(ws + WS_UB); const GAS bf16* bgb = (const GAS bf16*)(ws + WS_BG); const GAS bf16* sgab = (const GAS bf16*)(ws + WS_SGA);
            GAS bf16* merged = (GAS bf16*)(ws + WS_MERGED);
            karg_t* kp2 = kargs(); const GAS float* conv_w = INPTR(float, kp2, I_CONVW); const GAS float* state_conv = INPTR(float, kp2, I_SC);
            const int ch = kvh * 512 + lane_e * 8;
            const f32x8 w0 = *(const GAS f32x8*)(conv_w + ch), w1 = *(const GAS f32x8*)(conv_w + D + ch), w2 = *(const GAS f32x8*)(conv_w + 2 * D + ch);
            if constexpr (!SAMPLE) {
                const int tq0 = qt * 64 + tokw; const size_t off0 = (size_t)(mrow0 + tokw) * D + ch;
                bf16x8 ur[10], sgr[8], bgr[8];
#pragma unroll
                for (int i = 0; i < 10; ++i) { const bool ok = tq0 + i - 2 >= 0; const bf16x8 x = *(const GAS bf16x8*)(ub + (ok ? off0 + (size_t)(i - 2) * D : off0)); ur[i] = ok ? x : bf16x8{}; }
#pragma unroll
                for (int tk = 0; tk < 8; ++tk) { sgr[tk] = *(const GAS bf16x8*)(sgab + off0 + (size_t)tk * D); bgr[tk] = *(const GAS bf16x8*)(bgb + off0 + (size_t)tk * D); }
#pragma unroll
                for (int tk = 0; tk < 8; ++tk) {
                    const f32x8 ov = *(const f32x8*)(ol + tk * 512 + lane_e * 8);
                    float val[8];
#pragma unroll
                    for (int e = 0; e < 8; ++e) { const float cv = w0[e] * bf2f((unsigned short)ur[tk][e]) + w1[e] * bf2f((unsigned short)ur[tk + 1][e]) + w2[e] * bf2f((unsigned short)ur[tk + 2][e]);
                        val[e] = bf2f((unsigned short)sgr[tk][e]) * ov[e] + bf2f((unsigned short)bgr[tk][e]) * cv; }
                    v4u pk = {cvtpk(val[0], val[1]), cvtpk(val[2], val[3]), cvtpk(val[4], val[5]), cvtpk(val[6], val[7])};
                    st16<true>(merged, (off0 + (size_t)tk * D) * 2, (size_t)M * D * 2, pk);
                }
            } else {
            for (int tk = 0; tk < 8; ++tk) {
                const int tok = tokw + tk, mm = mrow0 + tok, t = SAMPLE ? tok : (qt * 64 + tok);
                const size_t off = (size_t)mm * D + ch;
                const f32x8 ov = *(const f32x8*)(ol + tk * 512 + lane_e * 8);
                const bf16x8 sg = *(const GAS bf16x8*)(sgab + off), bg = *(const GAS bf16x8*)(bgb + off), u2 = *(const GAS bf16x8*)(ub + off);
                f32x8 u1, u0;
                if (t >= 1) { const bf16x8 x = *(const GAS bf16x8*)(ub + off - D);
#pragma unroll
                    for (int e = 0; e < 8; ++e) u1[e] = bf2f((unsigned short)x[e]); }
                else if (SAMPLE) u1 = *(const GAS f32x8*)(state_conv + ((size_t)b * 2 + 1) * D + ch);
                else u1 = f32x8{};
                if (t >= 2) { const bf16x8 x = *(const GAS bf16x8*)(ub + off - 2 * D);
#pragma unroll
                    for (int e = 0; e < 8; ++e) u0[e] = bf2f((unsigned short)x[e]); }
                else if (SAMPLE) u0 = *(const GAS f32x8*)(state_conv + ((size_t)b * 2 + t) * D + ch);
                else u0 = f32x8{};
                float val[8];
#pragma unroll
                for (int e = 0; e < 8; ++e) { const float cv = w0[e] * u0[e] + w1[e] * u1[e] + w2[e] * bf2f((unsigned short)u2[e]);
                    val[e] = bf2f((unsigned short)sg[e]) * ov[e] + bf2f((unsigned short)bg[e]) * cv; }
                v4u pk = {cvtpk(val[0], val[1]), cvtpk(val[2], val[3]), cvtpk(val[4], val[5]), cvtpk(val[6], val[7])};
                st16<true>(merged, off * 2, (size_t)M * D * 2, pk);
            }
            }
            if (!bad_unit) {
                asm volatile("s_waitcnt vmcnt(0)" ::: "memory");
                if (lane_e == 0) __hip_atomic_fetch_add((unsigned*)(F.ctl + CW_DEP) + (size_t)(3 * 128 + (mrow0 >> 8)) * 64, 1u, __ATOMIC_RELAXED, __HIP_MEMORY_SCOPE_AGENT);
            }
        }
    }
#undef SLOAD
#undef SWRITE
#undef RESC
    return bad_unit;
}
__device__ __forceinline__ void attn_sample_unit(Frame& F, int b, int kvh, char* lds) {
    GAS unsigned char* ws = F.ws; asm volatile("" : "+s"(ws)); karg_t* kp = kargs();
    const GAS int* page_table = INPTR(int, kp, I_PT); const GAS float* cache_k = INPTR(float, kp, I_CK); const GAS float* cache_v = INPTR(float, kp, I_CV);
    const GAS bf16* qb = (const GAS bf16*)(ws + WS_QB); const GAS bf16* kb = (const GAS bf16*)(ws + WS_KB); const GAS bf16* vb = (const GAS bf16*)(ws + WS_VB);
    const GAS unsigned long long* maskb = (const GAS unsigned long long*)(ws + WS_MASK);
    const int tid = F.wave * 64 + lane_opaque();
    const int wid = F.wave, lane = tid & 63, r32 = lane & 31, hi = lane >> 5;
    char* V_lds = lds; char* K_lds = lds + 2 * SHM_V;
    float* wsl = (float*)(lds + 2 * SHM_V + 2 * SHM_K) + wid * 64; float* al_l = wsl + 32;
    float* mlt = (float*)(lds + LDSCTL_OFF + 6144);
    float m_reg = -1e30f, l_reg = 0; f32x16 o[4] = {}; bf16x8 qr[8];
    const int mrow0 = MP + b * TS;
    const int mtok = mrow0 + (r32 >> 2);
    const int head = kvh * 4 + (r32 & 3);
    { const GAS bf16* Qw = qb + (size_t)mtok * D + head * HD + hi * 8;
#pragma unroll
      for (int d0 = 0; d0 < 8; ++d0) qr[d0] = *(const GAS bf16x8*)(Qw + d0 * 16); }
    const GAS unsigned long long* mrow = maskb + (size_t)mtok * 64;
    const int sr = tid >> 4, sc = (tid & 15) * 8, vst0 = v_st(sr, sc), vst1 = v_st(32 + sr, sc);
    const int vb0 = (int)(uintptr_t)V_lds + v_rd_base(lane);
    unsigned long long* Mt = (unsigned long long*)(lds + 68 * 1024);
    unsigned long long* Ut = (unsigned long long*)(lds + 72 * 1024);
    int* baset = (int*)(lds + 72 * 1024 + 512);
    int* ptab = (int*)(lds + 72 * 1024 + 832);
    unsigned short* klist = (unsigned short*)(lds + 73 * 1024);
    unsigned long long* cmt = (unsigned long long*)(lds + 78 * 1024);
    if (wid == 0) {
        unsigned* cw = mask_counter(F.ctl, mrow0); unsigned polls = 0;
        while ((unsigned)__builtin_amdgcn_readfirstlane(__hip_atomic_load(cw, __ATOMIC_RELAXED, __HIP_MEMORY_SCOPE_AGENT)) < 8u) { if (++polls > (1u << 18)) break; __builtin_amdgcn_s_sleep(2); }
        __builtin_amdgcn_fence(__ATOMIC_ACQUIRE, "agent");
        asm volatile("s_waitcnt vmcnt(0)" ::: "memory"); }
    __syncthreads();
    Mt[wid * 64 + lane] = lane < 33 ? maskb[(size_t)(mrow0 + wid) * 64 + lane] : 0ull;
    if (tid < NPG) ptab[tid] = page_table[b * NPG + tid];
    asm volatile("s_waitcnt vmcnt(0) lgkmcnt(0)" ::: "memory");
    __syncthreads();
    if (wid == 0) {
        unsigned long long u = 0ull;
#pragma unroll
        for (int w2 = 0; w2 < 8; ++w2) u |= Mt[w2 * 64 + lane];
        const int pc = __builtin_popcountll(u);
        int pf = pc;
        pf += __builtin_amdgcn_update_dpp(0, pf, 0x111, 0xf, 0xf, true);
        pf += __builtin_amdgcn_update_dpp(0, pf, 0x112, 0xf, 0xf, true);
        pf += __builtin_amdgcn_update_dpp(0, pf, 0x114, 0xf, 0xf, true);
        pf += __builtin_amdgcn_update_dpp(0, pf, 0x118, 0xf, 0xf, true);
        pf += __builtin_amdgcn_update_dpp(0, pf, 0x142, 0xa, 0xf, true);
        pf += __builtin_amdgcn_update_dpp(0, pf, 0x143, 0xc, 0xf, true);
        Ut[lane] = u; baset[lane] = pf - pc;
        if (lane == 63) baset[64] = pf;
    }
    asm volatile("s_waitcnt lgkmcnt(0)" ::: "memory");
    __syncthreads();
    const int Cn = baset[64];
#pragma unroll
    for (int i = 0; i < 5; ++i) { const int k = tid + 512 * i;
        if (k < 33 * 64) { const unsigned long long wd = Ut[k >> 6];
            if ((wd >> (k & 63)) & 1ull) klist[baset[k >> 6] + __builtin_popcountll(wd & ((1ull << (k & 63)) - 1ull))] = (unsigned short)k; } }
    asm volatile("s_waitcnt lgkmcnt(0)" ::: "memory");
    __syncthreads();
    const int NTS = (Cn + 63) >> 6;
    for (int j = 0; j < NTS; ++j) {
        const int p = 64 * j + lane; const int key = klist[p < Cn ? p : Cn - 1];
        const bool bit = (p < Cn) && ((Mt[wid * 64 + (key >> 6)] >> (key & 63)) & 1ull);
        const unsigned long long wd = __ballot(bit);
        if (lane == 0) cmt[wid * 34 + j] = wd;
    }
    asm volatile("s_waitcnt lgkmcnt(0)" ::: "memory");
    __syncthreads();
    const unsigned long long* cmrow = cmt + (r32 >> 2) * 34;
    f32x8 vs0, vs1, ks0, ks1;
    auto tobf = [](f32x8 x) -> bf16x8 { v4u wq = {cvtpk(x[0], x[1]), cvtpk(x[2], x[3]), cvtpk(x[4], x[5]), cvtpk(x[6], x[7])}; return *reinterpret_cast<bf16x8*>(&wq); };
    auto ldrow = [&](int p, f32x8& kd, f32x8& vd) {
        const int key = klist[p < Cn ? p : Cn - 1];
        if (key < PAST) { const size_t r0 = ((size_t)ptab[key >> 7] * PAGE + (key & (PAGE - 1))) * (NKV * HD) + kvh * HD + sc;
            kd = *(const GAS f32x8*)(cache_k + r0); vd = *(const GAS f32x8*)(cache_v + r0); }
        else { const size_t r0 = (size_t)(mrow0 + (key - PAST)) * 256 + kvh * HD + sc;
            const bf16x8 kv = *(const GAS bf16x8*)(kb + r0), vv = *(const GAS bf16x8*)(vb + r0);
#pragma unroll
            for (int e = 0; e < 8; ++e) { kd[e] = bf2f((unsigned short)kv[e]); vd[e] = bf2f((unsigned short)vv[e]); } } };
#define SLOAD(kt) do { ldrow(64 * (kt) + sr, ks0, vs0); ldrow(64 * (kt) + 32 + sr, ks1, vs1); } while (0)
#define SWRITE(bsel) do { *(bf16x8*)(V_lds + (bsel) * SHM_V + vst0) = tobf(vs0); *(bf16x8*)(V_lds + (bsel) * SHM_V + vst1) = tobf(vs1); const int kc = sc * 2; \
        *(bf16x8*)(K_lds + (bsel) * SHM_K + KSWZ(sr, kc)) = tobf(ks0); *(bf16x8*)(K_lds + (bsel) * SHM_K + KSWZ(32 + sr, kc)) = tobf(ks1); } while (0)
    SLOAD(0); VM_WAIT(); SWRITE(0); SLOAD(1); __syncthreads();
    for (int j = 0; j < NTS; ++j) {
        if (j + 1 < NTS) { VM_WAIT(); SWRITE((j + 1) & 1); if (j + 2 < NTS) SLOAD(j + 2); }
        if (wid == (j & 7)) {
            const int bsel = j & 1;
            const unsigned long long mw = cmrow[j];
            f32x16 p0, p1; float mn, al; bf16x8 pa0, pa1, pa2, pa3; unsigned mh;
            qkt(p0, p1, K_lds + bsel * SHM_K, qr, r32, hi);
            partialSM(p0, p1, mw, hi, m_reg, mn, al, mh);
            if (__any(al < 1.f)) { if (hi == 0) al_l[r32] = al; asm volatile("s_waitcnt lgkmcnt(0)" ::: "memory");
#pragma unroll
                for (int d = 0; d < 4; ++d)
#pragma unroll
                    for (int r = 0; r < 16; ++r) o[d][r] *= al_l[crow(r, hi)]; }
            finishSM(p0, p1, al, mh, l_reg, pa0, pa1, pa2, pa3); SBAR();
            pv_d0(o, vb0 + bsel * (int)SHM_V, pa0, pa1, pa2, pa3);
        }
        __syncthreads();
    }
    {
        float* ol = (float*)(lds + wid * 16384);
#pragma unroll
        for (int r = 0; r < 16; ++r) { const int orow = crow(r, hi);
#pragma unroll
            for (int d0 = 0; d0 < 4; ++d0) ol[orow * 128 + d0 * 32 + r32] = o[d0][r]; }
        if (hi == 0) { mlt[(wid * 32 + r32) * 2] = m_reg; mlt[(wid * 32 + r32) * 2 + 1] = l_reg; }
        asm volatile("s_waitcnt lgkmcnt(0)" ::: "memory");
        __syncthreads();
        constexpr float C = 1.f;
        const int tk = wid, hq = lane >> 4, row = tk * 4 + hq;
        float mx = -1e30f;
#pragma unroll
        for (int w2 = 0; w2 < 8; ++w2) mx = fmaxf(mx, mlt[(w2 * 32 + row) * 2]);
        float fw[8]; float den = 0.f;
#pragma unroll
        for (int w2 = 0; w2 < 8; ++w2) { fw[w2] = __builtin_amdgcn_exp2f((mlt[(w2 * 32 + row) * 2] - mx) * C); den += fw[w2] * mlt[(w2 * 32 + row) * 2 + 1]; }
        const float rden = __builtin_amdgcn_rcpf(den);
        f32x8 ov = f32x8{};
#pragma unroll
        for (int w2 = 0; w2 < 8; ++w2) { const f32x8 x = *(const f32x8*)((float*)(lds + w2 * 16384) + row * 128 + (lane & 15) * 8); ov += x * fw[w2]; }
        ov = ov * rden;
        const GAS bf16* ub = (const GAS bf16*)(ws + WS_UB); const GAS bf16* bgb = (const GAS bf16*)(ws + WS_BG); const GAS bf16* sgab = (const GAS bf16*)(ws + WS_SGA);
        GAS bf16* merged = (GAS bf16*)(ws + WS_MERGED);
        karg_t* kp2 = kargs(); const GAS float* conv_w = INPTR(float, kp2, I_CONVW); const GAS float* state_conv = INPTR(float, kp2, I_SC);
        const int ch = kvh * 512 + lane * 8;
        const f32x8 w0 = *(const GAS f32x8*)(conv_w + ch), w1 = *(const GAS f32x8*)(conv_w + D + ch), w2v = *(const GAS f32x8*)(conv_w + 2 * D + ch);
        const int t = tk; const size_t off = (size_t)(mrow0 + tk) * D + ch;
        const bf16x8 sg = *(const GAS bf16x8*)(sgab + off), bg = *(const GAS bf16x8*)(bgb + off), u2 = *(const GAS bf16x8*)(ub + off);
        f32x8 u1, u0;
        if (t >= 1) { const bf16x8 x = *(const GAS bf16x8*)(ub + off - D);
#pragma unroll
            for (int e = 0; e < 8; ++e) u1[e] = bf2f((unsigned short)x[e]); }
        else u1 = *(const GAS f32x8*)(state_conv + ((size_t)b * 2 + 1) * D + ch);
        if (t >= 2) { const bf16x8 x = *(const GAS bf16x8*)(ub + off - 2 * D);
#pragma unroll
            for (int e = 0; e < 8; ++e) u0[e] = bf2f((unsigned short)x[e]); }
        else u0 = *(const GAS f32x8*)(state_conv + ((size_t)b * 2 + t) * D + ch);
        float val[8];
#pragma unroll
        for (int e = 0; e < 8; ++e) { const float cv = w0[e] * u0[e] + w1[e] * u1[e] + w2v[e] * bf2f((unsigned short)u2[e]);
            val[e] = bf2f((unsigned short)sg[e]) * ov[e] + bf2f((unsigned short)bg[e]) * cv; }
        v4u pk = {cvtpk(val[0], val[1]), cvtpk(val[2], val[3]), cvtpk(val[4], val[5]), cvtpk(val[6], val[7])};
        st16<true>(merged, off * 2, (size_t)M * D * 2, pk);
        asm volatile("s_waitcnt vmcnt(0)" ::: "memory");
        if (lane == 0) __hip_atomic_fetch_add((unsigned*)(F.ctl + CW_DEP) + (size_t)(3 * 128 + (mrow0 >> 8)) * 64, 1u, __ATOMIC_RELAXED, __HIP_MEMORY_SCOPE_AGENT);
    }
#undef SLOAD
#undef SWRITE
}
__device__ __forceinline__ void p4_attention(Frame& F, char* lds_generic) {
    char* lds = lds_generic + RING_OFF;
    const int grp = __builtin_amdgcn_readfirstlane(((int)blockIdx.x >> 3) & 1);
#pragma unroll 1
    for (int step = 0; step < 2; ++step) {
        const int kind = __builtin_amdgcn_readfirstlane(step ^ grp);
        if (kind == 0) {
            for (int it = blockIdx.x; it < 256; it += F.G) attn_sample_unit(F, it >> 1, it & 1, lds);
        } else {
            for (int it = blockIdx.x; it < 256; it += F.G) {
                const int combo = it & 7, i = it >> 3, b = combo >> 1, kvh = combo & 1;
                for (int h2 = 0; h2 < 2; ++h2) { const int qt = h2 ? i : 63 - i;
                    if (attn_unit<false, true>(F, b, kvh, qt, lds)) attn_unit<false, false>(F, b, kvh, qt, lds); }
            }
        }
    }
}

__device__ __forceinline__ void p9_final(Frame& F) {
    const int lane = lane_opaque(), w = F.wave;
    const GAS float* part3 = (const GAS float*)(F.ws + WS_PART3); const GAS bf16* x3b = (const GAS bf16*)(F.ws + WS_X3B);
    karg_t* kp = kargs(); const GAS f32x4* gr = (const GAS f32x4*)INPTR(float, kp, I_NFIN);
    f32x4 g4[4];
#pragma unroll
    for (int j = 0; j < 4; ++j) g4[j] = gr[(j >> 1) * 128 + 2 * lane + (j & 1)];
    unsigned* qc = (unsigned*)(F.ctl + CW_Q + 2 * 64); unsigned* bank = (unsigned*)(F.ctl + CW_DEP) + (size_t)4 * 128 * 64;
    for (;;) {
        __syncthreads();
        if (w == 0) { unsigned c = 0u; if (lane == 0) c = __hip_atomic_fetch_add(qc, 1u, __ATOMIC_RELAXED, __HIP_MEMORY_SCOPE_AGENT);
            c = (unsigned)__builtin_amdgcn_readfirstlane((int)c);
            if (c < (unsigned)(M / 32)) { const int pi = (int)c >> 3, pm = pi < 4 ? 64 + pi : 8 * ((pi - 4) & 7) + ((pi - 4) >> 3);
                unsigned* cw = bank + (size_t)pm * 64; unsigned polls = 0;
                while ((unsigned)__builtin_amdgcn_readfirstlane(__hip_atomic_load(cw, __ATOMIC_RELAXED, __HIP_MEMORY_SCOPE_AGENT)) < 32u) { if (++polls > (1u << 18)) break; __builtin_amdgcn_s_sleep(2); }
                __builtin_amdgcn_fence(__ATOMIC_ACQUIRE, "agent");
                asm volatile("s_waitcnt vmcnt(0)" ::: "memory");
                c = (unsigned)(pm * 8 + ((int)c & 7)); }
            else c = 0xffffffffu;
            if (lane == 0) F.MISC[16] = c; LDS_WAIT(); }
        __syncthreads();
        const unsigned ch = F.MISC[16];
        if (ch == 0xffffffffu) break;
        const int r0 = (int)ch * 32 + w * 4;
#pragma unroll
        for (int h = 0; h < 1; ++h) {
            v4u v[4][2]; float rs[4];
#pragma unroll
            for (int u = 0; u < 4; ++u) { const int m = r0 + 4 * h + u; rs[u] = row_rs(part3, m);
                const GAS v4u* xr = (const GAS v4u*)(x3b + (size_t)m * D) + lane; v[u][0] = xr[0]; v[u][1] = xr[64]; }
#pragma unroll
            for (int u = 0; u < 4; ++u) { const int m = r0 + 4 * h + u; GAS f32x4* yr = (GAS f32x4*)(F.out + O_Y + (size_t)m * D);
#pragma unroll
                for (int hh = 0; hh < 2; ++hh) { f32x4 a, b; unpack8(v[u][hh], a, b);
                    yr[hh * 128 + 2 * lane] = a * rs[u] * g4[2 * hh]; yr[hh * 128 + 2 * lane + 1] = b * rs[u] * g4[2 * hh + 1]; } }
        }
    }
}

__global__ void __launch_bounds__(NWAVES * 64, 2) mk_fwd(Args args) {
    extern __shared__ __attribute__((aligned(16))) unsigned char lds[];
    Frame F;
    F.lds = (LAS unsigned char*)lds;
    F.MISC = (volatile LAS unsigned*)(F.lds + MISC_OFF);
    F.tid = threadIdx.x; F.lane = F.tid & 63; F.wave = __builtin_amdgcn_readfirstlane(F.tid >> 6);
    F.G = gridDim.x;
    karg_t* kp0 = kargs();
    GAS unsigned char* ws = (GAS unsigned char*)kp0[21]; F.ws = ws; F.out = (GAS float*)kp0[20];
    F.ctl = (gu32*)(ws + WS_CTL);
    for (int u = F.tid; u < (LDS_BYTES - LDSCTL_OFF) / 4; u += NWAVES * 64) ((LAS unsigned*)(F.lds + LDSCTL_OFF))[u] = 0u;
    __syncthreads();
    const int lo = args.ph_lo, hi = args.ph_hi; F.qoff = args.qoff;
    const bool multi = (hi - lo) > 1;
    XcdBarrier bar; bar.bar = (unsigned*)(F.ctl + CW_BAR); bar.x = 0; bar.st = nullptr;
    if (multi) bar = xcd_barrier_post((unsigned*)(F.ctl + CW_BAR), F.MISC + 8, F.tid);
#ifndef PHASE_MASK
#define PHASE_MASK 0xfff
#endif
#define IN(k) (((PHASE_MASK >> (k)) & 1) && lo <= (k) && (k) < hi && (F.lane = lane_opaque(), F.tid = F.wave * 64 + F.lane, true))
#define INP(k) (((PHASE_MASK >> (k)) & 1) && lo <= (k) && (k) < hi)
#define SEAM(k) do { if (INP(k) && INP((k) + 1)) xcd_barrier(bar, F.wave * 64 + lane_opaque()); } while (0)
    using pg8::Gemm; using pg8::StaticOrder;
    const GAS bf16* HB = (const GAS bf16*)(ws + WS_HB);

    if (IN(0)) { if (blockIdx.x == 0 && F.tid < 8) __hip_atomic_store((unsigned*)(F.ctl + CW_Q + 64 * F.tid), 0u, RLX_AGENT);
                 p0_prologue(F); } SEAM(0);

    if (IN(1)) {
        { Gemm g{HB, (const GAS bf16*)(ws + WS_WIN), M, NIN, D}; StaticOrder S; S.init(M, NIN, F.G, (int)blockIdx.x);
          EpiIn E{(GAS bf16*)(ws + WS_QB), (GAS bf16*)(ws + WS_KB), (GAS bf16*)(ws + WS_VB), (GAS bf16*)(ws + WS_QIB), (GAS bf16*)(ws + WS_KIB), (GAS bf16*)(ws + WS_UB), (GAS bf16*)(ws + WS_BG), (GAS bf16*)(ws + WS_SGA),
                  (GAS float*)(ws + WS_WI), (const GAS float2*)(ws + WS_CS128), (const GAS float2*)(ws + WS_CS64), F.out};
          pg8::gemm_phase<EpiIn, StaticOrder, true, true>(F.lds + RING_OFF, g, S, E, F.wave * 64 + lane_opaque()); }
    } SEAM(1);

    if (IN(2)) { p2_index_select(F); }
    if (IN(3)) { p4_attention(F, (char*)lds); }

    if (IN(4)) {
        pg8::Stream S;
        S.A[0] = WS_PB; S.Bt[0] = WS_WPLE; S.nN[0] = D / 256;   S.K[0] = DPLE; S.dep[0] = -1; S.need[0] = 0;                S.pub[0] = 2;
        S.A[1] = WS_MERGED; S.Bt[1] = WS_WOUT; S.nN[1] = D / 256;   S.K[1] = D;    S.dep[1] = 3;  S.need[1] = 64; S.need1_hi = 512;  S.pub[1] = 0;
        S.A[2] = WS_X1B; S.Bt[2] = WS_WGU;  S.nN[2] = NGU / 256; S.K[2] = D;    S.dep[2] = 0;  S.need[2] = 8 * (D / 256);    S.pub[2] = 1;
        S.A[3] = WS_ACT; S.Bt[3] = WS_WDN;  S.nN[3] = D / 256;   S.K[3] = DFF;  S.dep[3] = 1;  S.need[3] = 8 * (NGU / 256);  S.pub[3] = 2;
        S.A[4] = WS_X2B; S.Bt[4] = WS_WPG;  S.nN[4] = D / 256;   S.K[4] = D;    S.dep[4] = 2;  S.need[4] = 16 * (D / 256);   S.pub[4] = 4;
        S.nM = M / 256; S.first[0] = 0;
        S.first[1] = S.first[0] + S.nM * S.nN[0]; S.first[2] = S.first[1] + S.nM * S.nN[1]; S.first[3] = S.first[2] + S.nM * S.nN[2]; S.first[4] = S.first[3] + S.nM * S.nN[3]; S.first[5] = S.first[4] + S.nM * S.nN[4];
        S.base = ws; S.cnt = (unsigned*)(F.ctl + CW_DEP); S.G = F.G; S.c = (int)blockIdx.x;
        karg_t* kp = kargs();
        EpiStream E{ws, F.out, INPTR(float, kp, I_XP), INPTR(float, kp, I_XS)};
        pg8::gemm_stream<EpiStream>(F.lds + RING_OFF, S, E, F.wave * 64 + lane_opaque(), F.MISC + 20);
    }

    if (IN(5)) { p9_final(F); }
#undef IN
#undef SEAM
}

extern "C" void kernel_launch(void* const* d_in, const int* in_sizes, int n_in, void* d_out, int out_size, void* d_ws, size_t ws_size, hipStream_t stream) {
    static int grid = 0;
    if (grid == 0) {
        if (n_in != 20 || out_size != (int)O_END || ws_size < WS_END) { fprintf(stderr, "kernel_launch: unexpected shapes: n_in %d out %d ws %zu (need %zu)\n", n_in, out_size, ws_size, (size_t)WS_END); grid = -1; return; }
        int dev = 0, cus = 0;
        if (hipGetDevice(&dev) != hipSuccess || hipDeviceGetAttribute(&cus, hipDeviceAttributeMultiprocessorCount, dev) != hipSuccess) { grid = -1; return; }
        if (hipFuncSetAttribute((const void*)mk_fwd, hipFuncAttributeMaxDynamicSharedMemorySize, LDS_BYTES) != hipSuccess) { fprintf(stderr, "kernel_launch: hipFuncSetAttribute failed\n"); grid = -1; return; }
        int nb = 0;
        if (hipOccupancyMaxActiveBlocksPerMultiprocessor(&nb, (const void*)mk_fwd, NWAVES * 64, LDS_BYTES) != hipSuccess || nb < 1) { fprintf(stderr, "kernel_launch: occupancy query failed (%d)\n", nb); grid = -1; return; }
        (void)hipGetLastError();
        grid = cus;
    }
    if (grid < 0) return;
    if (hipMemsetAsync((char*)d_ws + WS_CTL, 0, CTL_ZERO_BYTES, stream) != hipSuccess) { fprintf(stderr, "kernel_launch: memset failed\n"); return; }
    Args a{};
    for (int i = 0; i < 20; ++i) a.in[i] = d_in[i];
    a.out = (float*)d_out; a.ws = (unsigned char*)d_ws;
#if MK_ONE_LAUNCH
    a.ph_lo = 0; a.ph_hi = NPHASE;
    hipLaunchKernelGGL(mk_fwd, dim3(grid), dim3(NWAVES * 64), LDS_BYTES, stream, a);
#else
    for (int p = 0; p < NPHASE; ++p) { a.ph_lo = p; a.ph_hi = p + 1; a.qoff = 0; hipLaunchKernelGGL(mk_fwd, dim3(grid), dim3(NWAVES * 64), LDS_BYTES, stream, a); }
#endif
    const hipError_t le = hipPeekAtLastError();
    if (le != hipSuccess) fprintf(stderr, "kernel_launch: launch failed: %s\n", hipGetErrorName(le));
}
```

```cpp
#include <hip/hip_runtime.h>
#include <cstdio>
#include <cstdint>
#include <type_traits>

#ifndef MK_ONE_LAUNCH
#define MK_ONE_LAUNCH 1
#endif

__constant__ const unsigned int STREAM_SCHED[32 * 12] = {
    0x0100, 0x0120, 0x023a, 0x0250, 0x0266, 0x027e, 0x029e, 0x0003, 0x0012, 0x001a, 0x0400, 0x0408,
    0x0101, 0x0121, 0x023b, 0x0251, 0x0267, 0x027f, 0x029f, 0x0004, 0x0013, 0x001b, 0x0401, 0x0409,
    0x0102, 0x0200, 0x0300, 0x0268, 0x0280, 0x02a0, 0x0008, 0x030a, 0x040a, 0xffffu, 0xffffu, 0xffffu,
    0x0103, 0x0201, 0x0301, 0x0269, 0x0281, 0x02a1, 0x0009, 0x030b, 0x040b, 0xffffu, 0xffffu, 0xffffu,
    0x0104, 0x0202, 0x021e, 0x0302, 0x0282, 0x02a2, 0x000a, 0x030c, 0x040c, 0xffffu, 0xffffu, 0xffffu,
    0x0105, 0x0203, 0x021f, 0x0303, 0x0283, 0x02a3, 0x000b, 0x030d, 0x040d, 0xffffu, 0xffffu, 0xffffu,
    0x0106, 0x0204, 0x0220, 0x0304, 0x0284, 0x02a4, 0x000c, 0x030e, 0x040e, 0xffffu, 0xffffu, 0xffffu,
    0x0107, 0x0205, 0x0221, 0x0305, 0x0285, 0x02a5, 0x000d, 0x030f, 0x040f, 0xffffu, 0xffffu, 0xffffu,
    0x0108, 0x0206, 0x0222, 0x0306, 0x0286, 0x02a6, 0x000e, 0x0310, 0x0410, 0xffffu, 0xffffu, 0xffffu,
    0x0109, 0x0207, 0x0223, 0x0307, 0x0287, 0x02a7, 0x000f, 0x0311, 0x0411, 0xffffu, 0xffffu, 0xffffu,
    0x010a, 0x0208, 0x0224, 0x0308, 0x0288, 0x02a8, 0x0010, 0x0312, 0x0412, 0xffffu, 0xffffu, 0xffffu,
    0x010b, 0x0209, 0x0225, 0x0309, 0x0289, 0x02a9, 0x0011, 0x0313, 0x0413, 0xffffu, 0xffffu, 0xffffu,
    0x010c, 0x020a, 0x0226, 0x023c, 0x0252, 0x026a, 0x028a, 0x02aa, 0x0314, 0x0414, 0xffffu, 0xffffu,
    0x010d, 0x020b, 0x0227, 0x023d, 0x0253, 0x026b, 0x028b, 0x02ab, 0x0315, 0x0415, 0xffffu, 0xffffu,
    0x010e, 0x020c, 0x0228, 0x023e, 0x0254, 0x026c, 0x028c, 0x02ac, 0x0316, 0x0416, 0xffffu, 0xffffu,
    0x010f, 0x020d, 0x0229, 0x023f, 0x0255, 0x026d, 0x028d, 0x02ad, 0x0317, 0x0417, 0xffffu, 0xffffu,
    0x0110, 0x020e, 0x022a, 0x0240, 0x0256, 0x026e, 0x028e, 0x02ae, 0x0318, 0x0418, 0xffffu, 0xffffu,
    0x0111, 0x020f, 0x022b, 0x0241, 0x0257, 0x026f, 0x028f, 0x02af, 0x0319, 0x0419, 0xffffu, 0xffffu,
    0x0112, 0x0210, 0x022c, 0x0242, 0x0258, 0x0270, 0x0290, 0x02b0, 0x031a, 0x041a, 0xffffu, 0xffffu,
    0x0113, 0x0211, 0x022d, 0x0243, 0x0259, 0x0271, 0x0291, 0x02b1, 0x031b, 0x041b, 0xffffu, 0xffffu,
    0x0114, 0x0212, 0x022e, 0x0244, 0x025a, 0x0272, 0x0292, 0x02b2, 0x031c, 0x041c, 0xffffu, 0xffffu,
    0x0115, 0x0213, 0x022f, 0x0245, 0x025b, 0x0273, 0x0293, 0x02b3, 0x031d, 0x041d, 0xffffu, 0xffffu,
    0x0116, 0x0214, 0x0230, 0x0246, 0x025c, 0x0274, 0x0294, 0x02b4, 0x031e, 0x041e, 0xffffu, 0xffffu,
    0x0117, 0x0215, 0x0231, 0x0247, 0x025d, 0x0275, 0x0295, 0x02b5, 0x031f, 0x041f, 0xffffu, 0xffffu,
    0x0118, 0x0216, 0x0232, 0x0248, 0x025e, 0x0276, 0x0296, 0x02b6, 0x0320, 0x0420, 0xffffu, 0xffffu,
    0x0119, 0x0217, 0x0233, 0x0249, 0x025f, 0x0277, 0x0297, 0x02b7, 0x0321, 0x0421, 0xffffu, 0xffffu,
    0x011a, 0x0218, 0x0234, 0x024a, 0x0260, 0x0278, 0x0298, 0x02b8, 0x0017, 0x001f, 0x0405, 0xffffu,
    0x011b, 0x0219, 0x0235, 0x024b, 0x0261, 0x0279, 0x0299, 0x02b9, 0x0018, 0x0020, 0x0406, 0xffffu,
    0x011c, 0x021a, 0x0236, 0x024c, 0x0262, 0x027a, 0x029a, 0x02ba, 0x0019, 0x0021, 0x0407, 0xffffu,
    0x011d, 0x021b, 0x0237, 0x024d, 0x0263, 0x027b, 0x029b, 0x0000, 0x0005, 0x0014, 0x001c, 0x0402,
    0x011e, 0x021c, 0x0238, 0x024e, 0x0264, 0x027c, 0x029c, 0x0001, 0x0006, 0x0015, 0x001d, 0x0403,
    0x011f, 0x021d, 0x0239, 0x024f, 0x0265, 0x027d, 0x029d, 0x0002, 0x0007, 0x0016, 0x001e, 0x0404,
};
namespace pg8 {
#define PG8_LAS __attribute__((address_space(3)))
typedef unsigned short bf16_t;
typedef short bf16x8 __attribute__((ext_vector_type(8)));
typedef float f32x4 __attribute__((ext_vector_type(4)));
typedef unsigned u32x4 __attribute__((ext_vector_type(4)));
typedef unsigned u32x2 __attribute__((ext_vector_type(2)));
constexpr int BM = 256, BK = 64, HALF = 128, HTB = HALF * BK * 2, STAGE_BYTES = 8 * HTB, NXCD = 8, WGM = 8;

__host__ __device__ __forceinline__ int lds_byte(int r, int c) { const int st = (r >> 4) * 2 + (c >> 5), rr = r & 15, cc = c & 31, ob = rr * 64 + cc * 2; return st * 1024 + (ob ^ (((ob >> 9) & 1) << 5)); }
__host__ __device__ __forceinline__ void stage_rc(int b, int& R, int& C) { const int st = b / 1024, sb = b % 1024, swz = sb ^ (((sb >> 9) & 1) << 5); R = (st >> 1) * 16 + swz / 64; C = (st & 1) * 32 + (swz % 64) / 2; }

struct Unit { int pm, pn; };
#define PG8_GAS __attribute__((address_space(1)))
struct Gemm { const PG8_GAS bf16_t* A; const PG8_GAS bf16_t* Bt; int M, N, K; };

struct StaticOrder {
    int nM, nN, nwg, G, c;
    __host__ __device__ void init(int M, int N, int G_, int c_) { nM = M / BM; nN = N / BM; nwg = nM * nN; G = G_; c = c_; }
    __host__ __device__ bool next(int i, Unit& u) const {
        const long L = (long)i * G + c; if (L >= nwg) return false;
        int wgid = (int)L; { const int q = nwg / NXCD, r = nwg % NXCD, xcd = wgid % NXCD, off = wgid / NXCD; wgid = (xcd < r ? xcd * (q + 1) : r * (q + 1) + (xcd - r) * q) + off; }
        const int nig = WGM * nN, gid = wgid / nig, fm = gid * WGM, gsz = (nM - fm) < WGM ? (nM - fm) : WGM;
        u.pm = fm + ((wgid % nig) % gsz); u.pn = (wgid % nig) / gsz; return true;
    }
    __device__ __forceinline__ void a_ready(const Unit&) const {}
    __device__ __forceinline__ void done(const Unit&) const {}
};

typedef float f32x2c __attribute__((ext_vector_type(2)));
typedef __bf16 bf16x2c __attribute__((ext_vector_type(2)));
__device__ __forceinline__ unsigned cvt_pk_bf16(float lo, float hi) { const f32x2c v = {lo, hi}; const bf16x2c r = __builtin_convertvector(v, bf16x2c); return __builtin_bit_cast(unsigned, r); }

__host__ __device__ __forceinline__ int perm32(int rho);
template <class Epi, class Sched, bool ALIGN_EPI = false, bool SP2 = false>
__device__ __forceinline__ void gemm_phase(PG8_LAS unsigned char* lds, const Gemm g, const Sched& S, const Epi& E, const int tid) {
    const int wid = __builtin_amdgcn_readfirstlane(tid >> 6), lane = tid & 63, wr = wid >> 2, wc = wid & 3, fr = lane & 15, fq = lane >> 4;
    const int K = g.K, nt = K / BK;
    unsigned voffA[2], voffB[2];
#pragma unroll
    for (int i = 0; i < 2; ++i) { int R, C; stage_rc(tid * 16 + i * 8192, R, C);
        voffA[i] = (unsigned)(R * K + C) * 2u; voffB[i] = (unsigned)(((R & ~31) + perm32(R & 31)) * K + C) * 2u; }
    const size_t kstep = (size_t)(BK * 2);
    const size_t hstep = (size_t)HALF * K * 2;
    const size_t tstep = 2 * hstep;
    const unsigned ldsw = (unsigned)wid * 1024u;
    const int aoff = lds_byte(wr * 64 + fr, fq * 8), boff = lds_byte(wc * 32 + fr, fq * 8);
#define PG8_SA(b, h) (((b) * 2 + (h)) * HTB)
#define PG8_SB(b, h) ((4 + (b) * 2 + (h)) * HTB)
#define PG8_STAGE(bufoff, gbase, voff) do { _Pragma("unroll") for (int _i = 0; _i < 2; ++_i) \
        __builtin_amdgcn_global_load_lds((const PG8_GAS unsigned*)((gbase) + (voff)[_i]), (PG8_LAS unsigned*)(lds + (bufoff) + ldsw + _i * 8192), 16, 0, 0); } while (0)
#define PG8_LDA(dst, b, h) do { _Pragma("unroll") for (int m = 0; m < 4; ++m) _Pragma("unroll") for (int k = 0; k < 2; ++k) dst[m][k] = *(const PG8_LAS bf16x8*)(lds + PG8_SA(b, h) + aoff + m * 2048 + k * 1024); } while (0)
#define PG8_LDB(dst, b, h) do { _Pragma("unroll") for (int n = 0; n < 2; ++n) _Pragma("unroll") for (int k = 0; k < 2; ++k) dst[n][k] = *(const PG8_LAS bf16x8*)(lds + PG8_SB(b, h) + boff + n * 2048 + k * 1024); } while (0)
#define PG8_MMA(ai, bj, At, Bt) do { __builtin_amdgcn_s_setprio(1); _Pragma("unroll") for (int m = 0; m < 4; ++m) _Pragma("unroll") for (int n = 0; n < 2; ++n) _Pragma("unroll") for (int k = 0; k < 2; ++k) \
        acc[ai][bj][m][n] = __builtin_amdgcn_mfma_f32_16x16x32_bf16(Bt[n][k], At[m][k], acc[ai][bj][m][n], 0, 0, 0); __builtin_amdgcn_s_setprio(0); } while (0)
#define PG8_WAIT_V(n) asm volatile("s_waitcnt vmcnt(" #n ")" ::: "memory")
#define PG8_WAIT_L(n) asm volatile("s_waitcnt lgkmcnt(" #n ")" ::: "memory")
#define PG8_BAR __builtin_amdgcn_s_barrier()
#define PG8_SCHED __builtin_amdgcn_sched_barrier(0)
    Unit cur, nxt; int ui = 0;
    if (!S.next(0, cur)) return;
    f32x4 acc[2][2][4][2];
#pragma unroll
    for (int a = 0; a < 2; ++a)
#pragma unroll
        for (int b = 0; b < 2; ++b)
#pragma unroll
            for (int m = 0; m < 4; ++m)
#pragma unroll
                for (int n = 0; n < 2; ++n) acc[a][b][m][n] = (f32x4){0.f, 0.f, 0.f, 0.f};
    bf16x8 At[4][2], B0[2][2], B1[2][2];
    const PG8_GAS char* cA = (const PG8_GAS char*)g.A + (size_t)cur.pm * tstep; const PG8_GAS char* cB = (const PG8_GAS char*)g.Bt + (size_t)cur.pn * tstep;
    S.a_ready(cur);
    if constexpr (SP2) {
        PG8_STAGE(PG8_SB(0, 0), cB, voffB); PG8_STAGE(PG8_SB(0, 1), cB + hstep, voffB); PG8_STAGE(PG8_SA(0, 0), cA, voffA); PG8_STAGE(PG8_SA(0, 1), cA + hstep, voffA);
        if (wr == 1) PG8_BAR;
        PG8_WAIT_V(2); PG8_BAR;
        PG8_STAGE(PG8_SB(1, 0), cB + kstep, voffB); PG8_STAGE(PG8_SA(1, 0), cA + kstep, voffA); PG8_STAGE(PG8_SB(1, 1), cB + hstep + kstep, voffB);
        PG8_WAIT_V(6); PG8_BAR;
    } else {
        PG8_STAGE(PG8_SB(0, 0), cB, voffB); PG8_STAGE(PG8_SA(0, 0), cA, voffA); PG8_STAGE(PG8_SB(0, 1), cB + hstep, voffB); PG8_STAGE(PG8_SA(0, 1), cA + hstep, voffA);
        if (wr == 1) PG8_BAR;
        PG8_WAIT_V(4); PG8_BAR;
        PG8_STAGE(PG8_SB(1, 0), cB + kstep, voffB); PG8_STAGE(PG8_SA(1, 0), cA + kstep, voffA); PG8_STAGE(PG8_SB(1, 1), cB + hstep + kstep, voffB);
        PG8_WAIT_V(6); PG8_BAR;
    }
    for (;;) {
        const bool has_next = S.next(ui + 1, nxt);
        const PG8_GAS char* nA = has_next ? (const PG8_GAS char*)g.A + (size_t)nxt.pm * tstep : cA; const PG8_GAS char* nB = has_next ? (const PG8_GAS char*)g.Bt + (size_t)nxt.pn * tstep : cB;
        for (int t = 0; t < nt; t += 2) {
            const bool last = (t == nt - 2);
            const PG8_GAS char* a1 = cA + (size_t)(t + 1) * kstep;
            const PG8_GAS char* a2 = last ? nA : cA + (size_t)(t + 2) * kstep; const PG8_GAS char* b2 = last ? nB : cB + (size_t)(t + 2) * kstep;
            const PG8_GAS char* a3 = a2 + kstep; const PG8_GAS char* b3 = b2 + kstep;
            if (last && has_next) S.a_ready(nxt);
            if constexpr (SP2) {
            PG8_LDB(B0, 0, 0); PG8_LDB(B1, 0, 1); PG8_SCHED; PG8_LDA(At, 0, 0); PG8_STAGE(PG8_SA(1, 1), a1 + hstep, voffA);
            PG8_WAIT_V(8); PG8_WAIT_L(0); PG8_BAR; PG8_MMA(0, 0, At, B0); PG8_MMA(0, 1, At, B1); PG8_BAR; PG8_SCHED;
            PG8_LDA(At, 0, 1); PG8_STAGE(PG8_SB(0, 0), b2, voffB); PG8_STAGE(PG8_SB(0, 1), b2 + hstep, voffB); PG8_STAGE(PG8_SA(0, 0), a2, voffA);
            PG8_WAIT_V(8); PG8_WAIT_L(0); PG8_BAR; PG8_MMA(1, 0, At, B0); PG8_MMA(1, 1, At, B1); PG8_BAR; PG8_SCHED;
            PG8_LDB(B0, 1, 0); PG8_LDB(B1, 1, 1); PG8_SCHED; PG8_LDA(At, 1, 0); PG8_STAGE(PG8_SA(0, 1), a2 + hstep, voffA);
            PG8_WAIT_V(8); PG8_WAIT_L(0); PG8_BAR; PG8_MMA(0, 0, At, B0); PG8_MMA(0, 1, At, B1); PG8_BAR; PG8_SCHED;
            PG8_LDA(At, 1, 1); PG8_STAGE(PG8_SB(1, 0), b3, voffB); PG8_STAGE(PG8_SB(1, 1), b3 + hstep, voffB); PG8_STAGE(PG8_SA(1, 0), a3, voffA);
            PG8_WAIT_V(8); PG8_WAIT_L(0); PG8_BAR; PG8_MMA(1, 0, At, B0); PG8_MMA(1, 1, At, B1); PG8_BAR; PG8_SCHED;
            } else {
            PG8_LDB(B0, 0, 0); PG8_SCHED; PG8_LDA(At, 0, 0); PG8_STAGE(PG8_SA(1, 1), a1 + hstep, voffA);
            PG8_WAIT_L(8); PG8_BAR; PG8_WAIT_L(0); PG8_MMA(0, 0, At, B0); PG8_BAR; PG8_SCHED;
            PG8_LDB(B1, 0, 1); PG8_STAGE(PG8_SB(0, 0), b2, voffB);
            PG8_BAR; PG8_WAIT_L(0); PG8_MMA(0, 1, At, B1); PG8_BAR;
            PG8_LDA(At, 0, 1); PG8_STAGE(PG8_SA(0, 0), a2, voffA);
            PG8_BAR; PG8_WAIT_L(0); PG8_MMA(1, 0, At, B0); PG8_BAR; PG8_SCHED;
            PG8_STAGE(PG8_SB(0, 1), b2 + hstep, voffB);
            PG8_WAIT_V(6); PG8_BAR; PG8_MMA(1, 1, At, B1); PG8_BAR;
            PG8_LDB(B0, 1, 0); PG8_SCHED; PG8_LDA(At, 1, 0); PG8_STAGE(PG8_SA(0, 1), a2 + hstep, voffA);
            PG8_WAIT_L(8); PG8_BAR; PG8_WAIT_L(0); PG8_MMA(0, 0, At, B0); PG8_BAR; PG8_SCHED;
            PG8_LDB(B1, 1, 1); PG8_STAGE(PG8_SB(1, 0), b3, voffB);
            PG8_BAR; PG8_WAIT_L(0); PG8_MMA(0, 1, At, B1); PG8_BAR;
            PG8_LDA(At, 1, 1); PG8_STAGE(PG8_SA(1, 0), a3, voffA);
            PG8_BAR; PG8_WAIT_L(0); PG8_MMA(1, 0, At, B0); PG8_BAR; PG8_SCHED;
            PG8_STAGE(PG8_SB(1, 1), b3 + hstep, voffB);
            PG8_WAIT_V(6); PG8_BAR; PG8_MMA(1, 1, At, B1); PG8_BAR;
            }
        }
        if constexpr (ALIGN_EPI) { if (wr == 0) PG8_BAR; }
        E(acc, cur, wr, wc, fr, fq); S.done(cur);
        if (!has_next) break;
#pragma unroll
        for (int a = 0; a < 2; ++a)
#pragma unroll
            for (int b = 0; b < 2; ++b)
#pragma unroll
                for (int m = 0; m < 4; ++m)
#pragma unroll
                    for (int n = 0; n < 2; ++n) acc[a][b][m][n] = (f32x4){0.f, 0.f, 0.f, 0.f};
        cur = nxt; cA = nA; cB = nB; ++ui;
        if constexpr (ALIGN_EPI) { if (wr == 1) PG8_BAR; }
    }
    PG8_WAIT_V(0);
    if constexpr (!ALIGN_EPI) { if (wr == 0) PG8_BAR; }
    PG8_BAR;
#undef PG8_SA
#undef PG8_SB
#undef PG8_STAGE
#undef PG8_LDA
#undef PG8_LDB
#undef PG8_MMA
#undef PG8_WAIT_V
#undef PG8_WAIT_L
#undef PG8_BAR
#undef PG8_SCHED
}

__host__ __device__ __forceinline__ int perm32(int rho) { const int n = rho >> 4, i = rho & 15; return 8 * (i >> 2) + 4 * n + (i & 3); }
struct SUnit { int pm, pn, s; };
struct Stream {
    const PG8_GAS unsigned char* base; size_t A[5], Bt[5]; int nN[5], K[5], first[6], dep[5], need[5], pub[5];
    unsigned* cnt; int nM, G, c, need1_hi;
    __device__ __forceinline__ const PG8_GAS bf16_t* a_of(int s) const { return (const PG8_GAS bf16_t*)(base + (s == 0 ? A[0] : s == 1 ? A[1] : s == 2 ? A[2] : s == 3 ? A[3] : A[4])); }
    __device__ __forceinline__ const PG8_GAS bf16_t* b_of(int s) const { return (const PG8_GAS bf16_t*)(base + (s == 0 ? Bt[0] : s == 1 ? Bt[1] : s == 2 ? Bt[2] : s == 3 ? Bt[3] : Bt[4])); }
    __device__ __forceinline__ int k_of(int s) const { return s == 0 ? K[0] : s == 1 ? K[1] : s == 2 ? K[2] : s == 3 ? K[3] : K[4]; }
    __device__ __forceinline__ int nn_of(int s) const { return s == 0 ? nN[0] : s == 1 ? nN[1] : s == 2 ? nN[2] : s == 3 ? nN[3] : nN[4]; }
    __device__ __forceinline__ int dep_of(int s) const { return s == 0 ? dep[0] : s == 1 ? dep[1] : s == 2 ? dep[2] : s == 3 ? dep[3] : dep[4]; }
    __device__ __forceinline__ int need_of(int s) const { return s == 0 ? need[0] : s == 1 ? need[1] : s == 2 ? need[2] : s == 3 ? need[3] : need[4]; }
    __device__ __forceinline__ int need_for(const SUnit& u) const { return (u.s == 1 && u.pm >= 64) ? need1_hi : need_of(u.s); }
    __device__ __forceinline__ int pub_of(int s) const { return s == 0 ? pub[0] : s == 1 ? pub[1] : s == 2 ? pub[2] : s == 3 ? pub[3] : pub[4]; }
    __device__ __forceinline__ bool next(int i, SUnit& u) const {
        if (G == 256 && nM == 68) {
            if (i >= 12) return false;
            const unsigned e = STREAM_SCHED[(c >> 3) * 12 + i];
            if (e == 0xffffu) return false;
            const int s = (int)(e >> 8), j = (int)(e & 255u), x = c & 7, S = nn_of(s) >> 1;
            if (j < S) { const int g = x * S + j; u.pm = 64 + (g & 3); u.pn = g >> 2; }
            else if (s != 2) { const int jj = j - S; u.pm = 8 * x + (jj >> 2); u.pn = jj & 3; }
            else { const int jj = j - S;
                if (jj < 44) { u.pm = 8 * x + (jj & 1); u.pn = jj >> 1; } else { const int j2 = jj - 44; u.pm = 8 * x + 2 + j2 % 6; u.pn = j2 / 6; } }
            u.s = s; return true;
        }
        const int L = i * G + c; if (L >= first[5]) return false;
        const int s = (L >= first[1]) + (L >= first[2]) + (L >= first[3]) + (L >= first[4]);
        const int f = s == 0 ? first[0] : s == 1 ? first[1] : s == 2 ? first[2] : s == 3 ? first[3] : first[4];
        const int nn = nn_of(s), nwg = nM * nn; int wgid = L - f;
        { const int q = nwg / NXCD, r = nwg % NXCD, xcd = wgid % NXCD, off = wgid / NXCD; wgid = (xcd < r ? xcd * (q + 1) : r * (q + 1) + (xcd - r) * q) + off; }
        const int nig = WGM * nn, gid = wgid / nig, fm = gid * WGM, gsz = (nM - fm) < WGM ? (nM - fm) : WGM;
        u.pm = fm + ((wgid % nig) % gsz); u.pn = (wgid % nig) / gsz; u.s = s; return true;
    }
    __device__ __forceinline__ void wait_ready(const SUnit& u, int tid) const {
        const int d = dep_of(u.s);
        if (d < 0) return;
        if (tid < 64) {
            unsigned* w = cnt + (size_t)(d * 128 + u.pm) * 64; const unsigned need_ = (unsigned)need_for(u); unsigned polls = 0;
            while ((unsigned)__builtin_amdgcn_readfirstlane(__hip_atomic_load(w, __ATOMIC_RELAXED, __HIP_MEMORY_SCOPE_AGENT)) < need_) {
                if (++polls > (1u << 18)) break;
                __builtin_amdgcn_s_sleep(2); }
            __builtin_amdgcn_fence(__ATOMIC_ACQUIRE, "agent");
            asm volatile("s_waitcnt vmcnt(0)" ::: "memory");
        }
        asm volatile("" ::: "memory"); __builtin_amdgcn_s_barrier(); asm volatile("" ::: "memory");
    }
    __device__ __forceinline__ bool try_ready(const SUnit& u, int tid, volatile PG8_LAS unsigned* flag) const {
        const int d = dep_of(u.s);
        if (d < 0) return true;
        if (tid < 64) {
            unsigned* w = cnt + (size_t)(d * 128 + u.pm) * 64;
            const bool ok = (unsigned)__builtin_amdgcn_readfirstlane(__hip_atomic_load(w, __ATOMIC_RELAXED, __HIP_MEMORY_SCOPE_AGENT)) >= (unsigned)need_for(u);
            if (ok) { __builtin_amdgcn_fence(__ATOMIC_ACQUIRE, "agent"); asm volatile("s_waitcnt vmcnt(0)" ::: "memory"); }
            if (tid == 0) *flag = ok ? 1u : 0u;
            asm volatile("s_waitcnt lgkmcnt(0)" ::: "memory");
        }
        asm volatile("" ::: "memory"); __builtin_amdgcn_s_barrier(); asm volatile("" ::: "memory");
        return *flag != 0u;
    }
    __device__ __forceinline__ void done(const SUnit& u, int lane) const {
        const int p = pub_of(u.s);
        if (p < 0) return;
        asm volatile("s_waitcnt vmcnt(0)" ::: "memory");
        if (lane == 0) __hip_atomic_fetch_add(cnt + (size_t)(p * 128 + u.pm) * 64, 1u, __ATOMIC_RELAXED, __HIP_MEMORY_SCOPE_AGENT);
    }
};

template <class EpiSet>
__device__ __forceinline__ void gemm_stream(PG8_LAS unsigned char* lds, const Stream& S, const EpiSet& E, const int tid, volatile PG8_LAS unsigned* flag) {
    const int wid = __builtin_amdgcn_readfirstlane(tid >> 6), lane = tid & 63, wr = wid >> 2, wc = wid & 3, fr = lane & 15, fq = lane >> 4;
    int SR[2], SC[2];
#pragma unroll
    for (int i = 0; i < 2; ++i) stage_rc(tid * 16 + i * 8192, SR[i], SC[i]);
    const int SRb[2] = {(SR[0] & ~31) + perm32(SR[0] & 31), (SR[1] & ~31) + perm32(SR[1] & 31)};
    const size_t kstep = (size_t)(BK * 2);
    const unsigned ldsw = (unsigned)wid * 1024u;
    const int aoff = lds_byte(wr * 64 + fr, fq * 8), boff = lds_byte(wc * 32 + fr, fq * 8);
#define PG8_SA(b, h) (((b) * 2 + (h)) * HTB)
#define PG8_SB(b, h) ((4 + (b) * 2 + (h)) * HTB)
#define PG8_STAGE(bufoff, gbase, voff) do { _Pragma("unroll") for (int _i = 0; _i < 2; ++_i) \
        __builtin_amdgcn_global_load_lds((const PG8_GAS unsigned*)((gbase) + (voff)[_i]), (PG8_LAS unsigned*)(lds + (bufoff) + ldsw + _i * 8192), 16, 0, 0); } while (0)
#define PG8_LDA(dst, b, h) do { _Pragma("unroll") for (int m = 0; m < 4; ++m) _Pragma("unroll") for (int k = 0; k < 2; ++k) dst[m][k] = *(const PG8_LAS bf16x8*)(lds + PG8_SA(b, h) + aoff + m * 2048 + k * 1024); } while (0)
#define PG8_LDB(dst, b, h) do { _Pragma("unroll") for (int n = 0; n < 2; ++n) _Pragma("unroll") for (int k = 0; k < 2; ++k) dst[n][k] = *(const PG8_LAS bf16x8*)(lds + PG8_SB(b, h) + boff + n * 2048 + k * 1024); } while (0)
#define PG8_MMA(ai, bj, At, Bt) do { __builtin_amdgcn_s_setprio(1); _Pragma("unroll") for (int m = 0; m < 4; ++m) _Pragma("unroll") for (int n = 0; n < 2; ++n) _Pragma("unroll") for (int k = 0; k < 2; ++k) \
        acc[ai][bj][m][n] = __builtin_amdgcn_mfma_f32_16x16x32_bf16(Bt[n][k], At[m][k], acc[ai][bj][m][n], 0, 0, 0); __builtin_amdgcn_s_setprio(0); } while (0)
#define PG8_WAIT_V(n) asm volatile("s_waitcnt vmcnt(" #n ")" ::: "memory")
#define PG8_WAIT_L(n) asm volatile("s_waitcnt lgkmcnt(" #n ")" ::: "memory")
#define PG8_BAR __builtin_amdgcn_s_barrier()
#define PG8_SCHED __builtin_amdgcn_sched_barrier(0)
    SUnit cur, nxt; int ui = 0;
    if (!S.next(0, cur)) return;
    f32x4 acc[2][2][4][2];
#pragma unroll
    for (int a = 0; a < 2; ++a)
#pragma unroll
        for (int b = 0; b < 2; ++b)
#pragma unroll
            for (int m = 0; m < 4; ++m)
#pragma unroll
                for (int n = 0; n < 2; ++n) acc[a][b][m][n] = (f32x4){0.f, 0.f, 0.f, 0.f};
    bf16x8 At[4][2], B0[2][2], B1[2][2];
    for (;;) {
        int K = S.k_of(cur.s);
        size_t hstep = (size_t)HALF * K * 2;
        unsigned voff[2] = {(unsigned)(SR[0] * K + SC[0]) * 2u, (unsigned)(SR[1] * K + SC[1]) * 2u};
        unsigned voffB[2] = {(unsigned)(SRb[0] * K + SC[0]) * 2u, (unsigned)(SRb[1] * K + SC[1]) * 2u};
        const PG8_GAS char* cA = (const PG8_GAS char*)S.a_of(cur.s) + (size_t)cur.pm * 2 * hstep; const PG8_GAS char* cB = (const PG8_GAS char*)S.b_of(cur.s) + (size_t)cur.pn * 2 * hstep;
        S.wait_ready(cur, tid);
        PG8_STAGE(PG8_SB(0, 0), cB, voffB); PG8_STAGE(PG8_SB(0, 1), cB + hstep, voffB); PG8_STAGE(PG8_SA(0, 0), cA, voff); PG8_STAGE(PG8_SA(0, 1), cA + hstep, voff);
        if (wr == 1) PG8_BAR;
        PG8_WAIT_V(2); PG8_BAR;
        PG8_STAGE(PG8_SB(1, 0), cB + kstep, voffB); PG8_STAGE(PG8_SA(1, 0), cA + kstep, voff); PG8_STAGE(PG8_SB(1, 1), cB + hstep + kstep, voffB);
        PG8_WAIT_V(6); PG8_BAR;
        bool finished = false;
        for (;;) {
            const bool has_next = S.next(ui + 1, nxt);
            bool chain = has_next;
            const int Kn = has_next ? S.k_of(nxt.s) : K;
            const size_t hstep_n = (size_t)HALF * Kn * 2;
            const unsigned voffn[2] = {(unsigned)(SR[0] * Kn + SC[0]) * 2u, (unsigned)(SR[1] * Kn + SC[1]) * 2u};
            const unsigned voffBn[2] = {(unsigned)(SRb[0] * Kn + SC[0]) * 2u, (unsigned)(SRb[1] * Kn + SC[1]) * 2u};
            const PG8_GAS char* nA = has_next ? (const PG8_GAS char*)S.a_of(nxt.s) + (size_t)nxt.pm * 2 * hstep_n : cA;
            const PG8_GAS char* nB = has_next ? (const PG8_GAS char*)S.b_of(nxt.s) + (size_t)nxt.pn * 2 * hstep_n : cB;
            const int nt = K / BK;
            for (int t = 0; t < nt; t += 2) {
                const bool last = (t == nt - 2);
                if (last && has_next) chain = S.try_ready(nxt, tid, flag);
                const bool usen = last && chain;
                const PG8_GAS char* a1 = cA + (size_t)(t + 1) * kstep;
                const PG8_GAS char* a2 = last ? (chain ? nA : cA) : cA + (size_t)(t + 2) * kstep; const PG8_GAS char* b2 = last ? (chain ? nB : cB) : cB + (size_t)(t + 2) * kstep;
                const PG8_GAS char* a3 = a2 + kstep; const PG8_GAS char* b3 = b2 + kstep;
                const size_t h2 = usen ? hstep_n : hstep;
                const unsigned v2[2] = {usen ? voffn[0] : voff[0], usen ? voffn[1] : voff[1]};
                const unsigned v2B[2] = {usen ? voffBn[0] : voffB[0], usen ? voffBn[1] : voffB[1]};
                PG8_LDB(B0, 0, 0); PG8_LDB(B1, 0, 1); PG8_SCHED; PG8_LDA(At, 0, 0); PG8_STAGE(PG8_SA(1, 1), a1 + hstep, voff);
                PG8_WAIT_V(8); PG8_WAIT_L(0); PG8_BAR; PG8_MMA(0, 0, At, B0); PG8_MMA(0, 1, At, B1); PG8_BAR; PG8_SCHED;
                PG8_LDA(At, 0, 1); PG8_STAGE(PG8_SB(0, 0), b2, v2B); PG8_STAGE(PG8_SB(0, 1), b2 + h2, v2B); PG8_STAGE(PG8_SA(0, 0), a2, v2);
                PG8_WAIT_V(8); PG8_WAIT_L(0); PG8_BAR; PG8_MMA(1, 0, At, B0); PG8_MMA(1, 1, At, B1); PG8_BAR; PG8_SCHED;
                PG8_LDB(B0, 1, 0); PG8_LDB(B1, 1, 1); PG8_SCHED; PG8_LDA(At, 1, 0); PG8_STAGE(PG8_SA(0, 1), a2 + h2, v2);
                PG8_WAIT_V(8); PG8_WAIT_L(0); PG8_BAR; PG8_MMA(0, 0, At, B0); PG8_MMA(0, 1, At, B1); PG8_BAR; PG8_SCHED;
                PG8_LDA(At, 1, 1); PG8_STAGE(PG8_SB(1, 0), b3, v2B); PG8_STAGE(PG8_SB(1, 1), b3 + h2, v2B); PG8_STAGE(PG8_SA(1, 0), a3, v2);
                PG8_WAIT_V(8); PG8_WAIT_L(0); PG8_BAR; PG8_MMA(1, 0, At, B0); PG8_MMA(1, 1, At, B1); PG8_BAR; PG8_SCHED;
            }
            if (wr == 0) PG8_BAR;
            E(acc, cur, wr, wc, fr, fq); S.done(cur, lane);
            if (!has_next) { finished = true; break; }
#pragma unroll
            for (int a = 0; a < 2; ++a)
#pragma unroll
                for (int b = 0; b < 2; ++b)
#pragma unroll
                    for (int m = 0; m < 4; ++m)
#pragma unroll
                        for (int n = 0; n < 2; ++n) acc[a][b][m][n] = (f32x4){0.f, 0.f, 0.f, 0.f};
            cur = nxt; ++ui;
            if (!chain) break;
            cA = nA; cB = nB; K = Kn; hstep = hstep_n; voff[0] = voffn[0]; voff[1] = voffn[1]; voffB[0] = voffBn[0]; voffB[1] = voffBn[1];
            if (wr == 1) PG8_BAR;
        }
        PG8_WAIT_V(0);
        PG8_BAR;
        if (finished) break;
    }
#undef PG8_SA
#undef PG8_SB
#undef PG8_STAGE
#undef PG8_LDA
#undef PG8_LDB
#undef PG8_MMA
#undef PG8_WAIT_V
#undef PG8_WAIT_L
#undef PG8_BAR
#undef PG8_SCHED
}
}

constexpr int D = 1024, BP = 4, TP = 4096, MP = BP * TP, BS = 128, TS = 8, MS = BS * TS, M = MP + MS;
constexpr int PAST = 2048, PAGE = 128, NPG = PAST / PAGE;
constexpr int NH = 8, NKV = 2, HD = 128, NIH = 8, DI = 64, DFF = 2816, DPLE = 256;
constexpr int NIN = 29 * 256;
constexpr int NGU = 2 * DFF;
constexpr float EPS = 1e-6f;
constexpr float IDX_SCALE = 0.044194173824159216f;
constexpr int LMAX = 4096;
constexpr int OQ = 0, OK_ = 1024, OV = 1280, OQI = 1536, OKI = 2048, OWI = 2112, OBG = 2120, OCG = 3144, OXC = 4168, OGA = 5192, OGB = 6216, DIN = 7240;
constexpr size_t O_Y = 0, O_KP = 17825792, O_VP = 22020096, O_KIP = 26214400, O_CP = 27262976, O_KS = 27271168, O_VS = 27533312, O_KIS = 27795456, O_CS = 27860992, O_END = 28123136;

constexpr size_t MiB = 1u << 20;
constexpr size_t WS_CTL = 0, CTL_ZERO_BYTES = 1 * MiB;
constexpr size_t WS_WIN = 2 * MiB, WS_WOUT = 18 * MiB, WS_WGU = 20 * MiB, WS_WDN = 32 * MiB, WS_WPLE = 38 * MiB, WS_WPG = 39 * MiB;
constexpr size_t WS_CS128 = 41 * MiB, WS_CS64 = 43 * MiB;
constexpr size_t WS_X3B = 512 * MiB;
constexpr size_t WS_HB = 44 * MiB, WS_QB = 78 * MiB, WS_KB = 112 * MiB, WS_VB = 121 * MiB, WS_QIB = 130 * MiB, WS_KIB = 147 * MiB, WS_WI = 150 * MiB;
constexpr size_t WS_UB = 151 * MiB, WS_BG = 185 * MiB, WS_SGA = 219 * MiB, WS_MASK = 253 * MiB, WS_MERGED = 262 * MiB, WS_X1B = 296 * MiB;
constexpr size_t WS_PART1 = 330 * MiB, WS_PART2 = 332 * MiB, WS_PART3 = 334 * MiB, WS_ACT = 336 * MiB, WS_X2B = 430 * MiB, WS_PB = 464 * MiB, WS_PW = 473 * MiB;
constexpr size_t WS_SCORES = 512 * MiB, WS_END = 784 * MiB;
constexpr int CW_BAR = 4096;
constexpr int CW_Q = 16384;
constexpr int CW_DEP = 32768;
constexpr int NPHASE = 6;

#define GAS __attribute__((address_space(1)))
#define LAS __attribute__((address_space(3)))
typedef unsigned short bf16;
typedef unsigned v4u __attribute__((ext_vector_type(4)));
typedef unsigned v2u __attribute__((ext_vector_type(2)));
typedef float f32x4 __attribute__((ext_vector_type(4)));
typedef float f32x8 __attribute__((ext_vector_type(8)));
typedef float f32x16 __attribute__((ext_vector_type(16)));
typedef short bf16x8 __attribute__((ext_vector_type(8)));
typedef short s16x4 __attribute__((ext_vector_type(4)));
typedef GAS unsigned gu32;
#define RLX_AGENT __ATOMIC_RELAXED, __HIP_MEMORY_SCOPE_AGENT
#define LDS_WAIT() asm volatile("s_waitcnt lgkmcnt(0)" ::: "memory")
#define VM_WAIT() asm volatile("s_waitcnt vmcnt(0)" ::: "memory")
#define SBAR() __builtin_amdgcn_sched_barrier(0)
__device__ __forceinline__ unsigned cvtpk(float lo, float hi) { return pg8::cvt_pk_bf16(lo, hi); }
__device__ __forceinline__ float bf2f(unsigned short b) { return __uint_as_float(((unsigned)b) << 16); }
__device__ __forceinline__ float sigmoidf_fast(float x) { return __builtin_amdgcn_rcpf(1.0f + __builtin_amdgcn_exp2f(-1.4426950408889634f * x)); }
__device__ __forceinline__ float wave_sum(float v) {
#pragma unroll
    for (int o = 1; o < 64; o <<= 1) v += __shfl_xor(v, o);
    return v;
}
__device__ __forceinline__ int wave_sum_dpp(int v) {
    v += __builtin_amdgcn_update_dpp(0, v, 0x111, 0xf, 0xf, true);
    v += __builtin_amdgcn_update_dpp(0, v, 0x112, 0xf, 0xf, true);
    v += __builtin_amdgcn_update_dpp(0, v, 0x114, 0xf, 0xf, true);
    v += __builtin_amdgcn_update_dpp(0, v, 0x118, 0xf, 0xf, true);
    v += __builtin_amdgcn_update_dpp(0, v, 0x142, 0xa, 0xf, true);
    v += __builtin_amdgcn_update_dpp(0, v, 0x143, 0xc, 0xf, true);
    return __builtin_amdgcn_readlane(v, 63);
}
__device__ __forceinline__ unsigned wave_max_dpp(unsigned v) {
    unsigned t;
    t = (unsigned)__builtin_amdgcn_update_dpp(0, (int)v, 0x111, 0xf, 0xf, true); v = v > t ? v : t;
    t = (unsigned)__builtin_amdgcn_update_dpp(0, (int)v, 0x112, 0xf, 0xf, true); v = v > t ? v : t;
    t = (unsigned)__builtin_amdgcn_update_dpp(0, (int)v, 0x114, 0xf, 0xf, true); v = v > t ? v : t;
    t = (unsigned)__builtin_amdgcn_update_dpp(0, (int)v, 0x118, 0xf, 0xf, true); v = v > t ? v : t;
    t = (unsigned)__builtin_amdgcn_update_dpp(0, (int)v, 0x142, 0xa, 0xf, true); v = v > t ? v : t;
    t = (unsigned)__builtin_amdgcn_update_dpp(0, (int)v, 0x143, 0xc, 0xf, true); v = v > t ? v : t;
    return (unsigned)__builtin_amdgcn_readlane((int)v, 63);
}
__device__ __forceinline__ int wave_sum_i(int v) {
#pragma unroll
    for (int o = 1; o < 64; o <<= 1) v += __shfl_xor(v, o);
    return v;
}

#define XB_TMO      128
#define XB_XCNT(j)  (256  + 64 * (j))
#define XB_XSUB(j)  (1280 + 64 * (j))
#define XB_XGEN(j)  (2304 + 64 * (j))
#define XB_TOP      3328
#define XB_TOPGEN   3392
#define XCD_BAR_WORDS 3456
#define XB_SPIN_CAP (1u << 18)
__device__ __forceinline__ unsigned xb_ld(unsigned* p)              { return __hip_atomic_load(p, __ATOMIC_RELAXED, __HIP_MEMORY_SCOPE_AGENT); }
__device__ __forceinline__ unsigned xb_add(unsigned* p, unsigned v) { return __hip_atomic_fetch_add(p, v, __ATOMIC_RELAXED, __HIP_MEMORY_SCOPE_AGENT); }
__device__ __forceinline__ unsigned xb_xcc_id() { return (unsigned)__builtin_amdgcn_s_getreg((3 << 11) | 20) & 0xFu; }
#define XB_SPIN(cond, bar) do { unsigned _sp = 0; while (cond) { __builtin_amdgcn_s_sleep(1); \
    if ((++_sp & 255u) == 0u) { if (xb_ld(&(bar)[XB_TMO])) break; if (_sp > XB_SPIN_CAP) { atomicAdd(&(bar)[XB_TMO], 1u); break; } } } } while (0)
struct XcdBarrier { unsigned* bar; unsigned x; volatile LAS unsigned* st; };
__device__ __forceinline__ XcdBarrier xcd_barrier_post(unsigned* bar, volatile LAS unsigned* st, int tid) {
    XcdBarrier b; b.bar = bar; b.x = xb_xcc_id(); b.st = st;
    if (tid == 0) (void)xb_add(&bar[XB_XCNT(b.x)], 1u);
    return b;
}
__device__ __forceinline__ void xcd_barrier_complete(unsigned* bar, unsigned x, unsigned& nloc, unsigned& nx) {
    const unsigned G = gridDim.x * gridDim.y * gridDim.z;
    unsigned sum, cnt, mine, sp = 0u;
    for (;;) {
        sum = 0u; cnt = 0u; mine = 0u;
#pragma unroll
        for (unsigned j = 0; j < 16; ++j) { const unsigned c = xb_ld(&bar[XB_XCNT(j)]); sum += c; cnt += (c > 0u) ? 1u : 0u; mine = (j == x) ? c : mine; }
        if (sum == G) break;
        __builtin_amdgcn_s_sleep(1);
        if ((++sp & 255u) == 0u) { if (xb_ld(&bar[XB_TMO])) break; if (sp > XB_SPIN_CAP) { atomicAdd(&bar[XB_TMO], 1u); break; } }
    }
    nloc = mine > 0u ? mine : 1u; nx = cnt > 0u ? cnt : 1u;
}
__device__ __forceinline__ void xcd_barrier(const XcdBarrier& b, int tid) {
    asm volatile("s_waitcnt vmcnt(0)" ::: "memory");
    __syncthreads();
    if (tid == 0) {
        unsigned* bar = b.bar;
        __builtin_amdgcn_s_waitcnt(0);
        unsigned nloc = b.st[0], nx = b.st[1];
        if (nloc == 0u) { xcd_barrier_complete(bar, b.x, nloc, nx); b.st[0] = nloc; b.st[1] = nx; }
        const unsigned old = xb_add(&bar[XB_XSUB(b.x)], 1u);
        const unsigned gen = old / nloc;
        if (old + 1u == (gen + 1u) * nloc) {
            __builtin_amdgcn_fence(__ATOMIC_RELEASE, "agent");
            asm volatile("s_waitcnt vmcnt(0)" ::: "memory");
            const unsigned og = xb_add(&bar[XB_TOP], 1u);
            const unsigned tg = og / nx;
            if (og + 1u == (tg + 1u) * nx) xb_add(&bar[XB_TOPGEN], 1u);
            else XB_SPIN(xb_ld(&bar[XB_TOPGEN]) == tg, bar);
            __builtin_amdgcn_fence(__ATOMIC_ACQUIRE, "agent");
            xb_add(&bar[XB_XGEN(b.x)], 1u);
            asm volatile("s_waitcnt vmcnt(0)" ::: "memory");
        } else {
            XB_SPIN(xb_ld(&bar[XB_XGEN(b.x)]) == gen, bar);
            __builtin_amdgcn_fence(__ATOMIC_ACQUIRE, "agent");
            asm volatile("s_waitcnt vmcnt(0)" ::: "memory");
        }
    }
    __syncthreads();
}

constexpr int RING_OFF = 0, RING_BYTES = 131072;
constexpr int CW_MSK = 100000;
constexpr int LDSCTL_OFF = RING_BYTES, MISC_OFF = LDSCTL_OFF + 320;
constexpr int LDS_BYTES = 163840;
constexpr int NWAVES = 8;

struct Args { const void* in[20]; float* out; unsigned char* ws; int ph_lo, ph_hi, qoff, pad; };

struct Frame {
    LAS unsigned char* lds;
    volatile LAS unsigned* MISC;
    gu32* ctl;
    int tid, lane, wave, G, qoff;
    GAS unsigned char* ws; GAS float* out;
};
typedef __attribute__((address_space(4))) const unsigned long long karg_t;
__device__ __forceinline__ karg_t* kargs() { karg_t* p = (karg_t*)__builtin_amdgcn_kernarg_segment_ptr(); asm volatile("" : "+s"(p)); return p; }
#define INPTR(T, kp, i) ((const GAS T*)(kp)[i])
enum { I_XP = 0, I_XS, I_CK, I_CV, I_CKI, I_SC, I_PT, I_PP, I_PS, I_NMIX, I_WIN, I_CONVW, I_WOUT, I_NFFN, I_WGU, I_WDN, I_NPLE, I_WPLE, I_WPG, I_NFIN };
__device__ __forceinline__ int row_pos(int m) { return m < MP ? (m & (TP - 1)) : PAST + (m & (TS - 1)); }

__device__ __forceinline__ int lane_opaque() { int l = (int)__builtin_amdgcn_mbcnt_hi(~0u, __builtin_amdgcn_mbcnt_lo(~0u, 0u)); asm volatile("" : "+v"(l)); return l; }
__device__ __forceinline__ int wq_next(Frame& F, int q) {
    __syncthreads();
    if (F.tid == 0) F.MISC[16] = __hip_atomic_fetch_add((unsigned*)(F.ctl + CW_Q + 64 * (q + F.qoff)), 1u, RLX_AGENT);
    __syncthreads();
    return (int)F.MISC[16];
}

__device__ __forceinline__ int in_src_col(int p) {
    const int tile = p >> 8, q = p & 255, bj = q >> 7, w = q & 127;
    if (tile < 4) return OQ + (2 * tile + (w >> 6)) * 128 + 64 * bj + (w & 63);
    if (tile == 4) return OK_ + (w >> 6) * 128 + 64 * bj + (w & 63);
    if (tile == 5) return OV + q;
    if (tile < 8) return OQI + (4 * (tile - 6) + (w >> 5)) * 64 + 32 * bj + (w & 31);
    if (tile == 8) { if (w < 32) return OKI + 32 * bj + w; if (bj == 0 && w < 40) return OWI + (w - 32); return -1; }
    if (tile < 17) return (bj ? OXC : OCG) + 128 * (tile - 9) + w;
    if (tile < 25) return (bj ? OGB : OBG) + 128 * (tile - 17) + w;
    return OGA + 256 * (tile - 25) + q;
}
__device__ __forceinline__ int gu_src_col(int p) { const int tile = p >> 8, q = p & 255; return q < 128 ? 128 * tile + q : DFF + 128 * tile + (q - 128); }

template <int MAP>
__device__ __forceinline__ void p0_transpose_item(const GAS float* W, int Nsrc, int K, int Nphys, GAS bf16* WT, const GAS float* kscale, LAS float* scr, int item, int lane) {
    const int nblk = Nphys / 32, kb = item / nblk, nb = item % nblk, k0 = 64 * kb, n0 = 32 * nb;
    const int r8 = lane >> 3, c4 = (lane & 7) * 4, p = n0 + c4;
    const int sc = MAP == 0 ? p : (MAP == 1 ? in_src_col(p) : gu_src_col(p));
#pragma unroll
    for (int i = 0; i < 8; ++i) { const int kk = 8 * i + r8;
        f32x4 v = f32x4{0.f, 0.f, 0.f, 0.f}; if (sc >= 0) v = *(const GAS f32x4*)(W + (size_t)(k0 + kk) * Nsrc + sc);
        if (kscale) v = v * kscale[k0 + kk];
        LAS float* d = scr + kk * 33 + c4; d[0] = v.x; d[1] = v.y; d[2] = v.z; d[3] = v.w; }
    LDS_WAIT(); asm volatile("" ::: "memory");
    const int c = lane & 7;
#pragma unroll
    for (int j = 0; j < 4; ++j) { const int n = (lane >> 3) + 8 * j; const LAS float* s = scr + (8 * c) * 33 + n;
        v4u o; o.x = cvtpk(s[0 * 33], s[1 * 33]); o.y = cvtpk(s[2 * 33], s[3 * 33]); o.z = cvtpk(s[4 * 33], s[5 * 33]); o.w = cvtpk(s[6 * 33], s[7 * 33]);
        *(GAS v4u*)(WT + (size_t)(n0 + n) * K + k0 + 8 * c) = o; }
    LDS_WAIT(); asm volatile("" ::: "memory");
}
__device__ __forceinline__ void sincos_d(double x, double& s, double& c) {
    const double k = __builtin_rint(x * 0.63661977236758134308);
    double r = __builtin_fma(-k, 1.57079632679489655800e+00, x); r = __builtin_fma(-k, 6.12323399573676603587e-17, r);
    const double r2 = r * r;
    double sp = -7.6471637318198164759e-13; sp = sp * r2 + 1.6059043836821614599e-10; sp = sp * r2 - 2.5052108385441718775e-08; sp = sp * r2 + 2.7557319223985890653e-06;
    sp = sp * r2 - 1.9841269841269841270e-04; sp = sp * r2 + 8.3333333333333333333e-03; sp = sp * r2 - 1.6666666666666666667e-01; const double sr = r + r * r2 * sp;
    double cp = 4.7794773323873852974e-14; cp = cp * r2 - 1.1470745597729724714e-11; cp = cp * r2 + 2.0876756987868098979e-09; cp = cp * r2 - 2.7557319223985890653e-07;
    cp = cp * r2 + 2.4801587301587301587e-05; cp = cp * r2 - 1.3888888888888888889e-03; cp = cp * r2 + 4.1666666666666666667e-02; cp = cp * r2 - 0.5; const double cr = 1.0 + r2 * cp;
    const int q = ((int)k) & 3;
    s = (q == 0) ? sr : (q == 1) ? cr : (q == 2) ? -sr : -cr;
    c = (q == 0) ? cr : (q == 1) ? -sr : (q == 2) ? -cr : sr;
}
__device__ __forceinline__ void p0_prologue(Frame& F) {
    LAS float* scr = (LAS float*)(F.lds + RING_OFF + F.wave * 16384);
    const int gw = blockIdx.x * NWAVES + F.wave, NGW = F.G * NWAVES, lane = F.lane;
    GAS unsigned char* ws = F.ws; karg_t* kp = kargs();
    constexpr int I_IN = (D / 64) * (NIN / 32), I_OUT = (D / 64) * (D / 32), I_GU = (D / 64) * (NGU / 32), I_DN = (DFF / 64) * (D / 32), I_PLE = (DPLE / 64) * (D / 32), I_PG = I_OUT;
    constexpr int NITEMS = I_IN + I_OUT + I_GU + I_DN + I_PLE + I_PG;
    for (int it = gw; it < NITEMS; it += NGW) {
        int r = it;
        if (r < I_IN) { p0_transpose_item<1>(INPTR(float, kp, I_WIN), DIN, D, NIN, (GAS bf16*)(ws + WS_WIN), nullptr, scr, r, lane); continue; } r -= I_IN;
        if (r < I_OUT) { p0_transpose_item<0>(INPTR(float, kp, I_WOUT), D, D, D, (GAS bf16*)(ws + WS_WOUT), nullptr, scr, r, lane); continue; } r -= I_OUT;
        if (r < I_GU) { p0_transpose_item<2>(INPTR(float, kp, I_WGU), NGU, D, NGU, (GAS bf16*)(ws + WS_WGU), INPTR(float, kp, I_NFFN), scr, r, lane); continue; } r -= I_GU;
        if (r < I_DN) { p0_transpose_item<0>(INPTR(float, kp, I_WDN), D, DFF, D, (GAS bf16*)(ws + WS_WDN), nullptr, scr, r, lane); continue; } r -= I_DN;
        if (r < I_PLE) { p0_transpose_item<0>(INPTR(float, kp, I_WPLE), D, DPLE, D, (GAS bf16*)(ws + WS_WPLE), nullptr, scr, r, lane); continue; } r -= I_PLE;
        p0_transpose_item<0>(INPTR(float, kp, I_WPG), D, D, D, (GAS bf16*)(ws + WS_WPG), INPTR(float, kp, I_NPLE), scr, r, lane);
    }
    {
        const int gt = blockIdx.x * (NWAVES * 64) + F.tid, NT_ = F.G * NWAVES * 64;
        GAS float2* cs128 = (GAS float2*)(ws + WS_CS128); GAS float2* cs64 = (GAS float2*)(ws + WS_CS64);
        for (int i = gt; i < TP * 64 + TP * 32; i += NT_) {
            int pos, fi, half; GAS float2* dst;
            if (i < TP * 64) { pos = i >> 6; fi = i & 63; half = 64; dst = cs128 + i; } else { const int j = i - TP * 64; pos = j >> 5; fi = j & 31; half = 32; dst = cs64 + j; }
            const float freq = __builtin_powf(10000.0f, -(float)fi / (float)half);
            const float ang = (float)pos * freq;
            double s, c; sincos_d((double)ang, s, c);
            dst->x = (float)c; dst->y = (float)s;
        }
    }
    {
        const GAS f32x4* gr = (const GAS f32x4*)INPTR(float, kp, I_NMIX) + lane;
        f32x4 g4[4];
#pragma unroll
        for (int j = 0; j < 4; ++j) g4[j] = gr[64 * j];
        const GAS float* xp = INPTR(float, kp, I_XP); const GAS float* xs = INPTR(float, kp, I_XS);
        for (int m0 = gw; m0 < M; m0 += 4 * NGW) {
            f32x4 v[4][4];
#pragma unroll
            for (int u = 0; u < 4; ++u) { const int m = m0 + u * NGW; if (m < M) {
                const GAS f32x4* xr = (const GAS f32x4*)(m < MP ? xp + (size_t)m * D : xs + (size_t)(m - MP) * D) + lane;
#pragma unroll
                for (int j = 0; j < 4; ++j) v[u][j] = xr[64 * j]; } }
#pragma unroll
            for (int u = 0; u < 4; ++u) { const int m = m0 + u * NGW; if (m < M) {
                float s = 0.f;
#pragma unroll
                for (int j = 0; j < 4; ++j) s += (v[u][j].x * v[u][j].x + v[u][j].y * v[u][j].y) + (v[u][j].z * v[u][j].z + v[u][j].w * v[u][j].w);
                const float rs = 1.0f / sqrtf(wave_sum(s) * (1.f / D) + EPS);
                GAS v2u* o8 = (GAS v2u*)((GAS bf16*)(ws + WS_HB) + (size_t)m * D) + lane;
#pragma unroll
                for (int j = 0; j < 4; ++j) { const f32x4 g = g4[j]; v2u o; o.x = cvtpk(v[u][j].x * rs * g.x, v[u][j].y * rs * g.y); o.y = cvtpk(v[u][j].z * rs * g.z, v[u][j].w * rs * g.w); o8[64 * j] = o; } } }
        }
    }
    {
        const GAS float* pp = INPTR(float, kp, I_PP); const GAS float* ps = INPTR(float, kp, I_PS);
        for (int m0 = gw; m0 < M; m0 += 8 * NGW) {
            f32x4 v[8];
#pragma unroll
            for (int u = 0; u < 8; ++u) { const int m = m0 + u * NGW; if (m < M) v[u] = ((const GAS f32x4*)(m < MP ? pp + (size_t)m * DPLE : ps + (size_t)(m - MP) * DPLE))[lane]; }
#pragma unroll
            for (int u = 0; u < 8; ++u) { const int m = m0 + u * NGW; if (m < M) { v2u o; o.x = cvtpk(v[u].x, v[u].y); o.y = cvtpk(v[u].z, v[u].w);
                ((GAS v2u*)((GAS bf16*)(ws + WS_PB) + (size_t)m * DPLE))[lane] = o; } }
        }
    }
}

constexpr float QK_LOG2_SCALE = 0.088388347648318440f * 1.4426950408889634f;
struct EpiIn {
    GAS bf16 *qb, *kb, *vb, *qib, *kib, *ub, *bgb, *sgab; GAS float* wi; const GAS float2 *cs128, *cs64; GAS float* out;
    __device__ __forceinline__ void operator()(const pg8::f32x4 (&acc)[2][2][4][2], const pg8::Unit& u, int wr, int wc, int fr, int fq) const {
        const int pn = u.pn;
#pragma unroll
        for (int ai = 0; ai < 2; ++ai)
#pragma unroll
            for (int m = 0; m < 4; ++m) {
                int row = u.pm * 256 + ai * 128 + wr * 64 + m * 16 + fr; asm volatile("" : "+v"(row));
                const int pos = row_pos(row);
                if (pn < 5) {
                    v2u b1a[2], b2a[2];
#pragma unroll
                    for (int n = 0; n < 2; ++n) {
                        const int w = 32 * wc + 8 * fq + 4 * n, d = w & 63, hh = w >> 6;
                        const f32x4 c01 = *(const GAS f32x4*)(cs128 + pos * 64 + d), c23 = *(const GAS f32x4*)(cs128 + pos * 64 + d + 2);
                        const f32x4 x1 = acc[ai][0][m][n], x2 = acc[ai][1][m][n];
                        f32x4 o1, o2;
                        o1.x = x1.x * c01.x - x2.x * c01.y; o2.x = x2.x * c01.x + x1.x * c01.y;
                        o1.y = x1.y * c01.z - x2.y * c01.w; o2.y = x2.y * c01.z + x1.y * c01.w;
                        o1.z = x1.z * c23.x - x2.z * c23.y; o2.z = x2.z * c23.x + x1.z * c23.y;
                        o1.w = x1.w * c23.z - x2.w * c23.w; o2.w = x2.w * c23.z + x1.w * c23.w;
                        const float qs = pn < 4 ? QK_LOG2_SCALE : 1.f;
                        v2u b1, b2; b1.x = cvtpk(o1.x * qs, o1.y * qs); b1.y = cvtpk(o1.z * qs, o1.w * qs); b2.x = cvtpk(o2.x * qs, o2.y * qs); b2.y = cvtpk(o2.z * qs, o2.w * qs);
                        b1a[n] = b1; b2a[n] = b2;
                        if (pn == 4) { GAS float* ko = out + (row < MP ? O_KP + (size_t)row * 256 : O_KS + (size_t)(row - MP) * 256) + hh * 128 + d; *(GAS f32x4*)ko = o1; *(GAS f32x4*)(ko + 64) = o2; }
                    }
                    { const int w0 = 32 * wc + 8 * fq, d0 = w0 & 63, hh0 = w0 >> 6;
                      GAS bf16* qk = pn < 4 ? qb + (size_t)row * D + (2 * pn + hh0) * 128 + d0 : kb + (size_t)row * 256 + hh0 * 128 + d0;
                      *(GAS v4u*)qk = v4u{b1a[0].x, b1a[0].y, b1a[1].x, b1a[1].y}; *(GAS v4u*)(qk + 64) = v4u{b2a[0].x, b2a[0].y, b2a[1].x, b2a[1].y}; }
                } else if (pn == 5) {
#pragma unroll
                    for (int bj = 0; bj < 2; ++bj)
                        { const int c = 128 * bj + 32 * wc + 8 * fq; const f32x4 x0 = acc[ai][bj][m][0], x1 = acc[ai][bj][m][1];
                            *(GAS v4u*)(vb + (size_t)row * 256 + c) = v4u{cvtpk(x0.x, x0.y), cvtpk(x0.z, x0.w), cvtpk(x1.x, x1.y), cvtpk(x1.z, x1.w)};
                            GAS float* vo = out + (row < MP ? O_VP + (size_t)row * 256 : O_VS + (size_t)(row - MP) * 256) + c; *(GAS f32x4*)vo = x0; *(GAS f32x4*)(vo + 4) = x1; }
                } else if (pn < 8) {
                    v2u qb1, qb2;
#pragma unroll
                    for (int n = 0; n < 2; ++n) {
                        const int w = 32 * wc + 8 * fq + 4 * n, d = w & 31, ih = 4 * (pn - 6) + (w >> 5);
                        const f32x4 c01 = *(const GAS f32x4*)(cs64 + pos * 32 + d), c23 = *(const GAS f32x4*)(cs64 + pos * 32 + d + 2);
                        const f32x4 x1 = acc[ai][0][m][n], x2 = acc[ai][1][m][n];
                        f32x4 o1, o2;
                        o1.x = x1.x * c01.x - x2.x * c01.y; o2.x = x2.x * c01.x + x1.x * c01.y;
                        o1.y = x1.y * c01.z - x2.y * c01.w; o2.y = x2.y * c01.z + x1.y * c01.w;
                        o1.z = x1.z * c23.x - x2.z * c23.y; o2.z = x2.z * c23.x + x1.z * c23.y;
                        o1.w = x1.w * c23.z - x2.w * c23.w; o2.w = x2.w * c23.z + x1.w * c23.w;
                        v2u b1, b2; b1.x = cvtpk(o1.x, o1.y); b1.y = cvtpk(o1.z, o1.w); b2.x = cvtpk(o2.x, o2.y); b2.y = cvtpk(o2.z, o2.w);
                        if (n == 0) { qb1 = b1; qb2 = b2; }
                        else { const int d0 = d - 4, q8 = row & 7, rr = (ih & 3) + 8 * (ih >> 2) + 4 * (q8 & 1) + 16 * ((q8 >> 1) & 1);
                          GAS bf16* qf = qib + (size_t)(row >> 3) * 4096 + ((q8 >> 2) * 4 + (d0 >> 4)) * 512 + ((((d0 >> 3) & 1) * 32 + rr) * 8);
                          *(GAS v4u*)qf = v4u{qb1.x, qb1.y, b1.x, b1.y}; *(GAS v4u*)(qf + 1024) = v4u{qb2.x, qb2.y, b2.x, b2.y}; }
                    }
                } else if (pn == 8) {
                    if (wc == 0) {
                        v2u kb1, kb2;
#pragma unroll
                        for (int n = 0; n < 2; ++n) {
                            const int d = 8 * fq + 4 * n;
                            const f32x4 c01 = *(const GAS f32x4*)(cs64 + pos * 32 + d), c23 = *(const GAS f32x4*)(cs64 + pos * 32 + d + 2);
                            const f32x4 x1 = acc[ai][0][m][n], x2 = acc[ai][1][m][n];
                            f32x4 o1, o2;
                            o1.x = x1.x * c01.x - x2.x * c01.y; o2.x = x2.x * c01.x + x1.x * c01.y;
                            o1.y = x1.y * c01.z - x2.y * c01.w; o2.y = x2.y * c01.z + x1.y * c01.w;
                            o1.z = x1.z * c23.x - x2.z * c23.y; o2.z = x2.z * c23.x + x1.z * c23.y;
                            o1.w = x1.w * c23.z - x2.w * c23.w; o2.w = x2.w * c23.z + x1.w * c23.w;
                            v2u b1, b2; b1.x = cvtpk(o1.x, o1.y); b1.y = cvtpk(o1.z, o1.w); b2.x = cvtpk(o2.x, o2.y); b2.y = cvtpk(o2.z, o2.w);
                            if (n == 0) { kb1 = b1; kb2 = b2; }
                            else { const int d0 = d - 4; GAS bf16* kf = kib + (size_t)(row >> 5) * 2048 + (d0 >> 4) * 512 + ((((d0 >> 3) & 1) * 32 + (row & 31)) * 8);
                              *(GAS v4u*)kf = v4u{kb1.x, kb1.y, b1.x, b1.y}; *(GAS v4u*)(kf + 1024) = v4u{kb2.x, kb2.y, b2.x, b2.y}; }
                            GAS float* ko = out + (row < MP ? O_KIP + (size_t)row * 64 : O_KIS + (size_t)(row - MP) * 64) + d; *(GAS f32x4*)ko = o1; *(GAS f32x4*)(ko + 32) = o2;
                        }
                    } else if (wc == 1 && fq == 0) {
                        *(GAS f32x4*)(wi + (size_t)row * 8) = acc[ai][0][m][0] * IDX_SCALE; *(GAS f32x4*)(wi + (size_t)row * 8 + 4) = acc[ai][0][m][1] * IDX_SCALE;
                    }
                } else if (pn < 17) {
                    const int t = row < MP ? (row & (TP - 1)) : (row & (TS - 1)), tl = row < MP ? TP : TS;
                    { const int ch = 128 * (pn - 9) + 32 * wc + 8 * fq; const f32x4 x0 = acc[ai][0][m][0] * acc[ai][1][m][0], x1 = acc[ai][0][m][1] * acc[ai][1][m][1];
                        *(GAS v4u*)(ub + (size_t)row * D + ch) = v4u{cvtpk(x0.x, x0.y), cvtpk(x0.z, x0.w), cvtpk(x1.x, x1.y), cvtpk(x1.z, x1.w)};
                        if (t >= tl - 2) { const int bidx = row < MP ? (row >> 12) : ((row - MP) >> 3);
                            GAS float* co = out + (row < MP ? O_CP : O_CS) + ((size_t)bidx * 2 + (t - (tl - 2))) * D + ch; *(GAS f32x4*)co = x0; *(GAS f32x4*)(co + 4) = x1; } }
                } else if (pn < 25) {
                    { const int ch = 128 * (pn - 17) + 32 * wc + 8 * fq; const f32x4 a0 = acc[ai][0][m][0], g0 = acc[ai][1][m][0], a1 = acc[ai][0][m][1], g1 = acc[ai][1][m][1];
                        *(GAS v4u*)(bgb + (size_t)row * D + ch) = v4u{cvtpk(a0.x * sigmoidf_fast(g0.x), a0.y * sigmoidf_fast(g0.y)), cvtpk(a0.z * sigmoidf_fast(g0.z), a0.w * sigmoidf_fast(g0.w)),
                                                                        cvtpk(a1.x * sigmoidf_fast(g1.x), a1.y * sigmoidf_fast(g1.y)), cvtpk(a1.z * sigmoidf_fast(g1.z), a1.w * sigmoidf_fast(g1.w))}; }
                } else {
#pragma unroll
                    for (int bj = 0; bj < 2; ++bj)
                        { const int ch = 256 * (pn - 25) + 128 * bj + 32 * wc + 8 * fq; const f32x4 g0 = acc[ai][bj][m][0], g1 = acc[ai][bj][m][1];
                            *(GAS v4u*)(sgab + (size_t)row * D + ch) = v4u{cvtpk(sigmoidf_fast(g0.x), sigmoidf_fast(g0.y)), cvtpk(sigmoidf_fast(g0.z), sigmoidf_fast(g0.w)),
                                                                             cvtpk(sigmoidf_fast(g1.x), sigmoidf_fast(g1.y)), cvtpk(sigmoidf_fast(g1.z), sigmoidf_fast(g1.w))}; }
                }
                asm volatile("" ::: "memory");
            }
    }
};
template <bool WT> __device__ __forceinline__ void st16(GAS void* base, size_t byteoff, size_t nbytes, v4u v) {
    if (WT) __builtin_amdgcn_raw_buffer_store_b128(v, __builtin_amdgcn_make_buffer_rsrc((void*)base, 0, (int)nbytes, 0x00020000), (int)byteoff, 0, 16);
    else *(GAS v4u*)((GAS char*)base + byteoff) = v; }
template <bool WT> __device__ __forceinline__ void st4(GAS float* p, float v) {
    if (WT) __hip_atomic_store((GAS unsigned*)p, __float_as_uint(v), __ATOMIC_RELAXED, __HIP_MEMORY_SCOPE_AGENT); else *p = v; }
__device__ __forceinline__ v4u pack8(const f32x4& a, const f32x4& b) { v4u o; o.x = cvtpk(a.x, a.y); o.y = cvtpk(a.z, a.w); o.z = cvtpk(b.x, b.y); o.w = cvtpk(b.z, b.w); return o; }
__device__ __forceinline__ void unpack8(const v4u w, f32x4& a, f32x4& b) {
    a.x = __uint_as_float(w.x << 16); a.y = __uint_as_float(w.x & 0xffff0000u); a.z = __uint_as_float(w.y << 16); a.w = __uint_as_float(w.y & 0xffff0000u);
    b.x = __uint_as_float(w.z << 16); b.y = __uint_as_float(w.z & 0xffff0000u); b.z = __uint_as_float(w.w << 16); b.w = __uint_as_float(w.w & 0xffff0000u); }
template <bool WT = false> struct EpiBf {
    GAS bf16* O; int ldc;
    __device__ __forceinline__ void operator()(const pg8::f32x4 (&acc)[2][2][4][2], const pg8::Unit& u, int wr, int wc, int fr, int fq) const {
#pragma unroll
        for (int ai = 0; ai < 2; ++ai)
#pragma unroll
            for (int m = 0; m < 4; ++m) { const int row = u.pm * 256 + ai * 128 + wr * 64 + m * 16 + fr;
#pragma unroll
                for (int bj = 0; bj < 2; ++bj) { const int c = u.pn * 256 + 128 * bj + 32 * wc + 8 * fq;
                    st16<WT>(O, ((size_t)row * ldc + c) * 2, (size_t)M * ldc * 2, pack8(acc[ai][bj][m][0], acc[ai][bj][m][1])); } }
    }
};
template <int BASEMODE  , bool WT = false> struct EpiRes {
    const GAS float *xp, *xs; const GAS bf16* baseb; GAS bf16* xo; GAS float* part;
    __device__ __forceinline__ void operator()(const pg8::f32x4 (&acc)[2][2][4][2], const pg8::Unit& u, int wr, int wc, int fr, int fq) const {
#pragma unroll
        for (int ai = 0; ai < 2; ++ai) {
            f32x4 b0[4][2], b1[4][2];
#pragma unroll
            for (int m = 0; m < 4; ++m) { const int row = u.pm * 256 + ai * 128 + wr * 64 + m * 16 + fr;
#pragma unroll
                for (int bj = 0; bj < 2; ++bj) { const int c = u.pn * 256 + 128 * bj + 32 * wc + 8 * fq;
                    if (BASEMODE == 0) { const GAS float* xr = (row < MP ? xp + (size_t)row * D : xs + (size_t)(row - MP) * D) + c; b0[m][bj] = *(const GAS f32x4*)xr; b1[m][bj] = *(const GAS f32x4*)(xr + 4); }
                    else unpack8(*(const GAS v4u*)(baseb + (size_t)row * D + c), b0[m][bj], b1[m][bj]); } }
#pragma unroll
            for (int m = 0; m < 4; ++m) { const int row = u.pm * 256 + ai * 128 + wr * 64 + m * 16 + fr; float ss = 0.f;
#pragma unroll
                for (int bj = 0; bj < 2; ++bj) { const int c = u.pn * 256 + 128 * bj + 32 * wc + 8 * fq; const f32x4 x0 = acc[ai][bj][m][0] + b0[m][bj], x1 = acc[ai][bj][m][1] + b1[m][bj];
                    ss += ((x0.x * x0.x + x0.y * x0.y) + (x0.z * x0.z + x0.w * x0.w)) + ((x1.x * x1.x + x1.y * x1.y) + (x1.z * x1.z + x1.w * x1.w));
                    st16<WT>(xo, ((size_t)row * D + c) * 2, (size_t)M * D * 2, pack8(x0, x1)); }
                ss += __shfl_xor(ss, 16); ss += __shfl_xor(ss, 32);
                if (fq == 0) st4<WT>(part + (size_t)row * 16 + u.pn * 4 + wc, ss); }
        }
    }
};
__device__ __forceinline__ float row_rs(const GAS float* part, int row) {
    const f32x4 a = *(const GAS f32x4*)(part + (size_t)row * 16), b = *(const GAS f32x4*)(part + (size_t)row * 16 + 4), c = *(const GAS f32x4*)(part + (size_t)row * 16 + 8), d = *(const GAS f32x4*)(part + (size_t)row * 16 + 12);
    const float s = ((a.x + a.y) + (a.z + a.w)) + ((b.x + b.y) + (b.z + b.w)) + ((c.x + c.y) + (c.z + c.w)) + ((d.x + d.y) + (d.z + d.w));
    return 1.0f / sqrtf(s * (1.f / D) + EPS);
}
__device__ __forceinline__ f32x4 swiglu4(const f32x4& g, const f32x4& u) { f32x4 o; o.x = g.x * sigmoidf_fast(g.x) * u.x; o.y = g.y * sigmoidf_fast(g.y) * u.y; o.z = g.z * sigmoidf_fast(g.z) * u.z; o.w = g.w * sigmoidf_fast(g.w) * u.w; return o; }
__device__ __forceinline__ float row_rs_q(const GAS float* part, int row, int fq) {
    const f32x4 a = *(const GAS f32x4*)(part + (size_t)row * 16 + 4 * fq);
    float s = (a.x + a.y) + (a.z + a.w);
    s += __shfl_xor(s, 16); s += __shfl_xor(s, 32);
    return 1.0f / sqrtf(s * (1.f / D) + EPS);
}
template <bool WT = false> struct EpiSwiGLU {
    const GAS float* part; GAS bf16* act;
    __device__ __forceinline__ void operator()(const pg8::f32x4 (&acc)[2][2][4][2], const pg8::Unit& u, int wr, int wc, int fr, int fq) const {
        float rsv[2][4];
#pragma unroll
        for (int ai = 0; ai < 2; ++ai)
#pragma unroll
            for (int m = 0; m < 4; ++m) rsv[ai][m] = row_rs_q(part, u.pm * 256 + ai * 128 + wr * 64 + m * 16 + fr, fq);
#pragma unroll
        for (int ai = 0; ai < 2; ++ai)
#pragma unroll
            for (int m = 0; m < 4; ++m) { const int row = u.pm * 256 + ai * 128 + wr * 64 + m * 16 + fr; const float rs = rsv[ai][m];
                const int c = u.pn * 128 + 32 * wc + 8 * fq;
                st16<WT>(act, ((size_t)row * DFF + c) * 2, (size_t)M * DFF * 2, pack8(swiglu4(acc[ai][0][m][0] * rs, acc[ai][1][m][0] * rs), swiglu4(acc[ai][0][m][1] * rs, acc[ai][1][m][1] * rs))); }
    }
};
template <bool WT = false> struct EpiPle {
    const GAS float* part2; const GAS bf16 *x2b, *pw; GAS bf16* x3; GAS float* part3;
    __device__ __forceinline__ void operator()(const pg8::f32x4 (&acc)[2][2][4][2], const pg8::Unit& u, int wr, int wc, int fr, int fq) const {
#pragma unroll
        for (int ai = 0; ai < 2; ++ai) {
        float rsv[2][4];
#pragma unroll
        for (int m = 0; m < 4; ++m) rsv[ai][m] = row_rs_q(part2, u.pm * 256 + ai * 128 + wr * 64 + m * 16 + fr, fq);
#pragma unroll
        for (int mh = 0; mh < 2; ++mh) {
            v4u xv[2][2], pv[2][2];
#pragma unroll
            for (int m2 = 0; m2 < 2; ++m2) { const int row = u.pm * 256 + ai * 128 + wr * 64 + (2 * mh + m2) * 16 + fr;
#pragma unroll
                for (int bj = 0; bj < 2; ++bj) { const int c = u.pn * 256 + 128 * bj + 32 * wc + 8 * fq;
                    xv[m2][bj] = *(const GAS v4u*)(x2b + (size_t)row * D + c); pv[m2][bj] = *(const GAS v4u*)(pw + (size_t)row * D + c); } }
#pragma unroll
            for (int m2 = 0; m2 < 2; ++m2) { const int m = 2 * mh + m2; const int row = u.pm * 256 + ai * 128 + wr * 64 + m * 16 + fr; const float rs = rsv[ai][m]; float ss = 0.f;
#pragma unroll
                for (int bj = 0; bj < 2; ++bj) { const int c = u.pn * 256 + 128 * bj + 32 * wc + 8 * fq;
                    f32x4 xa, xb, pa, pb; unpack8(xv[m2][bj], xa, xb); unpack8(pv[m2][bj], pa, pb);
                    const f32x4 a0 = acc[ai][bj][m][0] * rs, a1 = acc[ai][bj][m][1] * rs;
                    f32x4 x0, x1;
                    x0.x = xa.x + pa.x * sigmoidf_fast(a0.x); x0.y = xa.y + pa.y * sigmoidf_fast(a0.y); x0.z = xa.z + pa.z * sigmoidf_fast(a0.z); x0.w = xa.w + pa.w * sigmoidf_fast(a0.w);
                    x1.x = xb.x + pb.x * sigmoidf_fast(a1.x); x1.y = xb.y + pb.y * sigmoidf_fast(a1.y); x1.z = xb.z + pb.z * sigmoidf_fast(a1.z); x1.w = xb.w + pb.w * sigmoidf_fast(a1.w);
                    ss += ((x0.x * x0.x + x0.y * x0.y) + (x0.z * x0.z + x0.w * x0.w)) + ((x1.x * x1.x + x1.y * x1.y) + (x1.z * x1.z + x1.w * x1.w));
                    st16<WT>(x3, ((size_t)row * D + c) * 2, (size_t)M * D * 2, pack8(x0, x1)); }
                ss += __shfl_xor(ss, 16); ss += __shfl_xor(ss, 32);
                if (fq == 0) st4<WT>(part3 + (size_t)row * 16 + u.pn * 4 + wc, ss); }
        }
        }
    }
};
struct EpiStream {
    GAS unsigned char* ws; GAS float* out; const GAS float *xp, *xs;
    __device__ __forceinline__ void operator()(const pg8::f32x4 (&acc)[2][2][4][2], const pg8::SUnit& su, int wr, int wc, int fr, int fq) const {
        const pg8::Unit u{su.pm, su.pn};
        if (su.s == 0) { const EpiBf<true> e{(GAS bf16*)(ws + WS_PW), D}; e(acc, u, wr, wc, fr, fq); }
        else if (su.s == 1) { const EpiRes<0, true> e{xp, xs, nullptr, (GAS bf16*)(ws + WS_X1B), (GAS float*)(ws + WS_PART1)}; e(acc, u, wr, wc, fr, fq); }
        else if (su.s == 2) { const EpiSwiGLU<true> e{(const GAS float*)(ws + WS_PART1), (GAS bf16*)(ws + WS_ACT)}; e(acc, u, wr, wc, fr, fq); }
        else if (su.s == 3) { const EpiRes<1, true> e{nullptr, nullptr, (const GAS bf16*)(ws + WS_X1B), (GAS bf16*)(ws + WS_X2B), (GAS float*)(ws + WS_PART2)}; e(acc, u, wr, wc, fr, fq); }
        else { const EpiPle<true> e{(const GAS float*)(ws + WS_PART2), (const GAS bf16*)(ws + WS_X2B), (const GAS bf16*)(ws + WS_PW), (GAS bf16*)(ws + WS_X3B), (GAS float*)(ws + WS_PART3)}; e(acc, u, wr, wc, fr, fq); }
    }
};

__device__ __forceinline__ float relu_i(float x) { const int i = __float_as_int(x); return __int_as_float(i > 0 ? i : 0); }
__device__ __forceinline__ void idx_scores(const bf16x8 (&Af)[2][4], const bf16x8 (&Bf)[4], const f32x4 (&wv)[2][4], float (&sc)[2][2]) {
#pragma unroll
    for (int R = 0; R < 2; ++R) {
        f32x16 d = {};
#pragma unroll
        for (int s = 0; s < 4; ++s) d = __builtin_amdgcn_mfma_f32_32x32x16_bf16(Af[R][s], Bf[s], d, 0, 0, 0);
        float s0 = 0.f, s1 = 0.f;
#pragma unroll
        for (int r = 0; r < 8; ++r) { s0 = fmaf(relu_i(d[r]), wv[R][r >> 2][r & 3], s0); asm volatile("" : "+v"(s0)); s1 = fmaf(relu_i(d[8 + r]), wv[R][2 + (r >> 2)][r & 3], s1); }
        sc[R][0] = s0; sc[R][1] = s1;
    }
}
__device__ __forceinline__ void idx_load_q(const GAS bf16* qib, const GAS float* wi, int mq0, int lane, bf16x8 (&Af)[2][4], f32x4 (&wv)[2][4]) {
    const int r = lane & 31, hh = lane >> 5;
#pragma unroll
    for (int R = 0; R < 2; ++R) {
        const GAS bf16* qp = qib + (size_t)(mq0 >> 3) * 4096 + R * 2048 + lane * 8;
#pragma unroll
        for (int s = 0; s < 4; ++s) Af[R][s] = *(const GAS bf16x8*)(qp + 512 * s);
        const GAS float* w0 = wi + (size_t)(mq0 + 4 * R + hh) * 8; const GAS float* w1 = wi + (size_t)(mq0 + 4 * R + 2 + hh) * 8;
        wv[R][0] = *(const GAS f32x4*)w0; wv[R][1] = *(const GAS f32x4*)(w0 + 4); wv[R][2] = *(const GAS f32x4*)w1; wv[R][3] = *(const GAS f32x4*)(w1 + 4);
    }
}
__device__ __forceinline__ unsigned sortable(float f) { const unsigned u = __float_as_uint(f); return (u & 0x80000000u) ? ~u : (u | 0x80000000u); }
__device__ __forceinline__ void st8wt(GAS void* base, size_t byteoff, size_t nbytes, unsigned long long v) {
    const v2u d = {(unsigned)v, (unsigned)(v >> 32)};
    __builtin_amdgcn_raw_buffer_store_b64(d, __builtin_amdgcn_make_buffer_rsrc((void*)base, 0, (int)nbytes, 0x00020000), (int)byteoff, 0, 16); }
__device__ __forceinline__ unsigned* mask_counter(gu32* ctl, int row) { return (unsigned*)(ctl + CW_MSK) + (size_t)(row < MP ? (row >> 6) : 256 + ((row - MP) >> 3)) * 64; }
__device__ __forceinline__ void p2_item(int p, bool& sample, int& b, int& t0, int& mq0) {
    sample = p < BS;
    if (sample) { b = p; t0 = PAST; mq0 = MP + b * TS; }
    else { const int tg = 2047 - (p - BS); t0 = (tg >> 2) * 8; b = tg & 3; mq0 = b * TP + t0; }
}
__device__ __forceinline__ void p2_index_select(Frame& F) {
    GAS unsigned char* ws = F.ws;
    const GAS bf16* qib = (const GAS bf16*)(ws + WS_QIB); const GAS bf16* kib = (const GAS bf16*)(ws + WS_KIB); const GAS float* wi = (const GAS float*)(ws + WS_WI);
    GAS unsigned long long* mask = (GAS unsigned long long*)(ws + WS_MASK);
    const int lane = F.lane, w = F.wave, c = lane & 31, hh = lane >> 5;
    karg_t* kp = kargs(); const GAS int* page_table = INPTR(int, kp, I_PT); const GAS float* cache_kidx = INPTR(float, kp, I_CKI);
    LAS float* sc = (LAS float*)(F.lds + RING_OFF);
    volatile LAS unsigned long long* wl = (volatile LAS unsigned long long*)(F.lds + LDSCTL_OFF + 2048 + w * 512);
    bf16x8 Af[2][4]; f32x4 wv[2][4];
    { bool s_; int b_, t_, m_; p2_item((int)blockIdx.x, s_, b_, t_, m_); idx_load_q(qib, wi, m_, lane, Af, wv); }
    unsigned* qctr = (unsigned*)(F.ctl + CW_Q);
    int pend_row = -1;
    for (int it = (int)blockIdx.x; it < 2048 + BS;) {
        unsigned claim = 0u;
        if (w == 0 && lane == 0) claim = (unsigned)F.G + __hip_atomic_fetch_add(qctr, 1u, __ATOMIC_RELAXED, __HIP_MEMORY_SCOPE_AGENT);
        __syncthreads();
        bool sample; int b, t0, mq0;
        p2_item(it, sample, b, t0, mq0);
        const int Lmax = t0 + 8, L = t0 + w + 1;
        if (Lmax > 256) {
            const int ntiles = ((Lmax + 63) >> 6) * 2;
            const int nj = (ntiles - w + 7) >> 3;
            if (!sample) {
                auto ldB = [&](bf16x8 (&B)[2][4], int j) {
#pragma unroll
                    for (int jj = 0; jj < 2; ++jj) { int kt = w + 8 * (j + jj); kt = kt < ntiles ? kt : ntiles - 1;
                        const GAS bf16* kq_ = kib + (size_t)(b * (TP / 32) + kt) * 2048 + lane * 8;
#pragma unroll
                        for (int s2 = 0; s2 < 4; ++s2) B[jj][s2] = *(const GAS bf16x8*)(kq_ + 512 * s2); } };
                auto cmpB = [&](const bf16x8 (&B)[2][4], int j) {
#pragma unroll
                    for (int jj = 0; jj < 2; ++jj) { if (j + jj < nj) { const int kt = w + 8 * (j + jj);
                        float s4[2][2]; idx_scores(Af, B[jj], wv, s4);
#pragma unroll
                        for (int R = 0; R < 2; ++R) { const int e = kt * 32 + c;
                            sc[(4 * R + hh) * LMAX + e] = __uint_as_float(e <= t0 + 4 * R + hh ? sortable(s4[R][0]) : 0u);
                            sc[(4 * R + 2 + hh) * LMAX + e] = __uint_as_float(e <= t0 + 4 * R + 2 + hh ? sortable(s4[R][1]) : 0u); } }
                        else { asm volatile("" :: "v"(B[jj][0]), "v"(B[jj][1]), "v"(B[jj][2]), "v"(B[jj][3])); } } };
                bf16x8 B0[2][4], B1[2][4];
                ldB(B0, 0);
                for (int j0 = 0; j0 < nj; j0 += 4) { ldB(B1, j0 + 2); cmpB(B0, j0); ldB(B0, j0 + 4); cmpB(B1, j0 + 2); }
#pragma unroll
                for (int jj = 0; jj < 2; ++jj) asm volatile("" :: "v"(B0[jj][0]), "v"(B0[jj][1]), "v"(B0[jj][2]), "v"(B0[jj][3]));
            } else {
                for (int j0 = 0; j0 < nj; j0 += 2) {
                    f32x4 Fb[2][8];
#pragma unroll
                    for (int jj = 0; jj < 2; ++jj) { { int kt = w + 8 * (j0 + jj); kt = kt < ntiles ? kt : ntiles - 1;
                        if (kt < 64) { const int phys = page_table[b * NPG + (kt >> 2)];
                            const GAS float* kq = cache_kidx + ((size_t)phys * PAGE + (kt & 3) * 32 + c) * DI + 8 * hh;
#pragma unroll
                            for (int s2 = 0; s2 < 4; ++s2) { Fb[jj][2 * s2] = *(const GAS f32x4*)(kq + 16 * s2); Fb[jj][2 * s2 + 1] = *(const GAS f32x4*)(kq + 16 * s2 + 4); } }
                        else { const int mk = mq0 + (c & 7);
                            const GAS bf16* kq = kib + (size_t)(mk >> 5) * 2048 + (hh * 32 + (mk & 31)) * 8;
#pragma unroll
                            for (int s2 = 0; s2 < 4; ++s2) { const bf16x8 kv = *(const GAS bf16x8*)(kq + 512 * s2);
                                Fb[jj][2 * s2] = f32x4{bf2f((unsigned short)kv[0]), bf2f((unsigned short)kv[1]), bf2f((unsigned short)kv[2]), bf2f((unsigned short)kv[3])};
                                Fb[jj][2 * s2 + 1] = f32x4{bf2f((unsigned short)kv[4]), bf2f((unsigned short)kv[5]), bf2f((unsigned short)kv[6]), bf2f((unsigned short)kv[7])}; } } } }
#pragma unroll
                    for (int jj = 0; jj < 2; ++jj) { if (j0 + jj < nj) { const int kt = w + 8 * (j0 + jj);
                        bf16x8 Bf[4];
#pragma unroll
                        for (int s2 = 0; s2 < 4; ++s2) { const f32x4 a = Fb[jj][2 * s2], bq = Fb[jj][2 * s2 + 1];
                            v4u o; o.x = cvtpk(a.x, a.y); o.y = cvtpk(a.z, a.w); o.z = cvtpk(bq.x, bq.y); o.w = cvtpk(bq.z, bq.w); Bf[s2] = *(bf16x8*)&o; }
                        float s4[2][2]; idx_scores(Af, Bf, wv, s4);
#pragma unroll
                        for (int R = 0; R < 2; ++R) { const int e = kt * 32 + c;
                            sc[(4 * R + hh) * LMAX + e] = __uint_as_float(e <= t0 + 4 * R + hh ? sortable(s4[R][0]) : 0u);
                            sc[(4 * R + 2 + hh) * LMAX + e] = __uint_as_float(e <= t0 + 4 * R + 2 + hh ? sortable(s4[R][1]) : 0u); } }
                        else { asm volatile("" :: "v"(Fb[jj][0]), "v"(Fb[jj][1]), "v"(Fb[jj][2]), "v"(Fb[jj][3]), "v"(Fb[jj][4]), "v"(Fb[jj][5]), "v"(Fb[jj][6]), "v"(Fb[jj][7])); } }
                }
            }
        }
        if (w == 0 && lane == 0) F.MISC[16] = claim;
        LDS_WAIT();
        __syncthreads();
        const int itn = (int)F.MISC[16];
        if (pend_row >= 0) {
            asm volatile("s_waitcnt vmcnt(0)" ::: "memory");
            if (lane == 0) __hip_atomic_fetch_add(mask_counter(F.ctl, pend_row), 1u, __ATOMIC_RELAXED, __HIP_MEMORY_SCOPE_AGENT);
            pend_row = -1; }
        auto prefetch_q = [&]() {
          if (itn < 2048 + BS) { bool sn; int bn, t0n, mqn; p2_item(itn, sn, bn, t0n, mqn);
              if (t0n + 8 > 256) idx_load_q(qib, wi, mqn, lane, Af, wv); } };
        GAS unsigned long long* mrow = mask + (size_t)(mq0 + w) * 64;
        if (L <= 256) {
            const int lo = 64 * lane;
            const unsigned long long word = (L >= lo + 64) ? ~0ull : (L > lo ? ((1ull << (L - lo)) - 1ull) : 0ull);
            st8wt(mask, ((size_t)(mq0 + w) * 64 + lane) * 8, (size_t)M * 64 * 8, word); pend_row = mq0 + w;
            it = itn;
            continue;
        }
        const int nch = (L + 63) >> 6;
        unsigned x[64];
        const LAS float* srow = sc + w * LMAX + lane; const int rem = L - lane;
#pragma unroll
        for (int g = 0; g < 8; ++g) { if (g * 8 < nch) {
#pragma unroll
            for (int i = 0; i < 8; ++i) { const unsigned v = __float_as_uint(srow[(g * 8 + i) * 64]); x[g * 8 + i] = (g * 8 + i < nch) ? v : 0u; } }
          else {
#pragma unroll
            for (int i = 0; i < 8; ++i) x[g * 8 + i] = 0u; } }
        prefetch_q();
        unsigned T = 0u; bool exact = false; unsigned prefix = 0u; int need = 256;
        {
            asm volatile("" ::: "memory");
            LAS unsigned* h12 = (LAS unsigned*)(sc + w * LMAX);
#pragma unroll
            for (int i = 0; i < 16; ++i) *(LAS v4u*)(h12 + 256 * i + 4 * lane) = v4u{0u, 0u, 0u, 0u};
            asm volatile("" ::: "memory");
#pragma unroll
            for (int g = 0; g < 8; ++g) { if (g * 8 < nch) {
#pragma unroll
                for (int i = 0; i < 8; ++i) __hip_atomic_fetch_add(h12 + (x[g * 8 + i] >> 20), 1u, __ATOMIC_RELAXED, __HIP_MEMORY_SCOPE_WORKGROUP); } }
            LDS_WAIT(); asm volatile("" ::: "memory");
            int sl = 0;
            int lo_ = lane; asm volatile("" : "+v"(lo_));
#pragma unroll
            for (int j = 0; j < 16; ++j) { const v4u c4 = *(const LAS v4u*)(h12 + 64 * lo_ + 4 * ((j + lo_) & 15)); sl += (int)(c4.x + c4.y + c4.z + c4.w); }
            int pf = sl;
            pf += __builtin_amdgcn_update_dpp(0, pf, 0x111, 0xf, 0xf, true);
            pf += __builtin_amdgcn_update_dpp(0, pf, 0x112, 0xf, 0xf, true);
            pf += __builtin_amdgcn_update_dpp(0, pf, 0x114, 0xf, 0xf, true);
            pf += __builtin_amdgcn_update_dpp(0, pf, 0x118, 0xf, 0xf, true);
            pf += __builtin_amdgcn_update_dpp(0, pf, 0x142, 0xa, 0xf, true);
            pf += __builtin_amdgcn_update_dpp(0, pf, 0x143, 0xc, 0xf, true);
            const int above_lane = __builtin_amdgcn_readlane(pf, 63) - pf;
            const int cl = __builtin_ctzll(__ballot((above_lane < need) && (above_lane + sl >= need)));
            const int ab_cl = __builtin_amdgcn_readlane(above_lane, cl);
            const int cb = (int)h12[64 * cl + lane];
            int pf2 = cb;
            pf2 += __builtin_amdgcn_update_dpp(0, pf2, 0x111, 0xf, 0xf, true);
            pf2 += __builtin_amdgcn_update_dpp(0, pf2, 0x112, 0xf, 0xf, true);
            pf2 += __builtin_amdgcn_update_dpp(0, pf2, 0x114, 0xf, 0xf, true);
            pf2 += __builtin_amdgcn_update_dpp(0, pf2, 0x118, 0xf, 0xf, true);
            pf2 += __builtin_amdgcn_update_dpp(0, pf2, 0x142, 0xa, 0xf, true);
            pf2 += __builtin_amdgcn_update_dpp(0, pf2, 0x143, 0xc, 0xf, true);
            const int above2 = ab_cl + __builtin_amdgcn_readlane(pf2, 63) - pf2;
            const int dl = __builtin_ctzll(__ballot((above2 < need) && (above2 + cb >= need)));
            const int above = __builtin_amdgcn_readlane(above2, dl), cnt_d = __builtin_amdgcn_readlane(cb, dl);
            need -= above;
            prefix = (unsigned)(64 * cl + dl);
            T = prefix << 20;
            exact = (cnt_d == need);
        }
        LAS unsigned* hist = (LAS unsigned*)(F.lds + LDSCTL_OFF + 8192 + w * 2048);
        if (!exact) {
#pragma unroll 1
        for (int p = 1; p < 4; ++p) {
            const int shift = p == 3 ? 0 : 20 - 8 * p, width = p == 3 ? 4 : 8;
            *(LAS v4u*)(hist + 4 * lane) = v4u{0u, 0u, 0u, 0u}; *(LAS v4u*)(hist + 256 + 4 * lane) = v4u{0u, 0u, 0u, 0u};
            LDS_WAIT();
#pragma unroll
            for (int g = 0; g < 8; ++g) { if (g * 8 < nch) {
#pragma unroll
                for (int i = 0; i < 8; ++i) { const unsigned xi = x[g * 8 + i];
                    if ((xi >> (shift + width)) == prefix) __hip_atomic_fetch_add(hist + (lane & 1) * 256 + ((xi >> shift) & ((1u << width) - 1u)), 1u, __ATOMIC_RELAXED, __HIP_MEMORY_SCOPE_WORKGROUP); } } }
            LDS_WAIT();
            const v4u c4 = *(const LAS v4u*)(hist + 4 * lane) + *(const LAS v4u*)(hist + 256 + 4 * lane);
            const int sl = (int)(c4.x + c4.y + c4.z + c4.w);
            int pf = sl;
            pf += __builtin_amdgcn_update_dpp(0, pf, 0x111, 0xf, 0xf, true);
            pf += __builtin_amdgcn_update_dpp(0, pf, 0x112, 0xf, 0xf, true);
            pf += __builtin_amdgcn_update_dpp(0, pf, 0x114, 0xf, 0xf, true);
            pf += __builtin_amdgcn_update_dpp(0, pf, 0x118, 0xf, 0xf, true);
            pf += __builtin_amdgcn_update_dpp(0, pf, 0x142, 0xa, 0xf, true);
            pf += __builtin_amdgcn_update_dpp(0, pf, 0x143, 0xc, 0xf, true);
            const int total = __builtin_amdgcn_readlane(pf, 63);
            const int above_lane = total - pf;
            const bool cross = (above_lane < need) && (above_lane + sl >= need);
            const int cl = __builtin_ctzll(__ballot(cross));
            const int t3 = above_lane + (int)c4.w, t2 = t3 + (int)c4.z, t1 = t2 + (int)c4.y;
            int dsel, ab, cd;
            if (t3 >= need) { dsel = 3; ab = above_lane; cd = (int)c4.w; }
            else if (t2 >= need) { dsel = 2; ab = t3; cd = (int)c4.z; }
            else if (t1 >= need) { dsel = 1; ab = t2; cd = (int)c4.y; }
            else { dsel = 0; ab = t1; cd = (int)c4.x; }
            const int d = 4 * cl + __builtin_amdgcn_readlane(dsel, cl);
            const int above = __builtin_amdgcn_readlane(ab, cl), cnt_d = __builtin_amdgcn_readlane(cd, cl);
            need -= above;
            prefix = (prefix << width) | (unsigned)d;
            T = prefix << shift;
            if (cnt_d == need) { exact = true; break; }
        }
        }
        if (exact) {
#pragma unroll
            for (int i = 0; i < 64; ++i) { const unsigned long long bm = __ballot(x[i] >= T);
                wl[i] = bm; }
        } else {
            int cgt = 0;
#pragma unroll
            for (int i = 0; i < 64; ++i) cgt += __builtin_popcountll(__ballot(x[i] > T));
            const int r = 256 - cgt;
            int base = 0;
#pragma unroll
            for (int i = 0; i < 64; ++i) {
                const unsigned long long bgt = __ballot(x[i] > T), beq = __ballot(x[i] == T);
                const int neq = __builtin_popcountll(beq);
                int take = r - base; take = take < 0 ? 0 : take;
                unsigned long long word = bgt | beq;
                if (take < neq) {
                    const int pre = __builtin_popcountll(beq & ((1ull << lane) - 1ull));
                    word = bgt | __ballot((x[i] == T) && pre < take);
                }
                base += neq;
                wl[i] = word;
            }
        }
        LDS_WAIT();
        st8wt(mask, ((size_t)(mq0 + w) * 64 + lane) * 8, (size_t)M * 64 * 8, wl[lane]); pend_row = mq0 + w;
        LDS_WAIT();
        it = itn;
    }
    if (pend_row >= 0) { asm volatile("s_waitcnt vmcnt(0)" ::: "memory"); if (lane == 0) __hip_atomic_fetch_add(mask_counter(F.ctl, pend_row), 1u, __ATOMIC_RELAXED, __HIP_MEMORY_SCOPE_AGENT); }
}

constexpr float SM_SCALE = 0.088388347648318440f;
constexpr int KVBLK = 64;
constexpr size_t SHM_V = KVBLK * HD * 2, SHM_K = KVBLK * HD * 2;
#define KSWZ(row, colB) ((row) * 256 + ((colB) ^ (((row) & 7) << 4)))
__device__ __forceinline__ int crow(int r, int hi) { return (r & 3) + 8 * (r >> 2) + 4 * hi; }
__device__ __forceinline__ int v_st(int k, int c) { const int kk = (k & ~0xC) | ((k & 4) << 1) | ((k & 8) >> 1); return ((kk >> 3) * 4 + (c >> 5)) * 512 + ((kk & 7) * 32 + (c & 31)) * 2; }
__device__ __forceinline__ int v_rd_base(int lane) { return ((lane & 3) << 3) | (((lane >> 2) & 3) << 6) | (((lane >> 4) & 1) << 5) | (((lane >> 5) & 1) << 8); }
constexpr int v_rd_off(int d0, int ks, int half) { return d0 * 512 + ks * 4096 + half * 2048; }
template <int OFF> __device__ __forceinline__ s16x4 tr_read(int vb) {
    s16x4 r; asm volatile("ds_read_b64_tr_b16 %0, %1 offset:%2" : "=&v"(r) : "v"(vb), "i"(OFF) : "memory"); return r;
}
template <int D0> __device__ __forceinline__ void pv_one(f32x16& od, int vb, bf16x8 pa0, bf16x8 pa1, bf16x8 pa2, bf16x8 pa3) {
    const s16x4 l0 = tr_read<v_rd_off(D0, 0, 0)>(vb), h0 = tr_read<v_rd_off(D0, 0, 1)>(vb), l1 = tr_read<v_rd_off(D0, 1, 0)>(vb), h1 = tr_read<v_rd_off(D0, 1, 1)>(vb);
    const s16x4 l2 = tr_read<v_rd_off(D0, 2, 0)>(vb), h2 = tr_read<v_rd_off(D0, 2, 1)>(vb), l3 = tr_read<v_rd_off(D0, 3, 0)>(vb), h3 = tr_read<v_rd_off(D0, 3, 1)>(vb);
    asm volatile("s_waitcnt lgkmcnt(0)" ::: "memory"); SBAR();
#define PK(L, H) (bf16x8){L[0], L[1], L[2], L[3], H[0], H[1], H[2], H[3]}
    od = __builtin_amdgcn_mfma_f32_32x32x16_bf16(pa0, PK(l0, h0), od, 0, 0, 0);
    od = __builtin_amdgcn_mfma_f32_32x32x16_bf16(pa1, PK(l1, h1), od, 0, 0, 0);
    od = __builtin_amdgcn_mfma_f32_32x32x16_bf16(pa2, PK(l2, h2), od, 0, 0, 0);
    od = __builtin_amdgcn_mfma_f32_32x32x16_bf16(pa3, PK(l3, h3), od, 0, 0, 0);
#undef PK
}
__device__ __forceinline__ void pv_d0(f32x16* o, int vb, bf16x8 pa0, bf16x8 pa1, bf16x8 pa2, bf16x8 pa3) {
    pv_one<0>(o[0], vb, pa0, pa1, pa2, pa3); pv_one<1>(o[1], vb, pa0, pa1, pa2, pa3); pv_one<2>(o[2], vb, pa0, pa1, pa2, pa3); pv_one<3>(o[3], vb, pa0, pa1, pa2, pa3);
}
__device__ __forceinline__ void qkt(f32x16& p0, f32x16& p1, const char* Ks, const bf16x8* qr, int r32, int hi) {
    p0 = f32x16{}; p1 = f32x16{};
#pragma unroll
    for (int d0 = 0; d0 < 8; ++d0) { const int cb = (d0 * 16 + hi * 8) * 2;
        const bf16x8 b0 = *reinterpret_cast<const bf16x8*>(Ks + KSWZ(r32, cb));
        const bf16x8 b1 = *reinterpret_cast<const bf16x8*>(Ks + KSWZ(32 + r32, cb));
        p0 = __builtin_amdgcn_mfma_f32_32x32x16_bf16(b0, qr[d0], p0, 0, 0, 0);
        p1 = __builtin_amdgcn_mfma_f32_32x32x16_bf16(b1, qr[d0], p1, 0, 0, 0); }
}
template <int R> __device__ __forceinline__ void mask_exp(f32x16& p, unsigned w) {
    if constexpr (R < 16) { constexpr int sh = (R & 3) + 8 * (R >> 2); unsigned m; asm("v_bfe_i32 %0, %1, %2, 1" : "=v"(m) : "v"(w), "n"(sh));
        p[R] = __uint_as_float(__float_as_uint(__builtin_amdgcn_exp2f(p[R])) & m); mask_exp<R + 1>(p, w); }
}
constexpr float SM_THR = 8.f;
__device__ __forceinline__ void partialSM(f32x16& p0, f32x16& p1, unsigned long long mw, int hi, float& m_reg, float& mn, float& alpha, unsigned& mhi) {
    constexpr float C = 1.f;
    float pmax = p0[0];
#pragma unroll
    for (int r = 1; r < 16; ++r) pmax = fmaxf(pmax, p0[r]);
#pragma unroll
    for (int r = 0; r < 16; ++r) pmax = fmaxf(pmax, p1[r]);
    { auto rr = __builtin_amdgcn_permlane32_swap(__float_as_uint(pmax), __float_as_uint(pmax), false, false);
      pmax = fmaxf(__uint_as_float(rr[0]), __uint_as_float(rr[1])); }
    if (__builtin_expect(__all(pmax - m_reg <= SM_THR * 1.4426950408889634f), 1)) { mn = m_reg; alpha = 1.f; }
    else { mn = fmaxf(m_reg, pmax); alpha = __builtin_amdgcn_exp2f((m_reg - mn) * C); m_reg = mn; }
    const float mnC = -mn * C;
#pragma unroll
    for (int r = 0; r < 16; ++r) p0[r] = fmaf(p0[r], C, mnC);
#pragma unroll
    for (int r = 0; r < 16; ++r) p1[r] = fmaf(p1[r], C, mnC);
    const unsigned w0 = (unsigned)mw >> (4 * hi); mhi = (unsigned)(mw >> 32) >> (4 * hi);
    mask_exp<0>(p0, w0);
}
__device__ __forceinline__ void finishSM(f32x16& p0, f32x16& p1, float alpha, unsigned mhi, float& l_reg, bf16x8& pa0, bf16x8& pa1, bf16x8& pa2, bf16x8& pa3) {
    mask_exp<0>(p1, mhi);
    float ps = 0;
#pragma unroll
    for (int r = 0; r < 16; ++r) ps += p0[r];
#pragma unroll
    for (int r = 0; r < 16; ++r) ps += p1[r];
    { auto rr = __builtin_amdgcn_permlane32_swap(__float_as_uint(ps), __float_as_uint(ps), false, false);
      ps = __uint_as_float(rr[0]) + __uint_as_float(rr[1]); }
    l_reg = l_reg * alpha + ps;
#define PK4(P, BASE, OUT) do { unsigned a0 = cvtpk(P[BASE + 0], P[BASE + 1]), a1 = cvtpk(P[BASE + 2], P[BASE + 3]);   \
    unsigned b0 = cvtpk(P[BASE + 4], P[BASE + 5]), b1 = cvtpk(P[BASE + 6], P[BASE + 7]);                              \
    auto r0 = __builtin_amdgcn_permlane32_swap(a0, b0, false, false); auto r1 = __builtin_amdgcn_permlane32_swap(a1, b1, false, false); \
    v4u wq = {r0[0], r1[0], r0[1], r1[1]}; OUT = *reinterpret_cast<bf16x8*>(&wq); } while (0)
    PK4(p0, 0, pa0); PK4(p0, 8, pa1); PK4(p1, 0, pa2); PK4(p1, 8, pa3);
#undef PK4
}

__device__ __forceinline__ void partialFast(f32x16& p0, unsigned long long mw, int hi, unsigned& mhi) {
    const unsigned w0 = (unsigned)mw >> (4 * hi); mhi = (unsigned)(mw >> 32) >> (4 * hi);
    mask_exp<0>(p0, w0);
}
__device__ __forceinline__ void finishFast(f32x16& p0, f32x16& p1, unsigned mhi, float& l_reg, bf16x8& pa0, bf16x8& pa1, bf16x8& pa2, bf16x8& pa3) {
    mask_exp<0>(p1, mhi);
    float ps = 0;
#pragma unroll
    for (int r = 0; r < 16; ++r) ps += p0[r];
#pragma unroll
    for (int r = 0; r < 16; ++r) ps += p1[r];
    { auto rr = __builtin_amdgcn_permlane32_swap(__float_as_uint(ps), __float_as_uint(ps), false, false);
      ps = __uint_as_float(rr[0]) + __uint_as_float(rr[1]); }
    l_reg += ps;
#define PK4(P, BASE, OUT) do { unsigned a0 = cvtpk(P[BASE + 0], P[BASE + 1]), a1 = cvtpk(P[BASE + 2], P[BASE + 3]);   \
    unsigned b0 = cvtpk(P[BASE + 4], P[BASE + 5]), b1 = cvtpk(P[BASE + 6], P[BASE + 7]);                              \
    auto r0 = __builtin_amdgcn_permlane32_swap(a0, b0, false, false); auto r1 = __builtin_amdgcn_permlane32_swap(a1, b1, false, false); \
    v4u wq = {r0[0], r1[0], r0[1], r1[1]}; OUT = *reinterpret_cast<bf16x8*>(&wq); } while (0)
    PK4(p0, 0, pa0); PK4(p0, 8, pa1); PK4(p1, 0, pa2); PK4(p1, 8, pa3);
#undef PK4
}

template <bool SAMPLE, bool FAST>
__device__ __forceinline__ bool attn_unit(Frame& F, int b, int kvh, int qt, char* lds) {
    GAS unsigned char* ws = F.ws; asm volatile("" : "+s"(ws)); karg_t* kp = kargs();
    const GAS int* page_table = INPTR(int, kp, I_PT); const GAS float* cache_k = INPTR(float, kp, I_CK); const GAS float* cache_v = INPTR(float, kp, I_CV);
    const GAS bf16* qb = (const GAS bf16*)(ws + WS_QB); const GAS bf16* kb = (const GAS bf16*)(ws + WS_KB); const GAS bf16* vb = (const GAS bf16*)(ws + WS_VB);
    const GAS unsigned long long* maskb = (const GAS unsigned long long*)(ws + WS_MASK);
    const int tid = F.wave * 64 + lane_opaque();
    const int wid = F.wave, lane = tid & 63, r32 = lane & 31, hi = lane >> 5;
    char* V_lds = lds; char* K_lds = lds + 3 * SHM_V;
    float* wsl = (float*)(lds + 3 * SHM_V + 3 * SHM_K) + wid * 64; float* li_l = wsl; float* al_l = wsl + 32;
    float m_reg = -1e30f, l_reg = 0; f32x16 o[4] = {}; bf16x8 qr[8];
    const int tokw = SAMPLE ? 0 : 8 * wid;
    const int mrow0 = SAMPLE ? (MP + b * TS) : (b * TP + qt * 64);
    const int mtok = mrow0 + tokw + (r32 >> 2);
    const int head = kvh * 4 + (r32 & 3);
    { const GAS bf16* Qw = qb + (size_t)mtok * D + head * HD + hi * 8;
#pragma unroll
      for (int d0 = 0; d0 < 8; ++d0) qr[d0] = *(const GAS bf16x8*)(Qw + d0 * 16); }
    const GAS unsigned long long* mrow = maskb + (size_t)mtok * 64;
    const int sr = tid >> 4, sc = (tid & 15) * 8, vst0 = v_st(sr, sc), vst1 = v_st(32 + sr, sc);
    const int vb0 = (int)(uintptr_t)V_lds + v_rd_base(lane);
    const int NT = SAMPLE ? 34 : ((qt + 1) + ((qt + 1) & 1));
    typedef typename std::conditional<SAMPLE, f32x8, bf16x8>::type ST;
    ST vs0, vs1, ks0, ks1;
    auto tobf = [](ST x) -> bf16x8 {
        if constexpr (SAMPLE) { v4u wq = {cvtpk(x[0], x[1]), cvtpk(x[2], x[3]), cvtpk(x[4], x[5]), cvtpk(x[6], x[7])}; return *reinterpret_cast<bf16x8*>(&wq); }
        else return x; };
#define SLOAD(kt) do { \
        if constexpr (SAMPLE) { \
            if ((kt) < 32) { const int phys = page_table[b * NPG + ((kt) >> 1)]; \
                const size_t r0 = ((size_t)phys * PAGE + ((kt) & 1) * 64 + sr) * (NKV * HD) + kvh * HD + sc, r1 = r0 + (size_t)32 * (NKV * HD); \
                vs0 = *(const GAS f32x8*)(cache_v + r0); vs1 = *(const GAS f32x8*)(cache_v + r1); ks0 = *(const GAS f32x8*)(cache_k + r0); ks1 = *(const GAS f32x8*)(cache_k + r1); } \
            else { const size_t r0 = (size_t)(mrow0 + (sr & 7)) * 256 + kvh * HD + sc; \
                const bf16x8 kv = *(const GAS bf16x8*)(kb + r0), vv = *(const GAS bf16x8*)(vb + r0); \
                _Pragma("unroll") for (int _e = 0; _e < 8; ++_e) { ks0[_e] = bf2f((unsigned short)kv[_e]); vs0[_e] = bf2f((unsigned short)vv[_e]); } ks1 = ks0; vs1 = vs0; } \
        } else { \
            const size_t r0 = (size_t)(b * TP + (kt) * 64 + sr) * 256 + kvh * HD + sc, r1 = r0 + (size_t)32 * 256; \
            vs0 = *(const GAS bf16x8*)(vb + r0); vs1 = *(const GAS bf16x8*)(vb + r1); ks0 = *(const GAS bf16x8*)(kb + r0); ks1 = *(const GAS bf16x8*)(kb + r1); } } while (0)
#define SWRITE(bsel) do { *(bf16x8*)(V_lds + (bsel) * SHM_V + vst0) = tobf(vs0); *(bf16x8*)(V_lds + (bsel) * SHM_V + vst1) = tobf(vs1); const int kc = sc * 2; \
        *(bf16x8*)(K_lds + (bsel) * SHM_K + KSWZ(sr, kc)) = tobf(ks0); *(bf16x8*)(K_lds + (bsel) * SHM_K + KSWZ(32 + sr, kc)) = tobf(ks1); } while (0)
#define RESC(a) do { if (__any((a) < 1.f)) { if (hi == 0) al_l[r32] = (a); asm volatile("s_waitcnt lgkmcnt(0)" ::: "memory"); \
        _Pragma("unroll") for (int d = 0; d < 4; ++d) _Pragma("unroll") for (int r = 0; r < 16; ++r) o[d][r] *= al_l[crow(r, hi)]; } } while (0)
    f32x16 pA0, pA1, pB0, pB1; float mnA, mnB, alA, alB; bf16x8 pa0, pa1, pa2, pa3;
    unsigned long long mw; unsigned mhA, mhB;
#define PSM(P0, P1, MN, AL, MH) do { if constexpr (FAST) partialFast(P0, mw, hi, MH); else partialSM(P0, P1, mw, hi, m_reg, MN, AL, MH); } while (0)
#define FSM(P0, P1, AL, MH) do { if constexpr (FAST) finishFast(P0, P1, MH, l_reg, pa0, pa1, pa2, pa3); else finishSM(P0, P1, AL, MH, l_reg, pa0, pa1, pa2, pa3); } while (0)
#define RESCF(a) do { if constexpr (!FAST) RESC(a); } while (0)
    if (wid == 0) {
        unsigned* cw = mask_counter(F.ctl, mrow0); unsigned polls = 0;
        while ((unsigned)__builtin_amdgcn_readfirstlane(__hip_atomic_load(cw, __ATOMIC_RELAXED, __HIP_MEMORY_SCOPE_AGENT)) < (SAMPLE ? 8u : 64u)) { if (++polls > (1u << 18)) break; __builtin_amdgcn_s_sleep(2); }
        __builtin_amdgcn_fence(__ATOMIC_ACQUIRE, "agent");
        asm volatile("s_waitcnt vmcnt(0)" ::: "memory"); }
    __syncthreads();
    if (FAST && tid == 0) F.MISC[24] = 0u;
    SLOAD(0); mw = mrow[0]; VM_WAIT(); SWRITE(0); __syncthreads();
    qkt(pA0, pA1, K_lds, qr, r32, hi); PSM(pA0, pA1, mnA, alA, mhA);
    SLOAD(1); mw = mrow[1];
    VM_WAIT(); SWRITE(1); if (NT > 2) SLOAD(2); __syncthreads();
    int s0 = 0, s1 = 1, s2 = 2;
    for (int t = 1; t + 1 < NT; t += 2) {
        VM_WAIT(); SWRITE(s2); SLOAD(t + 2);
        SBAR(); qkt(pB0, pB1, K_lds + s1 * SHM_K, qr, r32, hi);
        FSM(pA0, pA1, alA, mhA); SBAR();
        pv_d0(o, vb0 + s0 * (int)SHM_V, pa0, pa1, pa2, pa3); PSM(pB0, pB1, mnB, alB, mhB); mw = mrow[t + 1];
        RESCF(alB); __syncthreads();
        { const int t_ = s0; s0 = s1; s1 = s2; s2 = t_; }
        VM_WAIT(); SWRITE(s2); if (t + 3 < NT) SLOAD(t + 3);
        SBAR(); qkt(pA0, pA1, K_lds + s1 * SHM_K, qr, r32, hi);
        FSM(pB0, pB1, alB, mhB); SBAR();
        pv_d0(o, vb0 + s0 * (int)SHM_V, pa0, pa1, pa2, pa3); PSM(pA0, pA1, mnA, alA, mhA); mw = mrow[t + 2];
        RESCF(alA); __syncthreads();
        { const int t_ = s0; s0 = s1; s1 = s2; s2 = t_; }
    }
    SBAR(); qkt(pB0, pB1, K_lds + s1 * SHM_K, qr, r32, hi);
    FSM(pA0, pA1, alA, mhA); SBAR();
    pv_d0(o, vb0 + s0 * (int)SHM_V, pa0, pa1, pa2, pa3); PSM(pB0, pB1, mnB, alB, mhB);
    RESCF(alB);
    FSM(pB0, pB1, alB, mhB); SBAR();
    pv_d0(o, vb0 + s1 * (int)SHM_V, pa0, pa1, pa2, pa3);
    if constexpr (FAST) { if (__any(!(l_reg > 1e-30f && l_reg < 1e30f)) && lane == 0) F.MISC[24] = 1u; }
#undef PSM
#undef FSM
#undef RESCF
    if (hi == 0) li_l[r32] = l_reg; asm volatile("s_waitcnt lgkmcnt(0)" ::: "memory");
    bool bad_unit = false;
    {
        int lane_e = (int)__builtin_amdgcn_mbcnt_hi(~0u, __builtin_amdgcn_mbcnt_lo(~0u, 0u)); asm volatile("" : "+v"(lane_e) :: "memory"); const int r32e = lane_e & 31, hie = lane_e >> 5;
        float rli[16];
#pragma unroll
        for (int r = 0; r < 16; ++r) rli[r] = __builtin_amdgcn_rcpf(li_l[crow(r, hie)]);
        __syncthreads();
        if constexpr (FAST) { bad_unit = F.MISC[24] != 0u;
#ifdef PROBE_FORCE_SAFE
            bad_unit = bad_unit || (qt & 1);
#endif
        }
        float* ol = (float*)(lds + wid * 16384);
#pragma unroll
        for (int r = 0; r < 16; ++r) { const int orow = crow(r, hie);
#pragma unroll
            for (int d0 = 0; d0 < 4; ++d0) ol[orow * 128 + d0 * 32 + r32e] = o[d0][r] * rli[r]; }
        asm volatile("s_waitcnt lgkmcnt(0)" ::: "memory");
        if (!SAMPLE || wid == 0) {
            const GAS bf16* ub = (const GAS bf16*)(ws + WS_UB); const GAS bf16* bgb = (const GAS bf16*)(ws + WS_BG); const GAS bf16* sgab = (const GAS bf16*)(ws + WS_SGA);
            GAS bf16* merged = (GAS bf16*)(ws + WS_MERGED);
            karg_t* kp2 = kargs(); const GAS float* conv_w = INPTR(float, kp2, I_CONVW); const GAS float* state_conv = INPTR(float, kp2, I_SC);
            const int ch = kvh * 512 + lane_e * 8;
            const f32x8 w0 = *(const GAS f32x8*)(conv_w + ch), w1 = *(const GAS f32x8*)(conv_w + D + ch), w2 = *(const GAS f32x8*)(conv_w + 2 * D + ch);
            if constexpr (!SAMPLE) {
                const int tq0 = qt * 64 + tokw; const size_t off0 = (size_t)(mrow0 + tokw) * D + ch;
                bf16x8 ur[10], sgr[8], bgr[8];
#pragma unroll
                for (int i = 0; i < 10; ++i) { const bool ok = tq0 + i - 2 >= 0; const bf16x8 x = *(const GAS bf16x8*)(ub + (ok ? off0 + (size_t)(i - 2) * D : off0)); ur[i] = ok ? x : bf16x8{}; }
#pragma unroll
                for (int tk = 0; tk < 8; ++tk) { sgr[tk] = *(const GAS bf16x8*)(sgab + off0 + (size_t)tk * D); bgr[tk] = *(const GAS bf16x8*)(bgb + off0 + (size_t)tk * D); }
#pragma unroll
                for (int tk = 0; tk < 8; ++tk) {
                    const f32x8 ov = *(const f32x8*)(ol + tk * 512 + lane_e * 8);
                    float val[8];
#pragma unroll
                    for (int e = 0; e < 8; ++e) { const float cv = w0[e] * bf2f((unsigned short)ur[tk][e]) + w1[e] * bf2f((unsigned short)ur[tk + 1][e]) + w2[e] * bf2f((unsigned short)ur[tk + 2][e]);
                        val[e] = bf2f((unsigned short)sgr[tk][e]) * ov[e] + bf2f((unsigned short)bgr[tk][e]) * cv; }
                    v4u pk = {cvtpk(val[0], val[1]), cvtpk(val[2], val[3]), cvtpk(val[4], val[5]), cvtpk(val[6], val[7])};
                    st16<true>(merged, (off0 + (size_t)tk * D) * 2, (size_t)M * D * 2, pk);
                }
            } else {
            for (int tk = 0; tk < 8; ++tk) {
                const int tok = tokw + tk, mm = mrow0 + tok, t = SAMPLE ? tok : (qt * 64 + tok);
                const size_t off = (size_t)mm * D + ch;
                const f32x8 ov = *(const f32x8*)(ol + tk * 512 + lane_e * 8);
                const bf16x8 sg = *(const GAS bf16x8*)(sgab + off), bg = *(const GAS bf16x8*)(bgb + off), u2 = *(const GAS bf16x8*)(ub + off);
                f32x8 u1, u0;
                if (t >= 1) { const bf16x8 x = *(const GAS bf16x8*)(ub + off - D);
#pragma unroll
                    for (int e = 0; e < 8; ++e) u1[e] = bf2f((unsigned short)x[e]); }
                else if (SAMPLE) u1 = *(const GAS f32x8*)(state_conv + ((size_t)b * 2 + 1) * D + ch);
                else u1 = f32x8{};
                if (t >= 2) { const bf16x8 x = *(const GAS bf16x8*)(ub + off - 2 * D);
#pragma unroll
                    for (int e = 0; e < 8; ++e) u0[e] = bf2f((unsigned short)x[e]); }
                else if (SAMPLE) u0 = *(const GAS f32x8*)(state_conv + ((size_t)b * 2 + t) * D + ch);
                else u0 = f32x8{};
                float val[8];
#pragma unroll
                for (int e = 0; e < 8; ++e) { const float cv = w0[e] * u0[e] + w1[e] * u1[e] + w2[e] * bf2f((unsigned short)u2[e]);
                    val[e] = bf2f((unsigned short)sg[e]) * ov[e] + bf2f((unsigned short)bg[e]) * cv; }
                v4u pk = {cvtpk(val[0], val[1]), cvtpk(val[2], val[3]), cvtpk(val[4], val[5]), cvtpk(val[6], val[7])};
                st16<true>(merged, off * 2, (size_t)M * D * 2, pk);
            }
            }
            if (!bad_unit) {
                asm volatile("s_waitcnt vmcnt(0)" ::: "memory");
                if (lane_e == 0) __hip_atomic_fetch_add((unsigned*)(F.ctl + CW_DEP) + (size_t)(3 * 128 + (mrow0 >> 8)) * 64, 1u, __ATOMIC_RELAXED, __HIP_MEMORY_SCOPE_AGENT);
            }
        }
    }
#undef SLOAD
#undef SWRITE
#undef RESC
    return bad_unit;
}
__device__ __forceinline__ void attn_sample_unit(Frame& F, int b, int kvh, char* lds) {
    GAS unsigned char* ws = F.ws; asm volatile("" : "+s"(ws)); karg_t* kp = kargs();
    const GAS int* page_table = INPTR(int, kp, I_PT); const GAS float* cache_k = INPTR(float, kp, I_CK); const GAS float* cache_v = INPTR(float, kp, I_CV);
    const GAS bf16* qb = (const GAS bf16*)(ws + WS_QB); const GAS bf16* kb = (const GAS bf16*)(ws + WS_KB); const GAS bf16* vb = (const GAS bf16*)(ws + WS_VB);
    const GAS unsigned long long* maskb = (const GAS unsigned long long*)(ws + WS_MASK);
    const int tid = F.wave * 64 + lane_opaque();
    const int wid = F.wave, lane = tid & 63, r32 = lane & 31, hi = lane >> 5;
    char* V_lds = lds; char* K_lds = lds + 2 * SHM_V;
    float* wsl = (float*)(lds + 2 * SHM_V + 2 * SHM_K) + wid * 64; float* al_l = wsl + 32;
    float* mlt = (float*)(lds + LDSCTL_OFF + 6144);
    float m_reg = -1e30f, l_reg = 0; f32x16 o[4] = {}; bf16x8 qr[8];
    const int mrow0 = MP + b * TS;
    const int mtok = mrow0 + (r32 >> 2);
    const int head = kvh * 4 + (r32 & 3);
    { const GAS bf16* Qw = qb + (size_t)mtok * D + head * HD + hi * 8;
#pragma unroll
      for (int d0 = 0; d0 < 8; ++d0) qr[d0] = *(const GAS bf16x8*)(Qw + d0 * 16); }
    const GAS unsigned long long* mrow = maskb + (size_t)mtok * 64;
    const int sr = tid >> 4, sc = (tid & 15) * 8, vst0 = v_st(sr, sc), vst1 = v_st(32 + sr, sc);
    const int vb0 = (int)(uintptr_t)V_lds + v_rd_base(lane);
    unsigned long long* Mt = (unsigned long long*)(lds + 68 * 1024);
    unsigned long long* Ut = (unsigned long long*)(lds + 72 * 1024);
    int* baset = (int*)(lds + 72 * 1024 + 512);
    int* ptab = (int*)(lds + 72 * 1024 + 832);
    unsigned short* klist = (unsigned short*)(lds + 73 * 1024);
    unsigned long long* cmt = (unsigned long long*)(lds + 78 * 1024);
    if (wid == 0) {
        unsigned* cw = mask_counter(F.ctl, mrow0); unsigned polls = 0;
        while ((unsigned)__builtin_amdgcn_readfirstlane(__hip_atomic_load(cw, __ATOMIC_RELAXED, __HIP_MEMORY_SCOPE_AGENT)) < 8u) { if (++polls > (1u << 18)) break; __builtin_amdgcn_s_sleep(2); }
        __builtin_amdgcn_fence(__ATOMIC_ACQUIRE, "agent");
        asm volatile("s_waitcnt vmcnt(0)" ::: "memory"); }
    __syncthreads();
    Mt[wid * 64 + lane] = lane < 33 ? maskb[(size_t)(mrow0 + wid) * 64 + lane] : 0ull;
    if (tid < NPG) ptab[tid] = page_table[b * NPG + tid];
    asm volatile("s_waitcnt vmcnt(0) lgkmcnt(0)" ::: "memory");
    __syncthreads();
    if (wid == 0) {
        unsigned long long u = 0ull;
#pragma unroll
        for (int w2 = 0; w2 < 8; ++w2) u |= Mt[w2 * 64 + lane];
        const int pc = __builtin_popcountll(u);
        int pf = pc;
        pf += __builtin_amdgcn_update_dpp(0, pf, 0x111, 0xf, 0xf, true);
        pf += __builtin_amdgcn_update_dpp(0, pf, 0x112, 0xf, 0xf, true);
        pf += __builtin_amdgcn_update_dpp(0, pf, 0x114, 0xf, 0xf, true);
        pf += __builtin_amdgcn_update_dpp(0, pf, 0x118, 0xf, 0xf, true);
        pf += __builtin_amdgcn_update_dpp(0, pf, 0x142, 0xa, 0xf, true);
        pf += __builtin_amdgcn_update_dpp(0, pf, 0x143, 0xc, 0xf, true);
        Ut[lane] = u; baset[lane] = pf - pc;
        if (lane == 63) baset[64] = pf;
    }
    asm volatile("s_waitcnt lgkmcnt(0)" ::: "memory");
    __syncthreads();
    const int Cn = baset[64];
#pragma unroll
    for (int i = 0; i < 5; ++i) { const int k = tid + 512 * i;
        if (k < 33 * 64) { const unsigned long long wd = Ut[k >> 6];
            if ((wd >> (k & 63)) & 1ull) klist[baset[k >> 6] + __builtin_popcountll(wd & ((1ull << (k & 63)) - 1ull))] = (unsigned short)k; } }
    asm volatile("s_waitcnt lgkmcnt(0)" ::: "memory");
    __syncthreads();
    const int NTS = (Cn + 63) >> 6;
    for (int j = 0; j < NTS; ++j) {
        const int p = 64 * j + lane; const int key = klist[p < Cn ? p : Cn - 1];
        const bool bit = (p < Cn) && ((Mt[wid * 64 + (key >> 6)] >> (key & 63)) & 1ull);
        const unsigned long long wd = __ballot(bit);
        if (lane == 0) cmt[wid * 34 + j] = wd;
    }
    asm volatile("s_waitcnt lgkmcnt(0)" ::: "memory");
    __syncthreads();
    const unsigned long long* cmrow = cmt + (r32 >> 2) * 34;
    f32x8 vs0, vs1, ks0, ks1;
    auto tobf = [](f32x8 x) -> bf16x8 { v4u wq = {cvtpk(x[0], x[1]), cvtpk(x[2], x[3]), cvtpk(x[4], x[5]), cvtpk(x[6], x[7])}; return *reinterpret_cast<bf16x8*>(&wq); };
    auto ldrow = [&](int p, f32x8& kd, f32x8& vd) {
        const int key = klist[p < Cn ? p : Cn - 1];
        if (key < PAST) { const size_t r0 = ((size_t)ptab[key >> 7] * PAGE + (key & (PAGE - 1))) * (NKV * HD) + kvh * HD + sc;
            kd = *(const GAS f32x8*)(cache_k + r0); vd = *(const GAS f32x8*)(cache_v + r0); }
        else { const size_t r0 = (size_t)(mrow0 + (key - PAST)) * 256 + kvh * HD + sc;
            const bf16x8 kv = *(const GAS bf16x8*)(kb + r0), vv = *(const GAS bf16x8*)(vb + r0);
#pragma unroll
            for (int e = 0; e < 8; ++e) { kd[e] = bf2f((unsigned short)kv[e]); vd[e] = bf2f((unsigned short)vv[e]); } } };
#define SLOAD(kt) do { ldrow(64 * (kt) + sr, ks0, vs0); ldrow(64 * (kt) + 32 + sr, ks1, vs1); } while (0)
#define SWRITE(bsel) do { *(bf16x8*)(V_lds + (bsel) * SHM_V + vst0) = tobf(vs0); *(bf16x8*)(V_lds + (bsel) * SHM_V + vst1) = tobf(vs1); const int kc = sc * 2; \
        *(bf16x8*)(K_lds + (bsel) * SHM_K + KSWZ(sr, kc)) = tobf(ks0); *(bf16x8*)(K_lds + (bsel) * SHM_K + KSWZ(32 + sr, kc)) = tobf(ks1); } while (0)
    SLOAD(0); VM_WAIT(); SWRITE(0); SLOAD(1); __syncthreads();
    for (int j = 0; j < NTS; ++j) {
        if (j + 1 < NTS) { VM_WAIT(); SWRITE((j + 1) & 1); if (j + 2 < NTS) SLOAD(j + 2); }
        if (wid == (j & 7)) {
            const int bsel = j & 1;
            const unsigned long long mw = cmrow[j];
            f32x16 p0, p1; float mn, al; bf16x8 pa0, pa1, pa2, pa3; unsigned mh;
            qkt(p0, p1, K_lds + bsel * SHM_K, qr, r32, hi);
            partialSM(p0, p1, mw, hi, m_reg, mn, al, mh);
            if (__any(al < 1.f)) { if (hi == 0) al_l[r32] = al; asm volatile("s_waitcnt lgkmcnt(0)" ::: "memory");
#pragma unroll
                for (int d = 0; d < 4; ++d)
#pragma unroll
                    for (int r = 0; r < 16; ++r) o[d][r] *= al_l[crow(r, hi)]; }
            finishSM(p0, p1, al, mh, l_reg, pa0, pa1, pa2, pa3); SBAR();
            pv_d0(o, vb0 + bsel * (int)SHM_V, pa0, pa1, pa2, pa3);
        }
        __syncthreads();
    }
    {
        float* ol = (float*)(lds + wid * 16384);
#pragma unroll
        for (int r = 0; r < 16; ++r) { const int orow = crow(r, hi);
#pragma unroll
            for (int d0 = 0; d0 < 4; ++d0) ol[orow * 128 + d0 * 32 + r32] = o[d0][r]; }
        if (hi == 0) { mlt[(wid * 32 + r32) * 2] = m_reg; mlt[(wid * 32 + r32) * 2 + 1] = l_reg; }
        asm volatile("s_waitcnt lgkmcnt(0)" ::: "memory");
        __syncthreads();
        constexpr float C = 1.f;
        const int tk = wid, hq = lane >> 4, row = tk * 4 + hq;
        float mx = -1e30f;
#pragma unroll
        for (int w2 = 0; w2 < 8; ++w2) mx = fmaxf(mx, mlt[(w2 * 32 + row) * 2]);
        float fw[8]; float den = 0.f;
#pragma unroll
        for (int w2 = 0; w2 < 8; ++w2) { fw[w2] = __builtin_amdgcn_exp2f((mlt[(w2 * 32 + row) * 2] - mx) * C); den += fw[w2] * mlt[(w2 * 32 + row) * 2 + 1]; }
        const float rden = __builtin_amdgcn_rcpf(den);
        f32x8 ov = f32x8{};
#pragma unroll
        for (int w2 = 0; w2 < 8; ++w2) { const f32x8 x = *(const f32x8*)((float*)(lds + w2 * 16384) + row * 128 + (lane & 15) * 8); ov += x * fw[w2]; }
        ov = ov * rden;
        const GAS bf16* ub = (const GAS bf16*)(ws + WS_UB); const GAS bf16* bgb = (const GAS bf16*)(ws + WS_BG); const GAS bf16* sgab = (const GAS bf16*)(ws + WS_SGA);
        GAS bf16* merged = (GAS bf16*)(ws + WS_MERGED);
        karg_t* kp2 = kargs(); const GAS float* conv_w = INPTR(float, kp2, I_CONVW); const GAS float* state_conv = INPTR(float, kp2, I_SC);
        const int ch = kvh * 512 + lane * 8;
        const f32x8 w0 = *(const GAS f32x8*)(conv_w + ch), w1 = *(const GAS f32x8*)(conv_w + D + ch), w2v = *(const GAS f32x8*)(conv_w + 2 * D + ch);
        const int t = tk; const size_t off = (size_t)(mrow0 + tk) * D + ch;
        const bf16x8 sg = *(const GAS bf16x8*)(sgab + off), bg = *(const GAS bf16x8*)(bgb + off), u2 = *(const GAS bf16x8*)(ub + off);
        f32x8 u1, u0;
        if (t >= 1) { const bf16x8 x = *(const GAS bf16x8*)(ub + off - D);
#pragma unroll
            for (int e = 0; e < 8; ++e) u1[e] = bf2f((unsigned short)x[e]); }
        else u1 = *(const GAS f32x8*)(state_conv + ((size_t)b * 2 + 1) * D + ch);
        if (t >= 2) { const bf16x8 x = *(const GAS bf16x8*)(ub + off - 2 * D);
#pragma unroll
            for (int e = 0; e < 8; ++e) u0[e] = bf2f((unsigned short)x[e]); }
        else u0 = *(const GAS f32x8*)(state_conv + ((size_t)b * 2 + t) * D + ch);
        float val[8];
#pragma unroll
        for (int e = 0; e < 8; ++e) { const float cv = w0[e] * u0[e] + w1[e] * u1[e] + w2v[e] * bf2f((unsigned short)u2[e]);
            val[e] = bf2f((unsigned short)sg[e]) * ov[e] + bf2f((unsigned short)bg[e]) * cv; }
        v4u pk = {cvtpk(val[0], val[1]), cvtpk(val[2], val[3]), cvtpk(val[4], val[5]), cvtpk(val[6], val[7])};
        st16<true>(merged, off * 2, (size_t)M * D * 2, pk);
        asm volatile("s_waitcnt vmcnt(0)" ::: "memory");
        if (lane == 0) __hip_atomic_fetch_add((unsigned*)(F.ctl + CW_DEP) + (size_t)(3 * 128 + (mrow0 >> 8)) * 64, 1u, __ATOMIC_RELAXED, __HIP_MEMORY_SCOPE_AGENT);
    }
#undef SLOAD
#undef SWRITE
}
__device__ __forceinline__ void p4_attention(Frame& F, char* lds_generic) {
    char* lds = lds_generic + RING_OFF;
    const int grp = __builtin_amdgcn_readfirstlane(((int)blockIdx.x >> 3) & 1);
#pragma unroll 1
    for (int step = 0; step < 2; ++step) {
        const int kind = __builtin_amdgcn_readfirstlane(step ^ grp);
        if (kind == 0) {
            for (int it = blockIdx.x; it < 256; it += F.G) attn_sample_unit(F, it >> 1, it & 1, lds);
        } else {
            for (int it = blockIdx.x; it < 256; it += F.G) {
                const int combo = it & 7, i = it >> 3, b = combo >> 1, kvh = combo & 1;
                for (int h2 = 0; h2 < 2; ++h2) { const int qt = h2 ? i : 63 - i;
                    if (attn_unit<false, true>(F, b, kvh, qt, lds)) attn_unit<false, false>(F, b, kvh, qt, lds); }
            }
        }
    }
}

__device__ __forceinline__ void p9_final(Frame& F) {
    const int lane = lane_opaque(), w = F.wave;
    const GAS float* part3 = (const GAS float*)(F.ws + WS_PART3); const GAS bf16* x3b = (const GAS bf16*)(F.ws + WS_X3B);
    karg_t* kp = kargs(); const GAS f32x4* gr = (const GAS f32x4*)INPTR(float, kp, I_NFIN);
    f32x4 g4[4];
#pragma unroll
    for (int j = 0; j < 4; ++j) g4[j] = gr[(j >> 1) * 128 + 2 * lane + (j & 1)];
    unsigned* qc = (unsigned*)(F.ctl + CW_Q + 2 * 64); unsigned* bank = (unsigned*)(F.ctl + CW_DEP) + (size_t)4 * 128 * 64;
    for (;;) {
        __syncthreads();
        if (w == 0) { unsigned c = 0u; if (lane == 0) c = __hip_atomic_fetch_add(qc, 1u, __ATOMIC_RELAXED, __HIP_MEMORY_SCOPE_AGENT);
            c = (unsigned)__builtin_amdgcn_readfirstlane((int)c);
            if (c < (unsigned)(M / 32)) { const int pi = (int)c >> 3, pm = pi < 4 ? 64 + pi : 8 * ((pi - 4) & 7) + ((pi - 4) >> 3);
                unsigned* cw = bank + (size_t)pm * 64; unsigned polls = 0;
                while ((unsigned)__builtin_amdgcn_readfirstlane(__hip_atomic_load(cw, __ATOMIC_RELAXED, __HIP_MEMORY_SCOPE_AGENT)) < 32u) { if (++polls > (1u << 18)) break; __builtin_amdgcn_s_sleep(2); }
                __builtin_amdgcn_fence(__ATOMIC_ACQUIRE, "agent");
                asm volatile("s_waitcnt vmcnt(0)" ::: "memory");
                c = (unsigned)(pm * 8 + ((int)c & 7)); }
            else c = 0xffffffffu;
            if (lane == 0) F.MISC[16] = c; LDS_WAIT(); }
        __syncthreads();
        const unsigned ch = F.MISC[16];
        if (ch == 0xffffffffu) break;
        const int r0 = (int)ch * 32 + w * 4;
#pragma unroll
        for (int h = 0; h < 1; ++h) {
            v4u v[4][2]; float rs[4];
#pragma unroll
            for (int u = 0; u < 4; ++u) { const int m = r0 + 4 * h + u; rs[u] = row_rs(part3, m);
                const GAS v4u* xr = (const GAS v4u*)(x3b + (size_t)m * D) + lane; v[u][0] = xr[0]; v[u][1] = xr[64]; }
#pragma unroll
            for (int u = 0; u < 4; ++u) { const int m = r0 + 4 * h + u; GAS f32x4* yr = (GAS f32x4*)(F.out + O_Y + (size_t)m * D);
#pragma unroll
                for (int hh = 0; hh < 2; ++hh) { f32x4 a, b; unpack8(v[u][hh], a, b);
                    yr[hh * 128 + 2 * lane] = a * rs[u] * g4[2 * hh]; yr[hh * 128 + 2 * lane + 1] = b * rs[u] * g4[2 * hh + 1]; } }
        }
    }
}

__global__ void __launch_bounds__(NWAVES * 64, 2) mk_fwd(Args args) {
    extern __shared__ __attribute__((aligned(16))) unsigned char lds[];
    Frame F;
    F.lds = (LAS unsigned char*)lds;
    F.MISC = (volatile LAS unsigned*)(F.lds + MISC_OFF);
    F.tid = threadIdx.x; F.lane = F.tid & 63; F.wave = __builtin_amdgcn_readfirstlane(F.tid >> 6);
    F.G = gridDim.x;
    karg_t* kp0 = kargs();
    GAS unsigned char* ws = (GAS unsigned char*)kp0[21]; F.ws = ws; F.out = (GAS float*)kp0[20];
    F.ctl = (gu32*)(ws + WS_CTL);
    for (int u = F.tid; u < (LDS_BYTES - LDSCTL_OFF) / 4; u += NWAVES * 64) ((LAS unsigned*)(F.lds + LDSCTL_OFF))[u] = 0u;
    __syncthreads();
    const int lo = args.ph_lo, hi = args.ph_hi; F.qoff = args.qoff;
    const bool multi = (hi - lo) > 1;
    XcdBarrier bar; bar.bar = (unsigned*)(F.ctl + CW_BAR); bar.x = 0; bar.st = nullptr;
    if (multi) bar = xcd_barrier_post((unsigned*)(F.ctl + CW_BAR), F.MISC + 8, F.tid);
#ifndef PHASE_MASK
#define PHASE_MASK 0xfff
#endif
#define IN(k) (((PHASE_MASK >> (k)) & 1) && lo <= (k) && (k) < hi && (F.lane = lane_opaque(), F.tid = F.wave * 64 + F.lane, true))
#define INP(k) (((PHASE_MASK >> (k)) & 1) && lo <= (k) && (k) < hi)
#define SEAM(k) do { if (INP(k) && INP((k) + 1)) xcd_barrier(bar, F.wave * 64 + lane_opaque()); } while (0)
    using pg8::Gemm; using pg8::StaticOrder;
    const GAS bf16* HB = (const GAS bf16*)(ws + WS_HB);

    if (IN(0)) { if (blockIdx.x == 0 && F.tid < 8) __hip_atomic_store((unsigned*)(F.ctl + CW_Q + 64 * F.tid), 0u, RLX_AGENT);
                 p0_prologue(F); } SEAM(0);

    if (IN(1)) {
        { Gemm g{HB, (const GAS bf16*)(ws + WS_WIN), M, NIN, D}; StaticOrder S; S.init(M, NIN, F.G, (int)blockIdx.x);
          EpiIn E{(GAS bf16*)(ws + WS_QB), (GAS bf16*)(ws + WS_KB), (GAS bf16*)(ws + WS_VB), (GAS bf16*)(ws + WS_QIB), (GAS bf16*)(ws + WS_KIB), (GAS bf16*)(ws + WS_UB), (GAS bf16*)(ws + WS_BG), (GAS bf16*)(ws + WS_SGA),
                  (GAS float*)(ws + WS_WI), (const GAS float2*)(ws + WS_CS128), (const GAS float2*)(ws + WS_CS64), F.out};
          pg8::gemm_phase<EpiIn, StaticOrder, true, true>(F.lds + RING_OFF, g, S, E, F.wave * 64 + lane_opaque()); }
    } SEAM(1);

    if (IN(2)) { p2_index_select(F); }
    if (IN(3)) { p4_attention(F, (char*)lds); }

    if (IN(4)) {
        pg8::Stream S;
        S.A[0] = WS_PB; S.Bt[0] = WS_WPLE; S.nN[0] = D / 256;   S.K[0] = DPLE; S.dep[0] = -1; S.need[0] = 0;                S.pub[0] = 2;
        S.A[1] = WS_MERGED; S.Bt[1] = WS_WOUT; S.nN[1] = D / 256;   S.K[1] = D;    S.dep[1] = 3;  S.need[1] = 64; S.need1_hi = 512;  S.pub[1] = 0;
        S.A[2] = WS_X1B; S.Bt[2] = WS_WGU;  S.nN[2] = NGU / 256; S.K[2] = D;    S.dep[2] = 0;  S.need[2] = 8 * (D / 256);    S.pub[2] = 1;
        S.A[3] = WS_ACT; S.Bt[3] = WS_WDN;  S.nN[3] = D / 256;   S.K[3] = DFF;  S.dep[3] = 1;  S.need[3] = 8 * (NGU / 256);  S.pub[3] = 2;
        S.A[4] = WS_X2B; S.Bt[4] = WS_WPG;  S.nN[4] = D / 256;   S.K[4] = D;    S.dep[4] = 2;  S.need[4] = 16 * (D / 256);   S.pub[4] = 4;
        S.nM = M / 256; S.first[0] = 0;
        S.first[1] = S.first[0] + S.nM * S.nN[0]; S.first[2] = S.first[1] + S.nM * S.nN[1]; S.first[3] = S.first[2] + S.nM * S.nN[2]; S.first[4] = S.first[3] + S.nM * S.nN[3]; S.first[5] = S.first[4] + S.nM * S.nN[4];
        S.base = ws; S.cnt = (unsigned*)(F.ctl + CW_DEP); S.G = F.G; S.c = (int)blockIdx.x;
        karg_t* kp = kargs();
        EpiStream E{ws, F.out, INPTR(float, kp, I_XP), INPTR(float, kp, I_XS)};
        pg8::gemm_stream<EpiStream>(F.lds + RING_OFF, S, E, F.wave * 64 + lane_opaque(), F.MISC + 20);
    }

    if (IN(5)) { p9_final(F); }
#undef IN
#undef SEAM
}

extern "C" void kernel_launch(void* const* d_in, const int* in_sizes, int n_in, void* d_out, int out_size, void* d_ws, size_t ws_size, hipStream_t stream) {
    static int grid = 0;
    if (grid == 0) {
        if (n_in != 20 || out_size != (int)O_END || ws_size < WS_END) { fprintf(stderr, "kernel_launch: unexpected shapes: n_in %d out %d ws %zu (need %zu)\n", n_in, out_size, ws_size, (size_t)WS_END); grid = -1; return; }
        int dev = 0, cus = 0;
        if (hipGetDevice(&dev) != hipSuccess || hipDeviceGetAttribute(&cus, hipDeviceAttributeMultiprocessorCount, dev) != hipSuccess) { grid = -1; return; }
        if (hipFuncSetAttribute((const void*)mk_fwd, hipFuncAttributeMaxDynamicSharedMemorySize, LDS_BYTES) != hipSuccess) { fprintf(stderr, "kernel_launch: hipFuncSetAttribute failed\n"); grid = -1; return; }
        int nb = 0;
        if (hipOccupancyMaxActiveBlocksPerMultiprocessor(&nb, (const void*)mk_fwd, NWAVES * 64, LDS_BYTES) != hipSuccess || nb < 1) { fprintf(stderr, "kernel_launch: occupancy query failed (%d)\n", nb); grid = -1; return; }
        (void)hipGetLastError();
        grid = cus;
    }
    if (grid < 0) return;
    if (hipMemsetAsync((char*)d_ws + WS_CTL, 0, CTL_ZERO_BYTES, stream) != hipSuccess) { fprintf(stderr, "kernel_launch: memset failed\n"); return; }
    Args a{};
    for (int i = 0; i < 20; ++i) a.in[i] = d_in[i];
    a.out = (float*)d_out; a.ws = (unsigned char*)d_ws;
#if MK_ONE_LAUNCH
    a.ph_lo = 0; a.ph_hi = NPHASE;
    hipLaunchKernelGGL(mk_fwd, dim3(grid), dim3(NWAVES * 64), LDS_BYTES, stream, a);
#else
    for (int p = 0; p < NPHASE; ++p) { a.ph_lo = p; a.ph_hi = p + 1; a.qoff = 0; hipLaunchKernelGGL(mk_fwd, dim3(grid), dim3(NWAVES * 64), LDS_BYTES, stream, a); }
#endif
    const hipError_t le = hipPeekAtLastError();
    if (le != hipSuccess) fprintf(stderr, "kernel_launch: launch failed: %s\n", hipGetErrorName(le));
}
```
